# Optimizing an MI355X kernel written in HIP

```python
import jax, jax.numpy as jnp
from jax import lax
import numpy as np

D_MODEL = 1024
BATCH = 4
SEQ = 8192
DEPTH = 4

CTX_LEN = 256
GRID_W = 64
FOURIER_WIDTH = 256
FOURIER_GROUPS = 4
SGU_WIDTH = 256
SGU_GROUPS = 4
CHUNK = 128
N_HEADS = 8
N_KV_HEADS = 2
HEAD_DIM = 64
ATTN_WIDTH = N_HEADS * HEAD_DIM
KV_WIDTH = N_KV_HEADS * HEAD_DIM
WINDOW = 128
BLOCK = 128
ROPE_THETA = 10000.0
N_BRANCHES = 3
EPS = 1e-6
NEG_INF = -1e30
IN_WIDTH = 2 * FOURIER_WIDTH + 3 * SGU_WIDTH + 2 * ATTN_WIDTH + 2 * KV_WIDTH + N_BRANCHES * D_MODEL
KV_OFFSET = 2 * FOURIER_WIDTH + 3 * SGU_WIDTH + ATTN_WIDTH

kernel_name = "hybrid_fourier_sgu_window_gqa_trunk"


def _split_proj(p):
    sizes = (FOURIER_WIDTH, FOURIER_WIDTH, SGU_WIDTH, SGU_WIDTH, SGU_WIDTH,
             ATTN_WIDTH, KV_WIDTH, KV_WIDTH, ATTN_WIDTH, N_BRANCHES * D_MODEL)
    offs = [int(o) for o in np.cumsum(sizes)[:-1]]
    return jnp.split(p, offs, axis=-1)


def _rms(x):
    x32 = x.astype(jnp.float32)
    return (x32 * lax.rsqrt(jnp.mean(x32 * x32, axis=-1, keepdims=True) + EPS)).astype(x.dtype)


def _axial_rope(x, row, col):
    half = HEAD_DIM // 2
    nf = half // 2
    inv = ROPE_THETA ** (-jnp.arange(nf, dtype=jnp.float32) / nf)

    def rot(xp, pos):
        ang = pos.astype(jnp.float32)[:, None] * inv[None, :]
        cos = jnp.cos(ang)[None, :, None, :]
        sin = jnp.sin(ang)[None, :, None, :]
        x1, x2 = xp[..., :nf], xp[..., nf:]
        return jnp.concatenate([x1 * cos - x2 * sin, x2 * cos + x1 * sin], axis=-1)

    x32 = x.astype(jnp.float32)
    return jnp.concatenate([rot(x32[..., :half], row), rot(x32[..., half:], col)], axis=-1).astype(x.dtype)


def _fourier(f):
    B, L, W = f.shape
    fg = f.reshape(B, L, FOURIER_GROUPS, W // FOURIER_GROUPS).astype(jnp.float32)
    y = jnp.fft.fft2(fg, axes=(1, 3), norm="ortho").real
    return y.reshape(B, L, W).astype(f.dtype)


def _sgu(u, v, w_s, b_s):
    B, L, W = v.shape
    nc = L // CHUNK
    gw = W // SGU_GROUPS
    vn = _rms(v).reshape(B, nc, CHUNK, SGU_GROUPS, gw)
    mixed = jnp.einsum('gst,bctgd->bcsgd', w_s, vn) + b_s.T[:, :, None]
    return u * mixed.reshape(B, L, W)


def _latent_attn(q, k, v, kc, vc, sinks):
    B, L = q.shape[0], q.shape[1]
    C = kc.shape[1]
    nb = L // BLOCK
    G = N_HEADS // N_KV_HEADS
    qb = q.reshape(B, nb, BLOCK, N_KV_HEADS, G, HEAD_DIM)
    pad = ((0, 0), (BLOCK, BLOCK), (0, 0), (0, 0))
    kp = jnp.pad(k, pad).reshape(B, nb + 2, BLOCK, N_KV_HEADS, HEAD_DIM)
    vp = jnp.pad(v, pad).reshape(B, nb + 2, BLOCK, N_KV_HEADS, HEAD_DIM)

    def band(t):
        return jnp.concatenate([t[:, :-2], t[:, 1:-1], t[:, 2:]], axis=2)

    kb, vb = band(kp), band(vp)
    qi = jnp.arange(BLOCK)[:, None]
    kj = jnp.arange(3 * BLOCK)[None, :]
    in_win = jnp.abs(kj - BLOCK - qi) <= WINDOW
    kpos = jnp.arange(nb)[:, None] * BLOCK - BLOCK + jnp.arange(3 * BLOCK)[None, :]
    in_seq = (kpos >= 0) & (kpos < L)
    mask = in_win[None] & in_seq[:, None, :]
    scale = HEAD_DIM ** -0.5
    s_loc = jnp.einsum('bnqhgd,bnkhd->bnhgqk', qb, kb).astype(jnp.float32) * scale
    s_loc = jnp.where(mask[None, :, None, None], s_loc, NEG_INF)
    s_ctx = jnp.einsum('bnqhgd,bchd->bnhgqc', qb, kc).astype(jnp.float32) * scale
    s_sink = jnp.broadcast_to(sinks.astype(jnp.float32).reshape(N_KV_HEADS, G, 1, 1), s_loc.shape[:-1] + (1,))
    probs = jax.nn.softmax(jnp.concatenate([s_loc, s_ctx, s_sink], axis=-1), axis=-1)
    p_loc = probs[..., :3 * BLOCK].astype(v.dtype)
    p_ctx = probs[..., 3 * BLOCK:3 * BLOCK + C].astype(v.dtype)
    o = (jnp.einsum('bnhgqk,bnkhd->bnqhgd', p_loc, vb)
         + jnp.einsum('bnhgqc,bchd->bnqhgd', p_ctx, vc))
    return o.reshape(B, L, ATTN_WIDTH)


def _ctx_attn(q, k, v, sinks):
    B, C = q.shape[0], q.shape[1]
    G = N_HEADS // N_KV_HEADS
    qg = q.reshape(B, C, N_KV_HEADS, G, HEAD_DIM)
    s = jnp.einsum('bqhgd,bkhd->bhgqk', qg, k).astype(jnp.float32) * (HEAD_DIM ** -0.5)
    s_sink = jnp.broadcast_to(sinks.astype(jnp.float32).reshape(N_KV_HEADS, G, 1, 1), s.shape[:-1] + (1,))
    probs = jax.nn.softmax(jnp.concatenate([s, s_sink], axis=-1), axis=-1)[..., :C].astype(v.dtype)
    return jnp.einsum('bhgqk,bkhd->bqhgd', probs, v).reshape(B, C, ATTN_WIDTH)


def _mixer_out(fa, za, u, vs, zb, attn, zc, g, w_s, b_s, w_pa, w_pb, w_pc, w_out):
    ya = _fourier(fa) * jax.nn.silu(za)
    yb = _sgu(u, vs, w_s, b_s) * jax.nn.silu(zb)
    yc = attn * jax.nn.silu(zc)
    ga, gb, gc = jnp.split(jax.nn.sigmoid(g), N_BRANCHES, axis=-1)
    merged = ga * (ya @ w_pa) + gb * (yb @ w_pb) + gc * (yc @ w_pc)
    return merged @ w_out


def _qk(t, n_heads, gain):
    B, L = t.shape[0], t.shape[1]
    return _rms(t.reshape(B, L, n_heads, HEAD_DIM)) * gain


def setup_inputs(seed: int = 0) -> dict:
    key = jax.random.key(seed)
    ks = jax.random.split(key, 16)
    f32 = jnp.float32
    D = D_MODEL
    return {
        "x": jax.random.normal(ks[0], (BATCH, SEQ, D), f32),
        "c": jax.random.normal(ks[1], (BATCH, D), f32),
        "ctx": jax.random.normal(ks[2], (BATCH, CTX_LEN, D), f32),
        "c_ctx": jax.random.normal(ks[3], (D,), f32),
        "w_ada": jax.random.normal(ks[4], (DEPTH, D, 3 * D), f32) * (0.5 * D ** -0.5),
        "b_ada": jax.random.normal(ks[5], (DEPTH, 3 * D), f32) * 0.02,
        "w_in": jax.random.normal(ks[6], (DEPTH, D, IN_WIDTH), f32) * D ** -0.5,
        "sgu_w": jax.random.normal(ks[7], (DEPTH, SGU_GROUPS, CHUNK, CHUNK), f32) * CHUNK ** -0.5,
        "sgu_b": 1.0 + 0.02 * jax.random.normal(ks[8], (DEPTH, SGU_GROUPS, CHUNK), f32),
        "q_norm_g": 1.0 + 0.02 * jax.random.normal(ks[9], (DEPTH, HEAD_DIM), f32),
        "k_norm_g": 1.0 + 0.02 * jax.random.normal(ks[10], (DEPTH, HEAD_DIM), f32),
        "attn_sink": jax.random.normal(ks[11], (DEPTH, N_HEADS), f32),
        "w_pa": jax.random.normal(ks[12], (DEPTH, FOURIER_WIDTH, D), f32) * FOURIER_WIDTH ** -0.5,
        "w_pb": jax.random.normal(ks[13], (DEPTH, SGU_WIDTH, D), f32) * SGU_WIDTH ** -0.5,
        "w_pc": jax.random.normal(ks[14], (DEPTH, ATTN_WIDTH, D), f32) * ATTN_WIDTH ** -0.5,
        "w_out": jax.random.normal(ks[15], (DEPTH, D, D), f32) * D ** -0.5,
    }


def reference(x, c, ctx, c_ctx, w_ada, b_ada, w_in, sgu_w, sgu_b, q_norm_g, k_norm_g,
              attn_sink, w_pa, w_pb, w_pc, w_out):
    B, L, _ = x.shape
    C = ctx.shape[1]
    rows = L // GRID_W
    row = jnp.repeat(jnp.arange(rows), GRID_W)
    col = jnp.tile(jnp.arange(GRID_W), rows)
    s_c = jax.nn.silu(c)
    s_cc = jax.nn.silu(c_ctx)
    xc = ctx
    for l in range(DEPTH):
        last = l == DEPTH - 1
        shift, scale, gate = jnp.split(s_c @ w_ada[l] + b_ada[l], 3, axis=-1)
        shift_c, scale_c, gate_c = jnp.split(s_cc @ w_ada[l] + b_ada[l], 3, axis=-1)
        h = _rms(x) * (1.0 + scale[:, None, :]) + shift[:, None, :]
        hc = _rms(xc) * (1.0 + scale_c) + shift_c

        fa, za, u, vs, zb, q, k, va, zc, g = _split_proj(h @ w_in[l])
        q = _axial_rope(_qk(q, N_HEADS, q_norm_g[l]), row, col)
        k = _axial_rope(_qk(k, N_KV_HEADS, k_norm_g[l]), row, col)
        va = va.reshape(B, L, N_KV_HEADS, HEAD_DIM)

        if last:
            kc, vc = jnp.split(hc @ w_in[l][:, KV_OFFSET:KV_OFFSET + 2 * KV_WIDTH], 2, axis=-1)
        else:
            fa_c, za_c, u_c, vs_c, zb_c, qc, kc, vc, zc_c, g_c = _split_proj(hc @ w_in[l])
        kc = _qk(kc, N_KV_HEADS, k_norm_g[l])
        vc = vc.reshape(B, C, N_KV_HEADS, HEAD_DIM)

        attn = _latent_attn(q, k, va, kc, vc, attn_sink[l])
        out = _mixer_out(fa, za, u, vs, zb, attn, zc, g, sgu_w[l], sgu_b[l],
                         w_pa[l], w_pb[l], w_pc[l], w_out[l])

        if not last:
            qc = _qk(qc, N_HEADS, q_norm_g[l])
            attn_c = _ctx_attn(qc, kc, vc, attn_sink[l])
            out_c = _mixer_out(fa_c, za_c, u_c, vs_c, zb_c, attn_c, zc_c, g_c, sgu_w[l], sgu_b[l],
                               w_pa[l], w_pb[l], w_pc[l], w_out[l])
            xc = xc + gate_c * out_c
        x = x + gate[:, None, :] * out
    return x
```

```cpp
#include <hip/hip_runtime.h>
#include <hip/hip_cooperative_groups.h>
#include <cstdio>
#include <cstdint>
namespace cg = cooperative_groups;

#define LAS __attribute__((address_space(3)))
typedef unsigned short bf16_t;
typedef short bf16x8 __attribute__((ext_vector_type(8)));
typedef short s16x4 __attribute__((ext_vector_type(4)));
typedef float f32x4 __attribute__((ext_vector_type(4)));
typedef unsigned u32x4 __attribute__((ext_vector_type(4)));
typedef unsigned u32x2 __attribute__((ext_vector_type(2)));
typedef float f32x2_t __attribute__((ext_vector_type(2)));
typedef __bf16 bf16x2_t __attribute__((ext_vector_type(2)));

constexpr int DM = 1024, NB = 4, SEQ = 8192, DEPTH = 4, CTXL = 256;
constexpr int ML = NB * SEQ;
constexpr int MC = NB * CTXL;
constexpr int MT = ML + MC;
constexpr int INW = 5632;
constexpr int NIN = 5888;
constexpr float EPSV = 1e-6f;
constexpr float LOG2E = 1.4426950408889634f;

constexpr size_t MiB = 1u << 20;
constexpr size_t WS_MOD = 0;
constexpr size_t WS_ROPE = 256 * 1024;
constexpr size_t WS_T128 = 512 * 1024;
constexpr size_t WS_TC = 1 * MiB;
constexpr size_t WS_T3 = 2 * MiB;
constexpr size_t WS_SGUW = 4 * MiB;
constexpr size_t WS_XC = 8 * MiB;
constexpr size_t WS_W = 16 * MiB;
constexpr size_t W_IN_OFF = 0, W_PA_OFF = (size_t)NIN * 1024 * 2, W_PB_OFF = W_PA_OFF + 1024 * 256 * 2, W_PC_OFF = W_PB_OFF + 1024 * 256 * 2, W_OUT_OFF = W_PC_OFF + 1024 * 512 * 2;
constexpr size_t WS_H = 32 * MiB;
constexpr size_t WS_G = 98 * MiB;
constexpr size_t WS_Z = 131 * MiB;
constexpr size_t WS_U = 197 * MiB;
constexpr size_t WS_QKV = 230 * MiB;
constexpr size_t WS_GT = 280 * MiB;
constexpr size_t WS_END = 478 * MiB;
static_assert(W_OUT_OFF + 1024 * 1024 * 2 <= 16 * MiB, "weights fit");

constexpr int LDS_BYTES = 147456;

__device__ __forceinline__ unsigned cvtpk(float lo, float hi) { f32x2_t v = {lo, hi}; bf16x2_t b = __builtin_convertvector(v, bf16x2_t); return __builtin_bit_cast(unsigned, b); }
__device__ __forceinline__ float bflo(unsigned w) { return __uint_as_float(w << 16); }
__device__ __forceinline__ float bfhi(unsigned w) { return __uint_as_float(w & 0xffff0000u); }
__device__ __forceinline__ float silu_f(float v) { return v * __builtin_amdgcn_rcpf(1.f + __expf(-v)); }
__device__ __forceinline__ float sigm_f(float v) { return __builtin_amdgcn_rcpf(1.f + __expf(-v)); }
typedef short v4i16_t __attribute__((ext_vector_type(4)));
__device__ __forceinline__ s16x4 lds_tr(const LAS unsigned char* p) { return __builtin_bit_cast(s16x4, __builtin_amdgcn_ds_read_tr16_b64_v4i16((LAS v4i16_t*)p)); }
__device__ __forceinline__ bf16x8 cat8(s16x4 a, s16x4 b) { return (bf16x8){a[0], a[1], a[2], a[3], b[0], b[1], b[2], b[3]}; }

namespace pg8 {
constexpr int BM = 256, BK = 64, HALF = 128, HTB = HALF * BK * 2, STAGE_BYTES = 8 * HTB, NXCD = 8, WGM = 8;
__host__ __device__ __forceinline__ int lds_byte(int r, int c) { const int st = (r >> 4) * 2 + (c >> 5), rr = r & 15, cc = c & 31, ob = rr * 64 + cc * 2; return st * 1024 + (ob ^ (((ob >> 9) & 1) << 5)); }
__host__ __device__ __forceinline__ void stage_rc(int b, int& R, int& C) { const int st = b / 1024, sb = b % 1024, swz = sb ^ (((sb >> 9) & 1) << 5); R = (st >> 1) * 16 + swz / 64; C = (st & 1) * 32 + (swz % 64) / 2; }
__host__ __device__ __forceinline__ int perm32(int rho) { const int n = rho >> 4, i = rho & 15; return 8 * (i >> 2) + 4 * n + (i & 3); }
struct Unit { int pm, pn; };
struct Gemm { const bf16_t* A; const bf16_t* Bt; int M, N, K, lda; };
struct StaticOrder {
    int nM, nN, nwg, G, c;
    __host__ __device__ void init(int M, int N, int G_, int c_) { nM = M / BM; nN = N / BM; nwg = nM * nN; G = G_; c = c_; }
    __host__ __device__ bool next(int i, Unit& u) const {
        const long L = (long)i * G + c; if (L >= nwg) return false;
        int wgid = (int)L; { const int q = nwg / NXCD, r = nwg % NXCD, xcd = wgid % NXCD, off = wgid / NXCD; wgid = (xcd < r ? xcd * (q + 1) : r * (q + 1) + (xcd - r) * q) + off; }
        const int nig = WGM * nN, gid = wgid / nig, fm = gid * WGM, gsz = (nM - fm) < WGM ? (nM - fm) : WGM;
        u.pm = fm + ((wgid % nig) % gsz); u.pn = (wgid % nig) / gsz; return true;
    }
};
template <class Epi>
__device__ __forceinline__ void gemm_phase(LAS unsigned char* lds, const Gemm g, const StaticOrder& S, const Epi& E, const int tid) {
    const int wid = __builtin_amdgcn_readfirstlane(tid >> 6), lane = tid & 63, wr = wid >> 2, wc = wid & 3, fr = lane & 15, fq = lane >> 4;
    const int K = g.K, nt = K / BK, lda = g.lda;
    unsigned voffA[2], voffB[2];
#pragma unroll
    for (int i = 0; i < 2; ++i) { int R, C; stage_rc(tid * 16 + i * 8192, R, C); const int Rb = Epi::PERM ? ((R & ~31) + perm32(R & 31)) : R;
        voffA[i] = (unsigned)(R * lda + C) * 2u; voffB[i] = (unsigned)(Rb * K + C) * 2u; }
    const size_t kstep = (size_t)(BK * 2);
    const size_t hstepA = (size_t)HALF * lda * 2, hstepB = (size_t)HALF * K * 2;
    const size_t tstepA = 2 * hstepA, tstepB = 2 * hstepB;
    const unsigned ldsw = (unsigned)wid * 1024u;
    const int aoff = lds_byte(wr * 64 + fr, fq * 8), boff = lds_byte(wc * 32 + fr, fq * 8);
#define PG8_SA(b, h) (((b) * 2 + (h)) * HTB)
#define PG8_SB(b, h) ((4 + (b) * 2 + (h)) * HTB)
#define PG8_STAGE(bufoff, gbase, voff) do { _Pragma("unroll") for (int _i = 0; _i < 2; ++_i) \
        __builtin_amdgcn_global_load_lds((const unsigned*)((const char*)(gbase) + (voff)[_i]), (LAS unsigned*)(lds + (bufoff) + ldsw + _i * 8192), 16, 0, 0); } while (0)
#define PG8_LDA(dst, b, h) do { _Pragma("unroll") for (int m = 0; m < 4; ++m) _Pragma("unroll") for (int k = 0; k < 2; ++k) dst[m][k] = *(const LAS bf16x8*)(lds + PG8_SA(b, h) + aoff + m * 2048 + k * 1024); } while (0)
#define PG8_LDB(dst, b, h) do { _Pragma("unroll") for (int n = 0; n < 2; ++n) _Pragma("unroll") for (int k = 0; k < 2; ++k) dst[n][k] = *(const LAS bf16x8*)(lds + PG8_SB(b, h) + boff + n * 2048 + k * 1024); } while (0)
#define PG8_MMA(ai, bj, At, Bt) do { __builtin_amdgcn_s_setprio(1); _Pragma("unroll") for (int m = 0; m < 4; ++m) _Pragma("unroll") for (int n = 0; n < 2; ++n) _Pragma("unroll") for (int k = 0; k < 2; ++k) \
        acc[ai][bj][m][n] = __builtin_amdgcn_mfma_f32_16x16x32_bf16(Bt[n][k], At[m][k], acc[ai][bj][m][n], 0, 0, 0); __builtin_amdgcn_s_setprio(0); } while (0)
#define PG8_WAIT_V(n) asm volatile("s_waitcnt vmcnt(" #n ")" ::: "memory")
#define PG8_WAIT_L(n) asm volatile("s_waitcnt lgkmcnt(" #n ")" ::: "memory")
#define PG8_BAR __builtin_amdgcn_s_barrier()
#define PG8_SCHED __builtin_amdgcn_sched_barrier(0)
    Unit cur, nxt; int ui = 0;
    if (!S.next(0, cur)) return;
    f32x4 acc[2][2][4][2];
#pragma unroll
    for (int a = 0; a < 2; ++a)
#pragma unroll
        for (int b = 0; b < 2; ++b)
#pragma unroll
            for (int m = 0; m < 4; ++m)
#pragma unroll
                for (int n = 0; n < 2; ++n) acc[a][b][m][n] = (f32x4){0.f, 0.f, 0.f, 0.f};
    bf16x8 At[4][2], B0[2][2], B1[2][2];
    const char* cA = (const char*)g.A + (size_t)cur.pm * tstepA; const char* cB = (const char*)g.Bt + (size_t)cur.pn * tstepB;
    PG8_STAGE(PG8_SB(0, 0), cB, voffB); PG8_STAGE(PG8_SB(0, 1), cB + hstepB, voffB); PG8_STAGE(PG8_SA(0, 0), cA, voffA); PG8_STAGE(PG8_SA(0, 1), cA + hstepA, voffA);
    if (wr == 1) PG8_BAR;
    PG8_WAIT_V(2); PG8_BAR;
    PG8_STAGE(PG8_SB(1, 0), cB + kstep, voffB); PG8_STAGE(PG8_SA(1, 0), cA + kstep, voffA); PG8_STAGE(PG8_SB(1, 1), cB + hstepB + kstep, voffB);
    PG8_WAIT_V(6); PG8_BAR;
    for (;;) {
        const bool has_next = S.next(ui + 1, nxt);
        const char* nA = has_next ? (const char*)g.A + (size_t)nxt.pm * tstepA : cA; const char* nB = has_next ? (const char*)g.Bt + (size_t)nxt.pn * tstepB : cB;
        for (int t = 0; t < nt; t += 2) {
            const bool last = (t == nt - 2);
            const char* a1 = cA + (size_t)(t + 1) * kstep;
            const char* a2 = last ? nA : cA + (size_t)(t + 2) * kstep; const char* b2 = last ? nB : cB + (size_t)(t + 2) * kstep;
            const char* a3 = a2 + kstep; const char* b3 = b2 + kstep;
            PG8_LDB(B0, 0, 0); PG8_LDB(B1, 0, 1); PG8_SCHED; PG8_LDA(At, 0, 0); PG8_STAGE(PG8_SA(1, 1), a1 + hstepA, voffA);
            PG8_WAIT_V(8); PG8_WAIT_L(0); PG8_BAR; PG8_MMA(0, 0, At, B0); PG8_MMA(0, 1, At, B1); PG8_BAR; PG8_SCHED;
            PG8_LDA(At, 0, 1); PG8_STAGE(PG8_SB(0, 0), b2, voffB); PG8_STAGE(PG8_SB(0, 1), b2 + hstepB, voffB); PG8_STAGE(PG8_SA(0, 0), a2, voffA);
            PG8_WAIT_V(8); PG8_WAIT_L(0); PG8_BAR; PG8_MMA(1, 0, At, B0); PG8_MMA(1, 1, At, B1); PG8_BAR; PG8_SCHED;
            PG8_LDB(B0, 1, 0); PG8_LDB(B1, 1, 1); PG8_SCHED; PG8_LDA(At, 1, 0); PG8_STAGE(PG8_SA(0, 1), a2 + hstepA, voffA);
            PG8_WAIT_V(8); PG8_WAIT_L(0); PG8_BAR; PG8_MMA(0, 0, At, B0); PG8_MMA(0, 1, At, B1); PG8_BAR; PG8_SCHED;
            PG8_LDA(At, 1, 1); PG8_STAGE(PG8_SB(1, 0), b3, voffB); PG8_STAGE(PG8_SB(1, 1), b3 + hstepB, voffB); PG8_STAGE(PG8_SA(1, 0), a3, voffA);
            PG8_WAIT_V(8); PG8_WAIT_L(0); PG8_BAR; PG8_MMA(1, 0, At, B0); PG8_MMA(1, 1, At, B1); PG8_BAR; PG8_SCHED;
        }
        if (wr == 0) PG8_BAR;
        E(acc, cur, wr, wc, fr, fq);
        if (!has_next) break;
#pragma unroll
        for (int a = 0; a < 2; ++a)
#pragma unroll
            for (int b = 0; b < 2; ++b)
#pragma unroll
                for (int m = 0; m < 4; ++m)
#pragma unroll
                    for (int n = 0; n < 2; ++n) acc[a][b][m][n] = (f32x4){0.f, 0.f, 0.f, 0.f};
        cur = nxt; cA = nA; cB = nB; ++ui;
        if (wr == 1) PG8_BAR;
    }
    PG8_WAIT_V(0);
    PG8_BAR;
#undef PG8_SA
#undef PG8_SB
#undef PG8_STAGE
#undef PG8_LDA
#undef PG8_LDB
#undef PG8_MMA
#undef PG8_WAIT_V
#undef PG8_WAIT_L
#undef PG8_BAR
#undef PG8_SCHED
}

struct EpiProj {
    static constexpr bool PERM = true;
    bf16_t *Gb, *Zb, *Ub, *QKVb, *GTb; const float *rope, *qg, *kg;
    __device__ __forceinline__ void operator()(const f32x4 (&acc)[2][2][4][2], const Unit& u, int wr, int wc, int fr, int fq) const {
        const int pn = u.pn;
        const int row0 = u.pm * BM + wr * 64 + fr;
        if (pn >= 6 && pn <= 8) {
            const bool isq = pn < 8;
            if (!isq && wc >= 2) {
#pragma unroll
                for (int ai = 0; ai < 2; ++ai)
#pragma unroll
                    for (int m = 0; m < 4; ++m) { bf16_t* rowp = QKVb + (size_t)(row0 + ai * HALF + m * 16) * 768 + 640 + (wc - 2) * 64 + 8 * fq;
#pragma unroll
                        for (int bj = 0; bj < 2; ++bj) { const f32x4 v0 = acc[ai][bj][m][0], v1 = acc[ai][bj][m][1];
                            u32x4 w; w.x = cvtpk(v0[0], v0[1]); w.y = cvtpk(v0[2], v0[3]); w.z = cvtpk(v1[0], v1[1]); w.w = cvtpk(v1[2], v1[3]);
                            *(u32x4*)(rowp + bj * 32) = w; } }
            } else {
                const int head = isq ? (pn - 6) * 4 + wc : wc;
                const float* gain = isq ? qg : kg;
                const int cbase = (isq ? 0 : 512) + head * 64 + 4 * fq;
                const float scale = isq ? 0.125f * LOG2E : 1.f;
                const bool dorope = u.pm < (ML / BM);
                const f32x4 g1a = *(const f32x4*)(gain + 4 * fq), g2a = *(const f32x4*)(gain + 16 + 4 * fq), g1b = *(const f32x4*)(gain + 32 + 4 * fq), g2b = *(const f32x4*)(gain + 48 + 4 * fq);
#pragma unroll
                for (int ai = 0; ai < 2; ++ai)
#pragma unroll
                    for (int m = 0; m < 4; ++m) { const int row = row0 + ai * HALF + m * 16;
                        f32x4 x1a = acc[ai][0][m][0], x2a = acc[ai][0][m][1], x1b = acc[ai][1][m][0], x2b = acc[ai][1][m][1];
                        float ss = 0.f;
#pragma unroll
                        for (int e = 0; e < 4; ++e) ss += (x1a[e] * x1a[e] + x2a[e] * x2a[e]) + (x1b[e] * x1b[e] + x2b[e] * x2b[e]);
                        ss += __shfl_xor(ss, 16); ss += __shfl_xor(ss, 32);
                        const float rinv = rsqrtf(ss * (1.f / 64.f) + EPSV);
                        x1a = x1a * rinv * g1a; x2a = x2a * rinv * g2a; x1b = x1b * rinv * g1b; x2b = x2b * rinv * g2b;
                        if (dorope) { const int t = row & (SEQ - 1);
                            const float* ra = rope + ((t >> 6) * 16 + 4 * fq) * 2; const f32x4 a0 = *(const f32x4*)ra, a1 = *(const f32x4*)(ra + 4);
                            const float* rb = rope + ((t & 63) * 16 + 4 * fq) * 2; const f32x4 b0 = *(const f32x4*)rb, b1 = *(const f32x4*)(rb + 4);
                            const f32x4 ca = {a0[0], a0[2], a1[0], a1[2]}, sa = {a0[1], a0[3], a1[1], a1[3]}, cb = {b0[0], b0[2], b1[0], b1[2]}, sb = {b0[1], b0[3], b1[1], b1[3]};
                            const f32x4 y1a = x1a * ca - x2a * sa, y2a = x2a * ca + x1a * sa, y1b = x1b * cb - x2b * sb, y2b = x2b * cb + x1b * sb;
                            x1a = y1a; x2a = y2a; x1b = y1b; x2b = y2b; }
                        x1a = x1a * scale; x2a = x2a * scale; x1b = x1b * scale; x2b = x2b * scale;
                        bf16_t* dp = QKVb + (size_t)row * 768 + cbase;
                        u32x2 w;
                        w.x = cvtpk(x1a[0], x1a[1]); w.y = cvtpk(x1a[2], x1a[3]); *(u32x2*)dp = w;
                        w.x = cvtpk(x2a[0], x2a[1]); w.y = cvtpk(x2a[2], x2a[3]); *(u32x2*)(dp + 16) = w;
                        w.x = cvtpk(x1b[0], x1b[1]); w.y = cvtpk(x1b[2], x1b[3]); *(u32x2*)(dp + 32) = w;
                        w.x = cvtpk(x2b[0], x2b[1]); w.y = cvtpk(x2b[2], x2b[3]); *(u32x2*)(dp + 48) = w; }
            }
            return;
        }
        bf16_t* base; int ld, c0, act;
        if (pn < 2) { base = Gb; ld = 512; c0 = pn * 256; act = 0; }
        else if (pn == 2) { base = Zb; ld = 1024; c0 = 0; act = 1; }
        else if (pn == 3) { base = Ub; ld = 512; c0 = 0; act = 0; }
        else if (pn == 4) { base = Ub; ld = 512; c0 = 256; act = 0; }
        else if (pn == 5) { base = Zb; ld = 1024; c0 = 256; act = 1; }
        else if (pn < 11) { base = Zb; ld = 1024; c0 = 512 + (pn - 9) * 256; act = 1; }
        else { base = GTb; ld = 3072; c0 = (pn - 11) * 256; act = 2; }
        const int col0 = c0 + wc * 32 + 8 * fq;
#pragma unroll
        for (int ai = 0; ai < 2; ++ai)
#pragma unroll
            for (int m = 0; m < 4; ++m) { bf16_t* rowp = base + (size_t)(row0 + ai * HALF + m * 16) * ld + col0;
#pragma unroll
                for (int bj = 0; bj < 2; ++bj) { f32x4 v0 = acc[ai][bj][m][0], v1 = acc[ai][bj][m][1];
                    if (act == 1) {
#pragma unroll
                        for (int e = 0; e < 4; ++e) { v0[e] = silu_f(v0[e]); v1[e] = silu_f(v1[e]); } }
                    else if (act == 2) {
#pragma unroll
                        for (int e = 0; e < 4; ++e) { v0[e] = sigm_f(v0[e]); v1[e] = sigm_f(v1[e]); } }
                    u32x4 w; w.x = cvtpk(v0[0], v0[1]); w.y = cvtpk(v0[2], v0[3]); w.z = cvtpk(v1[0], v1[1]); w.w = cvtpk(v1[2], v1[3]);
                    *(u32x4*)(rowp + bj * HALF) = w; } }
    }
};
struct EpiMerge {
    static constexpr bool PERM = true;
    const bf16_t* GTb; bf16_t* MG; int seg;
    __device__ __forceinline__ void operator()(const f32x4 (&acc)[2][2][4][2], const Unit& u, int wr, int wc, int fr, int fq) const {
        const int row0 = u.pm * BM + wr * 64 + fr, col0 = u.pn * BM + wc * 32 + 8 * fq;
#pragma unroll
        for (int ai = 0; ai < 2; ++ai)
#pragma unroll
            for (int m = 0; m < 4; ++m) { const size_t row = (size_t)(row0 + ai * HALF + m * 16);
#pragma unroll
                for (int bj = 0; bj < 2; ++bj) { const int col = col0 + bj * HALF;
                    const u32x4 gw = *(const u32x4*)(GTb + row * 3072 + seg * 1024 + col);
                    f32x4 v0 = acc[ai][bj][m][0], v1 = acc[ai][bj][m][1];
                    v0[0] *= bflo(gw.x); v0[1] *= bfhi(gw.x); v0[2] *= bflo(gw.y); v0[3] *= bfhi(gw.y);
                    v1[0] *= bflo(gw.z); v1[1] *= bfhi(gw.z); v1[2] *= bflo(gw.w); v1[3] *= bfhi(gw.w);
                    bf16_t* mp = MG + row * 1024 + col;
                    if (seg != 0) { const u32x4 mw = *(const u32x4*)mp;
                        v0[0] += bflo(mw.x); v0[1] += bfhi(mw.x); v0[2] += bflo(mw.y); v0[3] += bfhi(mw.y);
                        v1[0] += bflo(mw.z); v1[1] += bfhi(mw.z); v1[2] += bflo(mw.w); v1[3] += bfhi(mw.w); }
                    u32x4 w; w.x = cvtpk(v0[0], v0[1]); w.y = cvtpk(v0[2], v0[3]); w.z = cvtpk(v1[0], v1[1]); w.w = cvtpk(v1[2], v1[3]);
                    *(u32x4*)mp = w; } }
    }
};
struct EpiRes {
    static constexpr bool PERM = false;
    const float* xsrc; float* xdst; const float* csrc; float* cdst; const float* modl;
    __device__ __forceinline__ void operator()(const f32x4 (&acc)[2][2][4][2], const Unit& u, int wr, int wc, int fr, int fq) const {
        const bool isctx = u.pm >= (ML / BM);
        const int rbase = u.pm * BM + wr * 64 + fr;
        const int bi = isctx ? 4 : (rbase >> 13);
        const float* src = isctx ? csrc + (size_t)(rbase - ML) * DM : xsrc + (size_t)rbase * DM;
        float* dst = isctx ? cdst + (size_t)(rbase - ML) * DM : xdst + (size_t)rbase * DM;
        const int col0 = u.pn * BM + wc * 32 + 4 * fq;
#pragma unroll
        for (int bj = 0; bj < 2; ++bj)
#pragma unroll
            for (int n = 0; n < 2; ++n) { const int col = col0 + bj * HALF + n * 16;
                const f32x4 gt = *(const f32x4*)(modl + bi * 3072 + 2048 + col);
#pragma unroll
                for (int ai = 0; ai < 2; ++ai)
#pragma unroll
                    for (int m = 0; m < 4; ++m) { const size_t off = (size_t)(ai * HALF + m * 16) * DM + col;
                        const f32x4 xs = *(const f32x4*)(src + off);
                        *(f32x4*)(dst + off) = xs + gt * acc[ai][bj][m][n]; } }
    }
};
}

template <int NI, int NJ, int KS>
__device__ __forceinline__ void act_gemm(f32x4 (&acc)[NI][NJ], const LAS unsigned char* act, int RS, int n0, const bf16_t* tab, int ldt, int lane) {
    const int g = lane >> 4, c = lane & 15;
    const LAS unsigned char* abase = act + (8 * g + (c >> 2)) * RS + (n0 + 4 * (c & 3)) * 2;
    const bf16_t* tbase = tab + (size_t)c * ldt + 8 * g;
#pragma unroll 2
    for (int ks = 0; ks < KS; ++ks) {
        bf16x8 a[NI], b[NJ];
#pragma unroll
        for (int i = 0; i < NI; ++i) { const s16x4 lo = lds_tr(abase + ks * 32 * RS + i * 32), hi = lds_tr(abase + (ks * 32 + 4) * RS + i * 32); a[i] = cat8(lo, hi); }
#pragma unroll
        for (int j = 0; j < NJ; ++j) b[j] = *(const bf16x8*)(tbase + (size_t)j * 16 * ldt + ks * 32);
#pragma unroll
        for (int i = 0; i < NI; ++i)
#pragma unroll
            for (int j = 0; j < NJ; ++j) acc[i][j] = __builtin_amdgcn_mfma_f32_16x16x32_bf16(a[i], b[j], acc[i][j], 0, 0, 0);
    }
}
template <int NI, int NJ> __device__ __forceinline__ void zero_acc(f32x4 (&acc)[NI][NJ]) {
#pragma unroll
    for (int i = 0; i < NI; ++i)
#pragma unroll
        for (int j = 0; j < NJ; ++j) acc[i][j] = (f32x4){0.f, 0.f, 0.f, 0.f};
}
__device__ __forceinline__ void mul_store4(bf16_t* p, f32x4 v) {
    const u32x2 z = *(const u32x2*)p;
    u32x2 o; o.x = cvtpk(v[0] * bflo(z.x), v[1] * bfhi(z.x)); o.y = cvtpk(v[2] * bflo(z.y), v[3] * bfhi(z.y));
    *(u32x2*)p = o;
}

struct Params { const float* in[16]; float* out; unsigned char* ws; };

__device__ __forceinline__ void phase0(const Params& p, LAS unsigned char* lds, int tid, int bid, int G) {
    LAS float* sc = (LAS float*)lds;
    LAS float* red = (LAS float*)(lds + 20480);
    for (int i = tid; i < 5120; i += 512) { const float v = i < 4096 ? p.in[1][i] : p.in[3][i - 4096]; sc[i] = v / (1.f + expf(-v)); }
    __syncthreads();
    float* mod = (float*)(p.ws + WS_MOD);
    for (int item = bid; item < 192; item += G) {
        const int l = item / 48, cgp = item % 48, col = tid & 63, kg = tid >> 6, n = cgp * 64 + col;
        const float* w = p.in[4] + ((size_t)l * 1024 + kg * 128) * 3072 + n;
        float a0 = 0.f, a1 = 0.f, a2 = 0.f, a3 = 0.f, a4 = 0.f;
#pragma unroll 8
        for (int k = 0; k < 128; ++k) { const float wv = w[(size_t)k * 3072]; const int kk = kg * 128 + k;
            a0 += sc[kk] * wv; a1 += sc[1024 + kk] * wv; a2 += sc[2048 + kk] * wv; a3 += sc[3072 + kk] * wv; a4 += sc[4096 + kk] * wv; }
        red[(kg * 5 + 0) * 64 + col] = a0; red[(kg * 5 + 1) * 64 + col] = a1; red[(kg * 5 + 2) * 64 + col] = a2; red[(kg * 5 + 3) * 64 + col] = a3; red[(kg * 5 + 4) * 64 + col] = a4;
        __syncthreads();
        if (tid < 320) { const int bi = tid >> 6, c2 = tid & 63; float s = 0.f;
#pragma unroll
            for (int k2 = 0; k2 < 8; ++k2) s += red[(k2 * 5 + bi) * 64 + c2];
            mod[(l * 5 + bi) * 3072 + cgp * 64 + c2] = s + p.in[5][l * 3072 + cgp * 64 + c2]; }
        __syncthreads();
    }
    const int gt = bid * 512 + tid, NT = G * 512;
    float* rope = (float*)(p.ws + WS_ROPE);
    for (int i = gt; i < 2048; i += NT) { const int pos = i >> 4, fi = i & 15; const float inv = powf(10000.f, -(float)fi / 16.f); const float ang = (float)pos * inv; float s, c; sincosf(ang, &s, &c); rope[2 * i] = c; rope[2 * i + 1] = s; }
    bf16_t* t128 = (bf16_t*)(p.ws + WS_T128);
    for (int i = gt; i < 65536; i += NT) { const int m = i >> 8, k = i & 255, part = m >> 7, k1 = m & 127, pp = k >> 7, l1 = k & 127; const int j = (l1 * k1) & 127; float s, c; sincospif((float)j / 64.f, &s, &c);
        const float v = (part == pp) ? c : (part == 0 ? s : -s); t128[i] = (bf16_t)(cvtpk(v, 0.f) & 0xffffu); }
    bf16_t* tc = (bf16_t*)(p.ws + WS_TC);
    for (int i = gt; i < 256 * 512; i += NT) { const int kk = i >> 9, k = i & 511, part = k >> 8, ll = k & 255; const int j = (kk * ll) & 255; float s, c; sincospif((float)j / 128.f, &s, &c);
        const float v = (part ? s : c) * 0.0625f; tc[i] = (bf16_t)(cvtpk(v, 0.f) & 0xffffu); }
    bf16_t* t3 = (bf16_t*)(p.ws + WS_T3);
    for (int i = gt; i < 128 * 64 * 128; i += NT) { const int k1 = i >> 13, k2 = (i >> 7) & 63, kp = i & 127, l2 = kp >> 1, part = kp & 1; const int j = (l2 * (k1 + 128 * k2)) & 8191; float s, c; sincospif((float)j / 4096.f, &s, &c);
        const float v = (part ? s : c) * 0.011048543456039806f; t3[i] = (bf16_t)(cvtpk(v, 0.f) & 0xffffu); }
}

__device__ __forceinline__ void transpose_blk(const float* Wsrc, int ldw, int K, bf16_t* WTdst, int kb, int perm, LAS float* scr, int lane) {
    const int k0 = 64 * kb;
#pragma unroll 8
    for (int i = 0; i < 32; ++i) { const int kk = 2 * i + (lane >> 5); scr[kk * 33 + (lane & 31)] = Wsrc[(size_t)(k0 + kk) * ldw + (lane & 31)]; }
    asm volatile("s_waitcnt lgkmcnt(0)" ::: "memory");
    const int c = lane & 7;
#pragma unroll
    for (int j = 0; j < 4; ++j) { const int n = (lane >> 3) + 8 * j; const int sc = perm ? (16 * ((n >> 2) & 1) + 4 * (n >> 3) + (n & 3)) : n; const LAS float* s = scr + (8 * c) * 33 + sc;
        u32x4 o; o.x = cvtpk(s[0 * 33], s[1 * 33]); o.y = cvtpk(s[2 * 33], s[3 * 33]); o.z = cvtpk(s[4 * 33], s[5 * 33]); o.w = cvtpk(s[6 * 33], s[7 * 33]);
        *(u32x4*)(WTdst + (size_t)n * K + k0 + 8 * c) = o; }
    asm volatile("s_waitcnt lgkmcnt(0)" ::: "memory");
}
__device__ __forceinline__ void phase1(const Params& p, LAS unsigned char* lds, int l, int tid, int lane, int wave, int bid, int G) {
    unsigned char* wsW = p.ws + WS_W;
    bf16_t* WinT = (bf16_t*)(wsW + W_IN_OFF);
    LAS float* scr = (LAS float*)(lds + wave * 8448);
    LAS float* ctab = (LAS float*)(lds + 8 * 8448);
    if (tid < 64) { float s, c; sincospif((float)tid / 32.f, &s, &c); ctab[tid] = c * 0.125f; ctab[64 + tid] = s * 0.125f; }
    __syncthreads();
    const int gw = bid * 8 + wave, NGW = G * 8;
    const float* win = p.in[6] + (size_t)l * 1024 * INW;
    constexpr int I_IN = 16 * 168, I_PA = 4 * 32, I_PC = 8 * 32, I_OUT = 16 * 32;
    for (int it = gw; it < I_IN + 2 * I_PA + I_PC + I_OUT; it += NGW) {
        int r = it;
        if (r < I_IN) { const int rb = 16 + r % 168, kb = r / 168, n = rb * 32; int c0, perm = 0;
            if (n < 1536 || n >= 2304) c0 = n - 256;
            else if (n < 2048) { const int t = n - 1536, tile = t >> 8, tt = t & 255, bj = tt >> 7, wc = (tt >> 5) & 3; c0 = 1280 + (tile * 4 + wc) * 64 + 32 * bj; perm = 1; }
            else { const int tt = n - 2048, bj = tt >> 7, wc = (tt >> 5) & 3; if (wc < 2) { c0 = 1792 + wc * 64 + 32 * bj; perm = 1; } else c0 = 1920 + (wc - 2) * 64 + 32 * bj; }
            transpose_blk(win + c0, INW, 1024, WinT + (size_t)n * 1024, kb, perm, scr, lane); continue; } r -= I_IN;
        if (r < I_PA) { transpose_blk(p.in[12] + (size_t)l * 256 * 1024 + 32 * (r & 31), 1024, 256, (bf16_t*)(wsW + W_PA_OFF) + (size_t)32 * (r & 31) * 256, r >> 5, 0, scr, lane); continue; } r -= I_PA;
        if (r < I_PA) { transpose_blk(p.in[13] + (size_t)l * 256 * 1024 + 32 * (r & 31), 1024, 256, (bf16_t*)(wsW + W_PB_OFF) + (size_t)32 * (r & 31) * 256, r >> 5, 0, scr, lane); continue; } r -= I_PA;
        if (r < I_PC) { transpose_blk(p.in[14] + (size_t)l * 512 * 1024 + 32 * (r & 31), 1024, 512, (bf16_t*)(wsW + W_PC_OFF) + (size_t)32 * (r & 31) * 512, r >> 5, 0, scr, lane); continue; } r -= I_PC;
        transpose_blk(p.in[15] + (size_t)l * 1024 * 1024 + 32 * (r & 31), 1024, 1024, (bf16_t*)(wsW + W_OUT_OFF) + (size_t)32 * (r & 31) * 1024, r >> 5, 0, scr, lane);
    }
    const int gtid = (G - 1 - bid) * 512 + tid, NT = G * 512;
    for (int id = gtid; id < 65536; id += NT) {
        const int n = id >> 7, ko = id & 127, part = n >> 8, grp = (n >> 6) & 3, m = n & 63;
        const LAS float* tb = ctab + part * 64;
        const float* wrow = win + (size_t)(ko * 8) * INW + grp * 64;
        float a[8];
#pragma unroll
        for (int j = 0; j < 8; ++j) a[j] = 0.f;
#pragma unroll 4
        for (int c4 = 0; c4 < 16; ++c4) {
            const float t0 = tb[(m * (4 * c4)) & 63], t1 = tb[(m * (4 * c4 + 1)) & 63], t2 = tb[(m * (4 * c4 + 2)) & 63], t3 = tb[(m * (4 * c4 + 3)) & 63];
#pragma unroll
            for (int j = 0; j < 8; ++j) { const f32x4 wv = *(const f32x4*)(wrow + (size_t)j * INW + c4 * 4); a[j] += wv[0] * t0 + wv[1] * t1 + wv[2] * t2 + wv[3] * t3; }
        }
        const float sg = part ? -1.f : 1.f;
        u32x4 o; o.x = cvtpk(sg * a[0], sg * a[1]); o.y = cvtpk(sg * a[2], sg * a[3]); o.z = cvtpk(sg * a[4], sg * a[5]); o.w = cvtpk(sg * a[6], sg * a[7]);
        *(u32x4*)(WinT + (size_t)n * 1024 + ko * 8) = o;
    }
    { const float* sw = p.in[7] + (size_t)l * 65536; bf16_t* dw = (bf16_t*)(p.ws + WS_SGUW);
      for (int id = gtid; id < 8192; id += NT) { const f32x4 v0 = *(const f32x4*)(sw + id * 8), v1 = *(const f32x4*)(sw + id * 8 + 4);
          u32x4 o; o.x = cvtpk(v0[0], v0[1]); o.y = cvtpk(v0[2], v0[3]); o.z = cvtpk(v1[0], v1[1]); o.w = cvtpk(v1[2], v1[3]); *(u32x4*)(dw + id * 8) = o; } }
    const float* xs = l == 0 ? p.in[0] : p.out;
    const float* cs = l == 0 ? p.in[2] : (const float*)(p.ws + WS_XC);
    const float* mod = (const float*)(p.ws + WS_MOD) + (size_t)l * 5 * 3072;
    bf16_t* H = (bf16_t*)(p.ws + WS_H);
    for (int row = gw; row < MT; row += NGW) {
        const float* src = row < ML ? xs + (size_t)row * DM : cs + (size_t)(row - ML) * DM;
        const int bi = row < ML ? (row >> 13) : 4;
        const float* md = mod + bi * 3072;
        f32x4 v[4]; float ss = 0.f;
#pragma unroll
        for (int j = 0; j < 4; ++j) { v[j] = *(const f32x4*)(src + 4 * lane + 256 * j); ss += (v[j][0] * v[j][0] + v[j][1] * v[j][1]) + (v[j][2] * v[j][2] + v[j][3] * v[j][3]); }
#pragma unroll
        for (int o = 1; o < 64; o <<= 1) ss += __shfl_xor(ss, o);
        const float rinv = rsqrtf(ss * (1.f / 1024.f) + EPSV);
#pragma unroll
        for (int j = 0; j < 4; ++j) { const int idx = 4 * lane + 256 * j; const f32x4 sh = *(const f32x4*)(md + idx), scl = *(const f32x4*)(md + 1024 + idx);
            const f32x4 o = v[j] * rinv * (scl + 1.f) + sh; u32x2 w; w.x = cvtpk(o[0], o[1]); w.y = cvtpk(o[2], o[3]); *(u32x2*)(H + (size_t)row * DM + idx) = w; }
    }
}

__device__ __forceinline__ void attn_item(LAS unsigned char* lds, const bf16_t* QKV, bf16_t* Z, const float* sinkl,
                                          int b, int blk, int kvh, int hp, bool isctx, int tid, int lane, int wave) {
    constexpr int RS = 144;
    LAS unsigned char* Qs = lds; LAS unsigned char* Ks = lds + 256 * RS; LAS unsigned char* Vs = Ks + 128 * RS;
    const int qrow0 = isctx ? (ML + b * 256 + blk * 128) : (b * SEQ + blk * 128);
    __syncthreads();
#pragma unroll
    for (int it = 0; it < 4; ++it) { const int id = it * 512 + tid, r = id >> 3, c16 = id & 7, hl = r >> 7, tq = r & 127;
        *(LAS u32x4*)(Qs + r * RS + c16 * 16) = *(const u32x4*)(QKV + (size_t)(qrow0 + tq) * 768 + (kvh * 4 + hp * 2 + hl) * 64 + c16 * 8); }
    const int hl = wave >> 2, qq = wave & 3, gq = hp * 2 + hl, g = lane >> 4, c = lane & 15;
    const LAS unsigned char* qbase = Qs + (hl * 128 + qq * 32 + c) * RS + 16 * g;
    f32x4 O[4][2]; float m_run[2], l_run[2];
    const float sinkv = sinkl[kvh * 4 + gq] * LOG2E;
#pragma unroll
    for (int qi = 0; qi < 2; ++qi) { m_run[qi] = sinkv; l_run[qi] = (g == 0) ? 1.f : 0.f;
#pragma unroll
        for (int df = 0; df < 4; ++df) O[df][qi] = (f32x4){0.f, 0.f, 0.f, 0.f}; }
    const LAS unsigned char* vbase = Vs + (4 * g + (c >> 2)) * RS + (4 * (c & 3)) * 2;
#pragma unroll 1
    for (int ti = 0; ti < 5; ++ti) {
        int krow0;
        if (ti < 3) { if (isctx) continue; if (ti == 0) { if (blk == 0) continue; krow0 = qrow0 - 128; } else if (ti == 1) krow0 = qrow0; else { if (blk == 63) continue; krow0 = qrow0 + 128; } }
        else krow0 = ML + b * 256 + (ti - 3) * 128;
        __syncthreads();
#pragma unroll
        for (int it = 0; it < 2; ++it) { const int id = tid + 512 * it, r = id >> 3, c16 = id & 7; const bf16_t* src = QKV + (size_t)(krow0 + r) * 768 + 512 + kvh * 64 + c16 * 8;
            *(LAS u32x4*)(Ks + r * RS + c16 * 16) = *(const u32x4*)src;
            *(LAS u32x4*)(Vs + r * RS + c16 * 16) = *(const u32x4*)(src + 128); }
        __syncthreads();
#pragma unroll
        for (int qi = 0; qi < 2; ++qi) {
            asm volatile("" ::: "memory"); __builtin_amdgcn_sched_barrier(0);
            f32x4 s[8];
            const bf16x8 qf0 = *(const LAS bf16x8*)(qbase + (16 * qi) * RS), qf1 = *(const LAS bf16x8*)(qbase + (16 * qi) * RS + 64);
#pragma unroll
            for (int kf = 0; kf < 8; ++kf) { const LAS unsigned char* kp = Ks + (16 * kf + c) * RS + 16 * g;
                const bf16x8 k0 = *(const LAS bf16x8*)kp, k1 = *(const LAS bf16x8*)(kp + 64);
                s[kf] = __builtin_amdgcn_mfma_f32_16x16x32_bf16(k0, qf0, (f32x4){0.f, 0.f, 0.f, 0.f}, 0, 0, 0);
                s[kf] = __builtin_amdgcn_mfma_f32_16x16x32_bf16(k1, qf1, s[kf], 0, 0, 0); }
            if (ti == 0 || ti == 2) { int qidx = qq * 32 + 16 * qi + c; asm volatile("" : "+v"(qidx));
#pragma unroll
                for (int kf = 0; kf < 8; ++kf)
#pragma unroll
                    for (int r = 0; r < 4; ++r) { const int key = 16 * kf + 4 * g + r; const bool valid = (ti == 0) ? (key >= qidx) : (key <= qidx); if (!valid) s[kf][r] = -1e30f; } }
            float mx = s[0][0];
#pragma unroll
            for (int kf = 0; kf < 8; ++kf)
#pragma unroll
                for (int r = 0; r < 4; ++r) mx = fmaxf(mx, s[kf][r]);
            mx = fmaxf(mx, __shfl_xor(mx, 16)); mx = fmaxf(mx, __shfl_xor(mx, 32));
            const float mnew = fmaxf(m_run[qi], mx), alpha = __builtin_amdgcn_exp2f(m_run[qi] - mnew); m_run[qi] = mnew;
            float psum = 0.f;
#pragma unroll
            for (int kf = 0; kf < 8; ++kf)
#pragma unroll
                for (int r = 0; r < 4; ++r) { const float pv = __builtin_amdgcn_exp2f(s[kf][r] - mnew); s[kf][r] = pv; psum += pv; }
            l_run[qi] = l_run[qi] * alpha + psum;
#pragma unroll
            for (int df = 0; df < 4; ++df) O[df][qi] *= alpha;
#pragma unroll
            for (int ks = 0; ks < 4; ++ks) {
                u32x4 pw; pw.x = cvtpk(s[2 * ks][0], s[2 * ks][1]); pw.y = cvtpk(s[2 * ks][2], s[2 * ks][3]); pw.z = cvtpk(s[2 * ks + 1][0], s[2 * ks + 1][1]); pw.w = cvtpk(s[2 * ks + 1][2], s[2 * ks + 1][3]);
                const bf16x8 pf = __builtin_bit_cast(bf16x8, pw);
#pragma unroll
                for (int df = 0; df < 4; ++df) { const LAS unsigned char* vp = vbase + (ks * 32) * RS + df * 32;
                    const bf16x8 vf = cat8(lds_tr(vp), lds_tr(vp + 16 * RS));
                    O[df][qi] = __builtin_amdgcn_mfma_f32_16x16x32_bf16(vf, pf, O[df][qi], 0, 0, 0); }
            }
        }
    }
#pragma unroll
    for (int qi = 0; qi < 2; ++qi) { float lt = l_run[qi]; lt += __shfl_xor(lt, 16); lt += __shfl_xor(lt, 32); const float inv = 1.f / lt;
        const size_t row = (size_t)(qrow0 + qq * 32 + 16 * qi + c);
#pragma unroll
        for (int df = 0; df < 4; ++df) mul_store4(Z + row * 1024 + 512 + (kvh * 4 + gq) * 64 + 16 * df + 4 * g, O[df][qi] * inv); }
}

__device__ __forceinline__ void f1_item(LAS unsigned char* lds, const bf16_t* Gb, bf16_t* Afft, const bf16_t* t128, int b, int l2, int tid, int lane, int wave) {
    constexpr int RS = 528;
    __syncthreads();
#pragma unroll 4
    for (int it = 0; it < 16; ++it) { const int id = it * 512 + tid, row = id >> 5, c16 = id & 31, pp = row >> 7, l1 = row & 127;
        *(LAS u32x4*)(lds + row * RS + c16 * 16) = *(const u32x4*)(Gb + (size_t)(b * SEQ + 64 * l1 + l2) * 512 + pp * 256 + c16 * 8); }
    __syncthreads();
    const int g = lane >> 4, c = lane & 15;
    for (int mh = 0; mh < 2; ++mh) {
        f32x4 acc[2][8]; zero_acc<2, 8>(acc);
        act_gemm<2, 8, 8>(acc, lds, RS, 32 * wave, t128 + (size_t)(mh * 128) * 256, 256, lane);
#pragma unroll
        for (int i = 0; i < 2; ++i)
#pragma unroll
            for (int j = 0; j < 8; ++j) { const int k1 = 16 * j + c, ch = 32 * wave + 16 * i + 4 * g; const size_t arow = ((size_t)(b * 128 + k1) * 64 + l2) * 2 + mh;
                u32x2 o; o.x = cvtpk(acc[i][j][0], acc[i][j][1]); o.y = cvtpk(acc[i][j][2], acc[i][j][3]); *(u32x2*)(Afft + arow * 256 + ch) = o; }
    }
}
__device__ __forceinline__ void sgu_item(LAS unsigned char* lds, const bf16_t* Ub, bf16_t* Z, const bf16_t* sguw, const float* sgub, int ci, int tid, int lane, int wave) {
    constexpr int RS = 528;
    const int row0 = ci * 128;
    __syncthreads();
    { const int t = tid >> 2, qd = tid & 3; const bf16_t* vp = Ub + (size_t)(row0 + t) * 512 + 256 + qd * 64;
      u32x4 w[8]; float ss = 0.f;
#pragma unroll
      for (int i = 0; i < 8; ++i) { w[i] = *(const u32x4*)(vp + 8 * i);
          const float a0 = bflo(w[i].x), a1 = bfhi(w[i].x), a2 = bflo(w[i].y), a3 = bfhi(w[i].y), a4 = bflo(w[i].z), a5 = bfhi(w[i].z), a6 = bflo(w[i].w), a7 = bfhi(w[i].w);
          ss += (a0 * a0 + a1 * a1) + (a2 * a2 + a3 * a3) + (a4 * a4 + a5 * a5) + (a6 * a6 + a7 * a7); }
      ss += __shfl_xor(ss, 1); ss += __shfl_xor(ss, 2);
      const float rinv = rsqrtf(ss * (1.f / 256.f) + EPSV);
#pragma unroll
      for (int i = 0; i < 8; ++i) { u32x4 o; o.x = cvtpk(bflo(w[i].x) * rinv, bfhi(w[i].x) * rinv); o.y = cvtpk(bflo(w[i].y) * rinv, bfhi(w[i].y) * rinv); o.z = cvtpk(bflo(w[i].z) * rinv, bfhi(w[i].z) * rinv); o.w = cvtpk(bflo(w[i].w) * rinv, bfhi(w[i].w) * rinv);
          *(LAS u32x4*)(lds + t * RS + qd * 128 + i * 16) = o; } }
    __syncthreads();
    const int grp = wave >> 1, sh = wave & 1, g = lane >> 4, c = lane & 15;
    f32x4 acc[4][4]; zero_acc<4, 4>(acc);
    act_gemm<4, 4, 4>(acc, lds, RS, grp * 64, sguw + (size_t)grp * 16384 + (size_t)(sh * 64) * 128, 128, lane);
#pragma unroll
    for (int j = 0; j < 4; ++j) { const int s = sh * 64 + 16 * j + c; const float bias = sgub[grp * 128 + s]; const size_t row = (size_t)(row0 + s);
#pragma unroll
        for (int i = 0; i < 4; ++i) { const int col = grp * 64 + 16 * i + 4 * g; const u32x2 uw = *(const u32x2*)(Ub + row * 512 + col);
            f32x4 v = acc[i][j]; v[0] = (v[0] + bias) * bflo(uw.x); v[1] = (v[1] + bias) * bfhi(uw.x); v[2] = (v[2] + bias) * bflo(uw.y); v[3] = (v[3] + bias) * bfhi(uw.y);
            mul_store4(Z + row * 1024 + 256 + col, v); } }
}
__device__ __forceinline__ void f3_item(LAS unsigned char* lds, const bf16_t* Afft, bf16_t* Z, const bf16_t* t3, int b, int k1, int tid, int lane, int wave) {
    constexpr int RS = 528;
    __syncthreads();
    const bf16_t* src = Afft + (size_t)(b * 128 + k1) * 128 * 256;
#pragma unroll 4
    for (int it = 0; it < 8; ++it) { const int id = it * 512 + tid, row = id >> 5, c16 = id & 31;
        *(LAS u32x4*)(lds + row * RS + c16 * 16) = *(const u32x4*)(src + (size_t)row * 256 + c16 * 8); }
    __syncthreads();
    const int g = lane >> 4, c = lane & 15;
    f32x4 acc[2][4]; zero_acc<2, 4>(acc);
    act_gemm<2, 4, 4>(acc, lds, RS, 32 * wave, t3 + (size_t)k1 * 64 * 128, 128, lane);
#pragma unroll
    for (int j = 0; j < 4; ++j) { const int k2 = 16 * j + c; const size_t row = (size_t)b * SEQ + k1 + 128 * k2;
#pragma unroll
        for (int i = 0; i < 2; ++i) mul_store4(Z + row * 1024 + 32 * wave + 16 * i + 4 * g, acc[i][j]); }
}
__device__ __forceinline__ void fc_item(LAS unsigned char* lds, const bf16_t* Gb, bf16_t* Z, const bf16_t* tc, int b, int hh, int tid, int lane, int wave) {
    constexpr int RS = 272;
    __syncthreads();
#pragma unroll 4
    for (int it = 0; it < 16; ++it) { const int id = it * 512 + tid, row = id >> 4, c16 = id & 15, part = row >> 8, ll = row & 255;
        *(LAS u32x4*)(lds + row * RS + c16 * 16) = *(const u32x4*)(Gb + (size_t)(ML + b * 256 + ll) * 512 + part * 256 + hh * 128 + c16 * 8); }
    __syncthreads();
    const int g = lane >> 4, c = lane & 15;
    f32x4 acc[1][16]; zero_acc<1, 16>(acc);
    act_gemm<1, 16, 16>(acc, lds, RS, 16 * wave, tc, 512, lane);
#pragma unroll
    for (int j = 0; j < 16; ++j) { const size_t row = (size_t)(ML + b * 256 + 16 * j + c); mul_store4(Z + row * 1024 + hh * 128 + 16 * wave + 4 * g, acc[0][j]); }
}

#define PHASE_IDS() int t__ = threadIdx.x, b__ = blockIdx.x, g__ = gridDim.x; asm volatile("" : "+v"(t__)); asm volatile("" : "+s"(b__), "+s"(g__)); \
    unsigned char* ws = p.ws; asm volatile("" : "+s"(ws)); \
    const int tid = t__, lane = tid & 63, wave = __builtin_amdgcn_readfirstlane(tid >> 6), bid = b__, G = g__; (void)lane; (void)wave; (void)bid; (void)G
__global__ void __launch_bounds__(512, 2) fwd_megakernel(Params p) {
    extern __shared__ __attribute__((aligned(16))) unsigned char lds_raw[];
    LAS unsigned char* lds = (LAS unsigned char*)lds_raw;
    cg::grid_group grid = cg::this_grid();
#ifndef SKIP_P0
    { PHASE_IDS(); phase0(p, lds, tid, bid, G); }
#endif
    grid.sync();
#pragma unroll 1
    for (int l = 0; l < DEPTH; ++l) {
        const bool last = (l == DEPTH - 1);
#ifndef SKIP_P1
        { PHASE_IDS(); phase1(p, lds, l, tid, lane, wave, bid, G); }
#endif
        grid.sync();
#ifndef SKIP_P2
        { PHASE_IDS();
          pg8::Gemm g{(const bf16_t*)(ws + WS_H), (const bf16_t*)(ws + WS_W + W_IN_OFF), MT, NIN, 1024, 1024}; pg8::StaticOrder S; S.init(MT, NIN, G, bid);
          pg8::EpiProj E{(bf16_t*)(ws + WS_G), (bf16_t*)(ws + WS_Z), (bf16_t*)(ws + WS_U), (bf16_t*)(ws + WS_QKV), (bf16_t*)(ws + WS_GT), (const float*)(ws + WS_ROPE), p.in[9] + l * 64, p.in[10] + l * 64};
          pg8::gemm_phase<pg8::EpiProj>(lds, g, S, E, tid); }
#endif
        grid.sync();
#ifndef SKIP_P3
        { PHASE_IDS();
          bf16_t* Zb = (bf16_t*)(ws + WS_Z); const bf16_t* QKVb = (const bf16_t*)(ws + WS_QKV);
          const int n_attn = last ? 1024 : 1056, n_f1 = 256, n_sgu = last ? 256 : 264, total = n_attn + n_f1 + n_sgu;
          const float* sinkl = p.in[11] + l * 8; const float* sgub = p.in[8] + l * 512;
          for (int item = bid; item < total; item += G) {
              if (item < n_attn) { const bool ic = item >= 1024; const int i2 = item - 1024;
                                   attn_item(lds, QKVb, Zb, sinkl, ic ? (i2 >> 3) : (item >> 8), ic ? ((i2 >> 2) & 1) : ((item >> 2) & 63), (item >> 1) & 1, item & 1, ic, tid, lane, wave); }
              else if (item < n_attn + n_f1) { const int i2 = item - n_attn; f1_item(lds, (const bf16_t*)(ws + WS_G), (bf16_t*)(ws + WS_H), (const bf16_t*)(ws + WS_T128), i2 >> 6, i2 & 63, tid, lane, wave); }
              else { sgu_item(lds, (const bf16_t*)(ws + WS_U), Zb, (const bf16_t*)(ws + WS_SGUW), sgub, item - n_attn - n_f1, tid, lane, wave); }
          } }
#endif
        grid.sync();
#ifndef SKIP_P4
        { PHASE_IDS();
          bf16_t* Zb = (bf16_t*)(ws + WS_Z);
          const int total = last ? 512 : 520;
          for (int item = bid; item < total; item += G) {
              if (item < 512) f3_item(lds, (const bf16_t*)(ws + WS_H), Zb, (const bf16_t*)(ws + WS_T3), item >> 7, item & 127, tid, lane, wave);
              else { const int i2 = item - 512; fc_item(lds, (const bf16_t*)(ws + WS_G), Zb, (const bf16_t*)(ws + WS_TC), i2 >> 1, i2 & 1, tid, lane, wave); }
          } }
#endif
        grid.sync();
#ifndef SKIP_P5
#pragma unroll 1
        for (int seg = 0; seg < 3; ++seg) { PHASE_IDS();
          const int Mrows = last ? ML : MT; pg8::StaticOrder S; S.init(Mrows, 1024, G, bid);
          const bf16_t* Zb = (const bf16_t*)(ws + WS_Z);
          const size_t woff = seg == 0 ? W_PA_OFF : (seg == 1 ? W_PB_OFF : W_PC_OFF);
          pg8::Gemm g{Zb + seg * 256, (const bf16_t*)(ws + WS_W + woff), Mrows, 1024, seg == 2 ? 512 : 256, 1024};
          pg8::EpiMerge E{(const bf16_t*)(ws + WS_GT), (bf16_t*)(ws + WS_H), seg};
          pg8::gemm_phase<pg8::EpiMerge>(lds, g, S, E, tid); }
#endif
        grid.sync();
#ifndef SKIP_P6
        { PHASE_IDS();
          const int Mrows = last ? ML : MT; pg8::StaticOrder S; S.init(Mrows, 1024, G, bid);
          pg8::Gemm g{(const bf16_t*)(ws + WS_H), (const bf16_t*)(ws + WS_W + W_OUT_OFF), Mrows, 1024, 1024, 1024};
          float* XC = (float*)(ws + WS_XC);
          pg8::EpiRes E{l == 0 ? p.in[0] : p.out, p.out, l == 0 ? p.in[2] : XC, XC, (const float*)(ws + WS_MOD) + (size_t)l * 5 * 3072};
          pg8::gemm_phase<pg8::EpiRes>(lds, g, S, E, tid); }
#endif
        if (!last) grid.sync();
    }
}

extern "C" void kernel_launch(void* const* d_in, const int* in_sizes, int n_in, void* d_out, int out_size, void* d_ws, size_t ws_size, hipStream_t stream) {
    static int grid = 0;
    if (grid == 0) {
        if (n_in != 16 || ws_size < WS_END) { fprintf(stderr, "kernel_launch: unexpected inputs (n_in %d, ws %zu)\n", n_in, ws_size); grid = -1; return; }
        int dev = 0, cus = 0, per_cu = 0;
        hipGetDevice(&dev);
        hipDeviceGetAttribute(&cus, hipDeviceAttributeMultiprocessorCount, dev);
        hipFuncSetAttribute((const void*)fwd_megakernel, hipFuncAttributeMaxDynamicSharedMemorySize, LDS_BYTES);
        hipOccupancyMaxActiveBlocksPerMultiprocessor(&per_cu, (const void*)fwd_megakernel, 512, LDS_BYTES);
        if (per_cu < 1 || cus < 1) { fprintf(stderr, "kernel_launch: occupancy query gave %d blocks/CU on %d CUs\n", per_cu, cus); grid = -1; return; }
        grid = cus;
    }
    if (grid < 0) return;
    Params p{};
    for (int i = 0; i < 16; ++i) p.in[i] = (const float*)d_in[i];
    p.out = (float*)d_out; p.ws = (unsigned char*)d_ws;
    void* args[] = {&p};
    hipError_t e = hipLaunchCooperativeKernel((const void*)fwd_megakernel, dim3(grid), dim3(512), args, LDS_BYTES, stream);
    if (e != hipSuccess) fprintf(stderr, "cooperative launch failed: %s (grid %d)\n", hipGetErrorString(e), grid);
}
```

```cpp
#include <hip/hip_runtime.h>
#include <hip/hip_cooperative_groups.h>
#include <cstdio>
#include <cstdint>
namespace cg = cooperative_groups;

#define LAS __attribute__((address_space(3)))
typedef unsigned short bf16_t;
typedef short bf16x8 __attribute__((ext_vector_type(8)));
typedef short s16x4 __attribute__((ext_vector_type(4)));
typedef float f32x4 __attribute__((ext_vector_type(4)));
typedef unsigned u32x4 __attribute__((ext_vector_type(4)));
typedef unsigned u32x2 __attribute__((ext_vector_type(2)));
typedef float f32x2_t __attribute__((ext_vector_type(2)));
typedef __bf16 bf16x2_t __attribute__((ext_vector_type(2)));

constexpr int DM = 1024, NB = 4, SEQ = 8192, DEPTH = 4, CTXL = 256;
constexpr int ML = NB * SEQ;
constexpr int MC = NB * CTXL;
constexpr int MT = ML + MC;
constexpr int INW = 5632;
constexpr int NIN = 5888;
constexpr float EPSV = 1e-6f;
constexpr float LOG2E = 1.4426950408889634f;

constexpr size_t MiB = 1u << 20;
constexpr size_t WS_MOD = 0;
constexpr size_t WS_ROPE = 256 * 1024;
constexpr size_t WS_T128 = 512 * 1024;
constexpr size_t WS_TC = 1 * MiB;
constexpr size_t WS_T3 = 2 * MiB;
constexpr size_t WS_SGUW = 4 * MiB;
constexpr size_t WS_BAR = 6 * MiB;
constexpr size_t WS_XC = 8 * MiB;
constexpr size_t WS_W = 16 * MiB;
constexpr size_t W_IN_OFF = 0, W_PA_OFF = (size_t)NIN * 1024 * 2, W_PB_OFF = W_PA_OFF + 1024 * 256 * 2, W_PC_OFF = W_PB_OFF + 1024 * 256 * 2, W_OUT_OFF = W_PC_OFF + 1024 * 512 * 2;
constexpr size_t WS_H = 32 * MiB;
constexpr size_t WS_G = 98 * MiB;
constexpr size_t WS_Z = 131 * MiB;
constexpr size_t WS_U = 197 * MiB;
constexpr size_t WS_QKV = 230 * MiB;
constexpr size_t WS_GT = 280 * MiB;
constexpr size_t WS_END = 478 * MiB;
static_assert(W_OUT_OFF + 1024 * 1024 * 2 <= 16 * MiB, "weights fit");

constexpr int LDS_BYTES = 147456;
#ifndef PROBE_DUP
#define PROBE_DUP 0
#endif

__device__ __forceinline__ unsigned cvtpk(float lo, float hi) { f32x2_t v = {lo, hi}; bf16x2_t b = __builtin_convertvector(v, bf16x2_t); return __builtin_bit_cast(unsigned, b); }
__device__ __forceinline__ float bflo(unsigned w) { return __uint_as_float(w << 16); }
__device__ __forceinline__ float bfhi(unsigned w) { return __uint_as_float(w & 0xffff0000u); }
__device__ __forceinline__ float silu_f(float v) { return v * __builtin_amdgcn_rcpf(1.f + __expf(-v)); }
__device__ __forceinline__ float sigm_f(float v) { return __builtin_amdgcn_rcpf(1.f + __expf(-v)); }
typedef short v4i16_t __attribute__((ext_vector_type(4)));
__device__ __forceinline__ s16x4 lds_tr(const LAS unsigned char* p) { return __builtin_bit_cast(s16x4, __builtin_amdgcn_ds_read_tr16_b64_v4i16((LAS v4i16_t*)p)); }
__device__ __forceinline__ bf16x8 cat8(s16x4 a, s16x4 b) { return (bf16x8){a[0], a[1], a[2], a[3], b[0], b[1], b[2], b[3]}; }

namespace pg8 {
constexpr int BM = 256, BK = 64, HALF = 128, HTB = HALF * BK * 2, STAGE_BYTES = 8 * HTB, NXCD = 8, WGM = 8;
__host__ __device__ __forceinline__ int lds_byte(int r, int c) { const int st = (r >> 4) * 2 + (c >> 5), rr = r & 15, cc = c & 31, ob = rr * 64 + cc * 2; return st * 1024 + (ob ^ (((ob >> 9) & 1) << 5)); }
__host__ __device__ __forceinline__ void stage_rc(int b, int& R, int& C) { const int st = b / 1024, sb = b % 1024, swz = sb ^ (((sb >> 9) & 1) << 5); R = (st >> 1) * 16 + swz / 64; C = (st & 1) * 32 + (swz % 64) / 2; }
__host__ __device__ __forceinline__ int perm32(int rho) { const int n = rho >> 4, i = rho & 15; return 8 * (i >> 2) + 4 * n + (i & 3); }
struct Unit { int pm, pn; };
struct Gemm { const bf16_t* A; const bf16_t* Bt; int M, N, K, lda; };
struct StaticOrder {
    int nM, nN, nwg, G, c;
    __host__ __device__ void init(int M, int N, int G_, int c_) { nM = M / BM; nN = N / BM; nwg = nM * nN; G = G_; c = c_; }
    __host__ __device__ bool next(int i, Unit& u) const {
        const long L = (long)i * G + c; if (L >= nwg) return false;
        int wgid = (int)L; { const int q = nwg / NXCD, r = nwg % NXCD, xcd = wgid % NXCD, off = wgid / NXCD; wgid = (xcd < r ? xcd * (q + 1) : r * (q + 1) + (xcd - r) * q) + off; }
        const int nig = WGM * nN, gid = wgid / nig, fm = gid * WGM, gsz = (nM - fm) < WGM ? (nM - fm) : WGM;
        u.pm = fm + ((wgid % nig) % gsz); u.pn = (wgid % nig) / gsz; return true;
    }
};
template <class Epi>
__device__ __forceinline__ void gemm_phase(LAS unsigned char* lds, const Gemm g, const StaticOrder& S, const Epi& E, const int tid) {
    const int wid = __builtin_amdgcn_readfirstlane(tid >> 6), lane = tid & 63, wr = wid >> 2, wc = wid & 3, fr = lane & 15, fq = lane >> 4;
    const int K = g.K, nt = K / BK, lda = g.lda;
    unsigned voffA[2], voffB[2];
#pragma unroll
    for (int i = 0; i < 2; ++i) { int R, C; stage_rc(tid * 16 + i * 8192, R, C); const int Rb = Epi::PERM ? ((R & ~31) + perm32(R & 31)) : R;
        voffA[i] = (unsigned)(R * lda + C) * 2u; voffB[i] = (unsigned)(Rb * K + C) * 2u; }
    const size_t kstep = (size_t)(BK * 2);
    const size_t hstepA = (size_t)HALF * lda * 2, hstepB = (size_t)HALF * K * 2;
    const size_t tstepA = 2 * hstepA, tstepB = 2 * hstepB;
    const unsigned ldsw = (unsigned)wid * 1024u;
    const int aoff = lds_byte(wr * 64 + fr, fq * 8), boff = lds_byte(wc * 32 + fr, fq * 8);
#define PG8_SA(b, h) (((b) * 2 + (h)) * HTB)
#define PG8_SB(b, h) ((4 + (b) * 2 + (h)) * HTB)
#define PG8_STAGE(bufoff, gbase, voff) do { _Pragma("unroll") for (int _i = 0; _i < 2; ++_i) \
        __builtin_amdgcn_global_load_lds((const unsigned*)((const char*)(gbase) + (voff)[_i]), (LAS unsigned*)(lds + (bufoff) + ldsw + _i * 8192), 16, 0, 0); } while (0)
#define PG8_LDA(dst, b, h) do { _Pragma("unroll") for (int m = 0; m < 4; ++m) _Pragma("unroll") for (int k = 0; k < 2; ++k) dst[m][k] = *(const LAS bf16x8*)(lds + PG8_SA(b, h) + aoff + m * 2048 + k * 1024); } while (0)
#define PG8_LDB(dst, b, h) do { _Pragma("unroll") for (int n = 0; n < 2; ++n) _Pragma("unroll") for (int k = 0; k < 2; ++k) dst[n][k] = *(const LAS bf16x8*)(lds + PG8_SB(b, h) + boff + n * 2048 + k * 1024); } while (0)
#define PG8_MMA(ai, bj, At, Bt) do { __builtin_amdgcn_s_setprio(1); _Pragma("unroll") for (int m = 0; m < 4; ++m) _Pragma("unroll") for (int n = 0; n < 2; ++n) _Pragma("unroll") for (int k = 0; k < 2; ++k) \
        acc[ai][bj][m][n] = __builtin_amdgcn_mfma_f32_16x16x32_bf16(Bt[n][k], At[m][k], acc[ai][bj][m][n], 0, 0, 0); __builtin_amdgcn_s_setprio(0); } while (0)
#define PG8_WAIT_V(n) asm volatile("s_waitcnt vmcnt(" #n ")" ::: "memory")
#define PG8_WAIT_L(n) asm volatile("s_waitcnt lgkmcnt(" #n ")" ::: "memory")
#define PG8_BAR __builtin_amdgcn_s_barrier()
#define PG8_SCHED __builtin_amdgcn_sched_barrier(0)
    Unit cur, nxt; int ui = 0;
    if (!S.next(0, cur)) return;
    f32x4 acc[2][2][4][2];
#pragma unroll
    for (int a = 0; a < 2; ++a)
#pragma unroll
        for (int b = 0; b < 2; ++b)
#pragma unroll
            for (int m = 0; m < 4; ++m)
#pragma unroll
                for (int n = 0; n < 2; ++n) acc[a][b][m][n] = (f32x4){0.f, 0.f, 0.f, 0.f};
    bf16x8 At[4][2], B0[2][2], B1[2][2];
    const char* cA = (const char*)g.A + (size_t)cur.pm * tstepA; const char* cB = (const char*)g.Bt + (size_t)cur.pn * tstepB;
    PG8_STAGE(PG8_SB(0, 0), cB, voffB); PG8_STAGE(PG8_SB(0, 1), cB + hstepB, voffB); PG8_STAGE(PG8_SA(0, 0), cA, voffA); PG8_STAGE(PG8_SA(0, 1), cA + hstepA, voffA);
    if (wr == 1) PG8_BAR;
    PG8_WAIT_V(2); PG8_BAR;
    PG8_STAGE(PG8_SB(1, 0), cB + kstep, voffB); PG8_STAGE(PG8_SA(1, 0), cA + kstep, voffA); PG8_STAGE(PG8_SB(1, 1), cB + hstepB + kstep, voffB);
    PG8_WAIT_V(6); PG8_BAR;
    for (;;) {
        const bool has_next = S.next(ui + 1, nxt);
        const char* nA = has_next ? (const char*)g.A + (size_t)nxt.pm * tstepA : cA; const char* nB = has_next ? (const char*)g.Bt + (size_t)nxt.pn * tstepB : cB;
        for (int t = 0; t < nt; t += 2) {
            const bool last = (t == nt - 2);
            const char* a1 = cA + (size_t)(t + 1) * kstep;
            const char* a2 = last ? nA : cA + (size_t)(t + 2) * kstep; const char* b2 = last ? nB : cB + (size_t)(t + 2) * kstep;
            const char* a3 = a2 + kstep; const char* b3 = b2 + kstep;
            PG8_LDB(B0, 0, 0); PG8_LDB(B1, 0, 1); PG8_SCHED; PG8_LDA(At, 0, 0); PG8_STAGE(PG8_SA(1, 1), a1 + hstepA, voffA);
            PG8_WAIT_V(8); PG8_WAIT_L(0); PG8_BAR; PG8_MMA(0, 0, At, B0); PG8_MMA(0, 1, At, B1); PG8_BAR; PG8_SCHED;
            PG8_LDA(At, 0, 1); PG8_STAGE(PG8_SB(0, 0), b2, voffB); PG8_STAGE(PG8_SB(0, 1), b2 + hstepB, voffB); PG8_STAGE(PG8_SA(0, 0), a2, voffA);
            PG8_WAIT_V(8); PG8_WAIT_L(0); PG8_BAR; PG8_MMA(1, 0, At, B0); PG8_MMA(1, 1, At, B1); PG8_BAR; PG8_SCHED;
            PG8_LDB(B0, 1, 0); PG8_LDB(B1, 1, 1); PG8_SCHED; PG8_LDA(At, 1, 0); PG8_STAGE(PG8_SA(0, 1), a2 + hstepA, voffA);
            PG8_WAIT_V(8); PG8_WAIT_L(0); PG8_BAR; PG8_MMA(0, 0, At, B0); PG8_MMA(0, 1, At, B1); PG8_BAR; PG8_SCHED;
            PG8_LDA(At, 1, 1); PG8_STAGE(PG8_SB(1, 0), b3, voffB); PG8_STAGE(PG8_SB(1, 1), b3 + hstepB, voffB); PG8_STAGE(PG8_SA(1, 0), a3, voffA);
            PG8_WAIT_V(8); PG8_WAIT_L(0); PG8_BAR; PG8_MMA(1, 0, At, B0); PG8_MMA(1, 1, At, B1); PG8_BAR; PG8_SCHED;
        }
        if (wr == 0) PG8_BAR;
        E(acc, cur, wr, wc, fr, fq);
        if (!has_next) break;
#pragma unroll
        for (int a = 0; a < 2; ++a)
#pragma unroll
            for (int b = 0; b < 2; ++b)
#pragma unroll
                for (int m = 0; m < 4; ++m)
#pragma unroll
                    for (int n = 0; n < 2; ++n) acc[a][b][m][n] = (f32x4){0.f, 0.f, 0.f, 0.f};
        cur = nxt; cA = nA; cB = nB; ++ui;
        if (wr == 1) PG8_BAR;
    }
    PG8_WAIT_V(0);
    PG8_BAR;
#undef PG8_SA
#undef PG8_SB
#undef PG8_STAGE
#undef PG8_LDA
#undef PG8_LDB
#undef PG8_MMA
#undef PG8_WAIT_V
#undef PG8_WAIT_L
#undef PG8_BAR
#undef PG8_SCHED
}

struct EpiProj {
    static constexpr bool PERM = true;
    bf16_t *Gb, *Zb, *Ub, *QKVb, *GTb; const float *rope, *qg, *kg;
    __device__ __forceinline__ void operator()(const f32x4 (&acc)[2][2][4][2], const Unit& u, int wr, int wc, int fr, int fq) const {
        const int pn = u.pn;
        const int row0 = u.pm * BM + wr * 64 + fr;
        if (pn >= 6 && pn <= 8) {
            const bool isq = pn < 8;
            if (!isq && wc >= 2) {
#pragma unroll
                for (int ai = 0; ai < 2; ++ai)
#pragma unroll
                    for (int m = 0; m < 4; ++m) { bf16_t* rowp = QKVb + (size_t)(row0 + ai * HALF + m * 16) * 768 + 640 + (wc - 2) * 64 + 8 * fq;
#pragma unroll
                        for (int bj = 0; bj < 2; ++bj) { const f32x4 v0 = acc[ai][bj][m][0], v1 = acc[ai][bj][m][1];
                            u32x4 w; w.x = cvtpk(v0[0], v0[1]); w.y = cvtpk(v0[2], v0[3]); w.z = cvtpk(v1[0], v1[1]); w.w = cvtpk(v1[2], v1[3]);
                            *(u32x4*)(rowp + bj * 32) = w; } }
            } else {
                const int head = isq ? (pn - 6) * 4 + wc : wc;
                const float* gain = isq ? qg : kg;
                const int cbase = (isq ? 0 : 512) + head * 64 + 4 * fq;
                const float scale = isq ? 0.125f * LOG2E : 1.f;
                const bool dorope = u.pm < (ML / BM);
                const f32x4 g1a = *(const f32x4*)(gain + 4 * fq), g2a = *(const f32x4*)(gain + 16 + 4 * fq), g1b = *(const f32x4*)(gain + 32 + 4 * fq), g2b = *(const f32x4*)(gain + 48 + 4 * fq);
#pragma unroll
                for (int ai = 0; ai < 2; ++ai)
#pragma unroll
                    for (int m = 0; m < 4; ++m) { const int row = row0 + ai * HALF + m * 16;
                        f32x4 x1a = acc[ai][0][m][0], x2a = acc[ai][0][m][1], x1b = acc[ai][1][m][0], x2b = acc[ai][1][m][1];
                        float ss = 0.f;
#pragma unroll
                        for (int e = 0; e < 4; ++e) ss += (x1a[e] * x1a[e] + x2a[e] * x2a[e]) + (x1b[e] * x1b[e] + x2b[e] * x2b[e]);
                        ss += __shfl_xor(ss, 16); ss += __shfl_xor(ss, 32);
                        const float rinv = rsqrtf(ss * (1.f / 64.f) + EPSV);
                        x1a = x1a * rinv * g1a; x2a = x2a * rinv * g2a; x1b = x1b * rinv * g1b; x2b = x2b * rinv * g2b;
                        if (dorope) { const int t = row & (SEQ - 1);
                            const float* ra = rope + ((t >> 6) * 16 + 4 * fq) * 2; const f32x4 a0 = *(const f32x4*)ra, a1 = *(const f32x4*)(ra + 4);
                            const float* rb = rope + ((t & 63) * 16 + 4 * fq) * 2; const f32x4 b0 = *(const f32x4*)rb, b1 = *(const f32x4*)(rb + 4);
                            const f32x4 ca = {a0[0], a0[2], a1[0], a1[2]}, sa = {a0[1], a0[3], a1[1], a1[3]}, cb = {b0[0], b0[2], b1[0], b1[2]}, sb = {b0[1], b0[3], b1[1], b1[3]};
                            const f32x4 y1a = x1a * ca - x2a * sa, y2a = x2a * ca + x1a * sa, y1b = x1b * cb - x2b * sb, y2b = x2b * cb + x1b * sb;
                            x1a = y1a; x2a = y2a; x1b = y1b; x2b = y2b; }
                        x1a = x1a * scale; x2a = x2a * scale; x1b = x1b * scale; x2b = x2b * scale;
                        bf16_t* dp = QKVb + (size_t)row * 768 + cbase;
                        u32x2 w;
                        w.x = cvtpk(x1a[0], x1a[1]); w.y = cvtpk(x1a[2], x1a[3]); *(u32x2*)dp = w;
                        w.x = cvtpk(x2a[0], x2a[1]); w.y = cvtpk(x2a[2], x2a[3]); *(u32x2*)(dp + 16) = w;
                        w.x = cvtpk(x1b[0], x1b[1]); w.y = cvtpk(x1b[2], x1b[3]); *(u32x2*)(dp + 32) = w;
                        w.x = cvtpk(x2b[0], x2b[1]); w.y = cvtpk(x2b[2], x2b[3]); *(u32x2*)(dp + 48) = w; }
            }
            return;
        }
        bf16_t* base; int ld, c0, act;
        if (pn < 2) { base = Gb; ld = 512; c0 = pn * 256; act = 0; }
        else if (pn == 2) { base = Zb; ld = 1024; c0 = 0; act = 1; }
        else if (pn == 3) { base = Ub; ld = 512; c0 = 0; act = 0; }
        else if (pn == 4) { base = Ub; ld = 512; c0 = 256; act = 0; }
        else if (pn == 5) { base = Zb; ld = 1024; c0 = 256; act = 1; }
        else if (pn < 11) { base = Zb; ld = 1024; c0 = 512 + (pn - 9) * 256; act = 1; }
        else { base = GTb; ld = 3072; c0 = (pn - 11) * 256; act = 2; }
        const int col0 = c0 + wc * 32 + 8 * fq;
#pragma unroll
        for (int ai = 0; ai < 2; ++ai)
#pragma unroll
            for (int m = 0; m < 4; ++m) { bf16_t* rowp = base + (size_t)(row0 + ai * HALF + m * 16) * ld + col0;
#pragma unroll
                for (int bj = 0; bj < 2; ++bj) { f32x4 v0 = acc[ai][bj][m][0], v1 = acc[ai][bj][m][1];
                    if (act == 1) {
#pragma unroll
                        for (int e = 0; e < 4; ++e) { v0[e] = silu_f(v0[e]); v1[e] = silu_f(v1[e]); } }
                    else if (act == 2) {
#pragma unroll
                        for (int e = 0; e < 4; ++e) { v0[e] = sigm_f(v0[e]); v1[e] = sigm_f(v1[e]); } }
                    u32x4 w; w.x = cvtpk(v0[0], v0[1]); w.y = cvtpk(v0[2], v0[3]); w.z = cvtpk(v1[0], v1[1]); w.w = cvtpk(v1[2], v1[3]);
                    *(u32x4*)(rowp + bj * HALF) = w; } }
    }
};
struct EpiMerge {
    static constexpr bool PERM = true;
    const bf16_t* GTb; bf16_t* MG; int seg;
    __device__ __forceinline__ void operator()(const f32x4 (&acc)[2][2][4][2], const Unit& u, int wr, int wc, int fr, int fq) const {
        const int row0 = u.pm * BM + wr * 64 + fr, col0 = u.pn * BM + wc * 32 + 8 * fq;
#pragma unroll
        for (int ai = 0; ai < 2; ++ai)
#pragma unroll
            for (int m = 0; m < 4; ++m) { const size_t row = (size_t)(row0 + ai * HALF + m * 16);
#pragma unroll
                for (int bj = 0; bj < 2; ++bj) { const int col = col0 + bj * HALF;
                    const u32x4 gw = *(const u32x4*)(GTb + row * 3072 + seg * 1024 + col);
                    f32x4 v0 = acc[ai][bj][m][0], v1 = acc[ai][bj][m][1];
                    v0[0] *= bflo(gw.x); v0[1] *= bfhi(gw.x); v0[2] *= bflo(gw.y); v0[3] *= bfhi(gw.y);
                    v1[0] *= bflo(gw.z); v1[1] *= bfhi(gw.z); v1[2] *= bflo(gw.w); v1[3] *= bfhi(gw.w);
                    bf16_t* mp = MG + row * 1024 + col;
                    if (seg != 0) { const u32x4 mw = *(const u32x4*)mp;
                        v0[0] += bflo(mw.x); v0[1] += bfhi(mw.x); v0[2] += bflo(mw.y); v0[3] += bfhi(mw.y);
                        v1[0] += bflo(mw.z); v1[1] += bfhi(mw.z); v1[2] += bflo(mw.w); v1[3] += bfhi(mw.w); }
                    u32x4 w; w.x = cvtpk(v0[0], v0[1]); w.y = cvtpk(v0[2], v0[3]); w.z = cvtpk(v1[0], v1[1]); w.w = cvtpk(v1[2], v1[3]);
                    *(u32x4*)mp = w; } }
    }
};
struct EpiRes {
    static constexpr bool PERM = false;
    const float* xsrc; float* xdst; const float* csrc; float* cdst; const float* modl;
    __device__ __forceinline__ void operator()(const f32x4 (&acc)[2][2][4][2], const Unit& u, int wr, int wc, int fr, int fq) const {
        const bool isctx = u.pm >= (ML / BM);
        const int rbase = u.pm * BM + wr * 64 + fr;
        const int bi = isctx ? 4 : (rbase >> 13);
        const float* src = isctx ? csrc + (size_t)(rbase - ML) * DM : xsrc + (size_t)rbase * DM;
        float* dst = isctx ? cdst + (size_t)(rbase - ML) * DM : xdst + (size_t)rbase * DM;
        const int col0 = u.pn * BM + wc * 32 + 4 * fq;
#pragma unroll
        for (int bj = 0; bj < 2; ++bj)
#pragma unroll
            for (int n = 0; n < 2; ++n) { const int col = col0 + bj * HALF + n * 16;
                const f32x4 gt = *(const f32x4*)(modl + bi * 3072 + 2048 + col);
#pragma unroll
                for (int ai = 0; ai < 2; ++ai)
#pragma unroll
                    for (int m = 0; m < 4; ++m) { const size_t off = (size_t)(ai * HALF + m * 16) * DM + col;
                        const f32x4 xs = *(const f32x4*)(src + off);
                        *(f32x4*)(dst + off) = xs + gt * acc[ai][bj][m][n]; } }
    }
};
}

template <int NI, int NJ, int KS>
__device__ __forceinline__ void act_gemm(f32x4 (&acc)[NI][NJ], const LAS unsigned char* act, int RS, int n0, const bf16_t* tab, int ldt, int lane) {
    const int g = lane >> 4, c = lane & 15;
    const LAS unsigned char* abase = act + (8 * g + (c >> 2)) * RS + (n0 + 4 * (c & 3)) * 2;
    const bf16_t* tbase = tab + (size_t)c * ldt + 8 * g;
#pragma unroll 2
    for (int ks = 0; ks < KS; ++ks) {
        bf16x8 a[NI], b[NJ];
#pragma unroll
        for (int i = 0; i < NI; ++i) { const s16x4 lo = lds_tr(abase + ks * 32 * RS + i * 32), hi = lds_tr(abase + (ks * 32 + 4) * RS + i * 32); a[i] = cat8(lo, hi); }
#pragma unroll
        for (int j = 0; j < NJ; ++j) b[j] = *(const bf16x8*)(tbase + (size_t)j * 16 * ldt + ks * 32);
#pragma unroll
        for (int i = 0; i < NI; ++i)
#pragma unroll
            for (int j = 0; j < NJ; ++j) acc[i][j] = __builtin_amdgcn_mfma_f32_16x16x32_bf16(a[i], b[j], acc[i][j], 0, 0, 0);
    }
}
template <int NI, int NJ> __device__ __forceinline__ void zero_acc(f32x4 (&acc)[NI][NJ]) {
#pragma unroll
    for (int i = 0; i < NI; ++i)
#pragma unroll
        for (int j = 0; j < NJ; ++j) acc[i][j] = (f32x4){0.f, 0.f, 0.f, 0.f};
}
__device__ __forceinline__ void mul_store4(bf16_t* p, f32x4 v, bool dry = false) {
    if (dry && v[0] != 1.2345e30f) return;
    const u32x2 z = *(const u32x2*)p;
    u32x2 o; o.x = cvtpk(v[0] * bflo(z.x), v[1] * bfhi(z.x)); o.y = cvtpk(v[2] * bflo(z.y), v[3] * bfhi(z.y));
    *(u32x2*)p = o;
}

struct Params { const float* in[16]; float* out; unsigned char* ws; };

__device__ __forceinline__ void phase0(const Params& p, LAS unsigned char* lds, int tid, int bid, int G) {
    LAS float* sc = (LAS float*)lds;
    LAS float* red = (LAS float*)(lds + 20480);
    for (int i = tid; i < 5120; i += 512) { const float v = i < 4096 ? p.in[1][i] : p.in[3][i - 4096]; sc[i] = v / (1.f + expf(-v)); }
    __syncthreads();
    float* mod = (float*)(p.ws + WS_MOD);
    for (int item = bid; item < 192; item += G) {
        const int l = item / 48, cgp = item % 48, col = tid & 63, kg = tid >> 6, n = cgp * 64 + col;
        const float* w = p.in[4] + ((size_t)l * 1024 + kg * 128) * 3072 + n;
        float a0 = 0.f, a1 = 0.f, a2 = 0.f, a3 = 0.f, a4 = 0.f;
#pragma unroll 8
        for (int k = 0; k < 128; ++k) { const float wv = w[(size_t)k * 3072]; const int kk = kg * 128 + k;
            a0 += sc[kk] * wv; a1 += sc[1024 + kk] * wv; a2 += sc[2048 + kk] * wv; a3 += sc[3072 + kk] * wv; a4 += sc[4096 + kk] * wv; }
        red[(kg * 5 + 0) * 64 + col] = a0; red[(kg * 5 + 1) * 64 + col] = a1; red[(kg * 5 + 2) * 64 + col] = a2; red[(kg * 5 + 3) * 64 + col] = a3; red[(kg * 5 + 4) * 64 + col] = a4;
        __syncthreads();
        if (tid < 320) { const int bi = tid >> 6, c2 = tid & 63; float s = 0.f;
#pragma unroll
            for (int k2 = 0; k2 < 8; ++k2) s += red[(k2 * 5 + bi) * 64 + c2];
            mod[(l * 5 + bi) * 3072 + cgp * 64 + c2] = s + p.in[5][l * 3072 + cgp * 64 + c2]; }
        __syncthreads();
    }
    const int gt = bid * 512 + tid, NT = G * 512;
    float* rope = (float*)(p.ws + WS_ROPE);
    for (int i = gt; i < 5 * 3072; i += NT) ((float*)(p.ws + WS_ROPE + 65536))[i] = 0.f;
    for (int i = gt; i < 2048; i += NT) { const int pos = i >> 4, fi = i & 15; const float inv = powf(10000.f, -(float)fi / 16.f); const float ang = (float)pos * inv; float s, c; sincosf(ang, &s, &c); rope[2 * i] = c; rope[2 * i + 1] = s; }
    bf16_t* t128 = (bf16_t*)(p.ws + WS_T128);
    for (int i = gt; i < 65536; i += NT) { const int m = i >> 8, k = i & 255, part = m >> 7, k1 = m & 127, pp = k >> 7, l1 = k & 127; const int j = (l1 * k1) & 127; float s, c; sincospif((float)j / 64.f, &s, &c);
        const float v = (part == pp) ? c : (part == 0 ? s : -s); t128[i] = (bf16_t)(cvtpk(v, 0.f) & 0xffffu); }
    bf16_t* tc = (bf16_t*)(p.ws + WS_TC);
    for (int i = gt; i < 256 * 512; i += NT) { const int kk = i >> 9, k = i & 511, part = k >> 8, ll = k & 255; const int j = (kk * ll) & 255; float s, c; sincospif((float)j / 128.f, &s, &c);
        const float v = (part ? s : c) * 0.0625f; tc[i] = (bf16_t)(cvtpk(v, 0.f) & 0xffffu); }
    bf16_t* t3 = (bf16_t*)(p.ws + WS_T3);
    for (int i = gt; i < 128 * 64 * 128; i += NT) { const int k1 = i >> 13, k2 = (i >> 7) & 63, kp = i & 127, l2 = kp >> 1, part = kp & 1; const int j = (l2 * (k1 + 128 * k2)) & 8191; float s, c; sincospif((float)j / 4096.f, &s, &c);
        const float v = (part ? s : c) * 0.011048543456039806f; t3[i] = (bf16_t)(cvtpk(v, 0.f) & 0xffffu); }
}

__device__ __forceinline__ void transpose_blk(const float* Wsrc, int ldw, int K, bf16_t* WTdst, int kb, int perm, LAS float* scr, int lane) {
    const int k0 = 64 * kb;
#pragma unroll 8
    for (int i = 0; i < 32; ++i) { const int kk = 2 * i + (lane >> 5); scr[kk * 33 + (lane & 31)] = Wsrc[(size_t)(k0 + kk) * ldw + (lane & 31)]; }
    asm volatile("s_waitcnt lgkmcnt(0)" ::: "memory");
    const int c = lane & 7;
#pragma unroll
    for (int j = 0; j < 4; ++j) { const int n = (lane >> 3) + 8 * j; const int sc = perm ? (16 * ((n >> 2) & 1) + 4 * (n >> 3) + (n & 3)) : n; const LAS float* s = scr + (8 * c) * 33 + sc;
        u32x4 o; o.x = cvtpk(s[0 * 33], s[1 * 33]); o.y = cvtpk(s[2 * 33], s[3 * 33]); o.z = cvtpk(s[4 * 33], s[5 * 33]); o.w = cvtpk(s[6 * 33], s[7 * 33]);
        *(u32x4*)(WTdst + (size_t)n * K + k0 + 8 * c) = o; }
    asm volatile("s_waitcnt lgkmcnt(0)" ::: "memory");
}
__device__ __forceinline__ void phase1(const Params& p, LAS unsigned char* lds, int l, int tid, int lane, int wave, int bid, int G) {
    unsigned char* wsW = p.ws + WS_W;
    bf16_t* WinT = (bf16_t*)(wsW + W_IN_OFF);
    LAS float* scr = (LAS float*)(lds + wave * 8448);
    LAS float* ctab = (LAS float*)(lds + 8 * 8448);
    if (tid < 64) { float s, c; sincospif((float)tid / 32.f, &s, &c); ctab[tid] = c * 0.125f; ctab[64 + tid] = s * 0.125f; }
    __syncthreads();
    const int gw = bid * 8 + wave, NGW = G * 8;
    const float* win = p.in[6] + (size_t)l * 1024 * INW;
    constexpr int I_IN = 16 * 168, I_PA = 4 * 32, I_PC = 8 * 32, I_OUT = 16 * 32;
    for (int it = gw; it < I_IN + 2 * I_PA + I_PC + I_OUT; it += NGW) {
        int r = it;
        if (r < I_IN) { const int rb = 16 + r % 168, kb = r / 168, n = rb * 32; int c0, perm = 0;
            if (n < 1536 || n >= 2304) c0 = n - 256;
            else if (n < 2048) { const int t = n - 1536, tile = t >> 8, tt = t & 255, bj = tt >> 7, wc = (tt >> 5) & 3; c0 = 1280 + (tile * 4 + wc) * 64 + 32 * bj; perm = 1; }
            else { const int tt = n - 2048, bj = tt >> 7, wc = (tt >> 5) & 3; if (wc < 2) { c0 = 1792 + wc * 64 + 32 * bj; perm = 1; } else c0 = 1920 + (wc - 2) * 64 + 32 * bj; }
            transpose_blk(win + c0, INW, 1024, WinT + (size_t)n * 1024, kb, perm, scr, lane); continue; } r -= I_IN;
        if (r < I_PA) { transpose_blk(p.in[12] + (size_t)l * 256 * 1024 + 32 * (r & 31), 1024, 256, (bf16_t*)(wsW + W_PA_OFF) + (size_t)32 * (r & 31) * 256, r >> 5, 0, scr, lane); continue; } r -= I_PA;
        if (r < I_PA) { transpose_blk(p.in[13] + (size_t)l * 256 * 1024 + 32 * (r & 31), 1024, 256, (bf16_t*)(wsW + W_PB_OFF) + (size_t)32 * (r & 31) * 256, r >> 5, 0, scr, lane); continue; } r -= I_PA;
        if (r < I_PC) { transpose_blk(p.in[14] + (size_t)l * 512 * 1024 + 32 * (r & 31), 1024, 512, (bf16_t*)(wsW + W_PC_OFF) + (size_t)32 * (r & 31) * 512, r >> 5, 0, scr, lane); continue; } r -= I_PC;
        transpose_blk(p.in[15] + (size_t)l * 1024 * 1024 + 32 * (r & 31), 1024, 1024, (bf16_t*)(wsW + W_OUT_OFF) + (size_t)32 * (r & 31) * 1024, r >> 5, 0, scr, lane);
    }
    const int gtid = (G - 1 - bid) * 512 + tid, NT = G * 512;
    for (int id = gtid; id < 65536; id += NT) {
        const int n = id >> 7, ko = id & 127, part = n >> 8, grp = (n >> 6) & 3, m = n & 63;
        const LAS float* tb = ctab + part * 64;
        const float* wrow = win + (size_t)(ko * 8) * INW + grp * 64;
        float a[8];
#pragma unroll
        for (int j = 0; j < 8; ++j) a[j] = 0.f;
#pragma unroll 4
        for (int c4 = 0; c4 < 16; ++c4) {
            const float t0 = tb[(m * (4 * c4)) & 63], t1 = tb[(m * (4 * c4 + 1)) & 63], t2 = tb[(m * (4 * c4 + 2)) & 63], t3 = tb[(m * (4 * c4 + 3)) & 63];
#pragma unroll
            for (int j = 0; j < 8; ++j) { const f32x4 wv = *(const f32x4*)(wrow + (size_t)j * INW + c4 * 4); a[j] += wv[0] * t0 + wv[1] * t1 + wv[2] * t2 + wv[3] * t3; }
        }
        const float sg = part ? -1.f : 1.f;
        u32x4 o; o.x = cvtpk(sg * a[0], sg * a[1]); o.y = cvtpk(sg * a[2], sg * a[3]); o.z = cvtpk(sg * a[4], sg * a[5]); o.w = cvtpk(sg * a[6], sg * a[7]);
        *(u32x4*)(WinT + (size_t)n * 1024 + ko * 8) = o;
    }
    { const float* sw = p.in[7] + (size_t)l * 65536; bf16_t* dw = (bf16_t*)(p.ws + WS_SGUW);
      for (int id = gtid; id < 8192; id += NT) { const f32x4 v0 = *(const f32x4*)(sw + id * 8), v1 = *(const f32x4*)(sw + id * 8 + 4);
          u32x4 o; o.x = cvtpk(v0[0], v0[1]); o.y = cvtpk(v0[2], v0[3]); o.z = cvtpk(v1[0], v1[1]); o.w = cvtpk(v1[2], v1[3]); *(u32x4*)(dw + id * 8) = o; } }
    const float* xs = l == 0 ? p.in[0] : p.out;
    const float* cs = l == 0 ? p.in[2] : (const float*)(p.ws + WS_XC);
    const float* mod = (const float*)(p.ws + WS_MOD) + (size_t)l * 5 * 3072;
    bf16_t* H = (bf16_t*)(p.ws + WS_H);
    for (int row = gw; row < MT; row += NGW) {
        const float* src = row < ML ? xs + (size_t)row * DM : cs + (size_t)(row - ML) * DM;
        const int bi = row < ML ? (row >> 13) : 4;
        const float* md = mod + bi * 3072;
        f32x4 v[4]; float ss = 0.f;
#pragma unroll
        for (int j = 0; j < 4; ++j) { v[j] = *(const f32x4*)(src + 4 * lane + 256 * j); ss += (v[j][0] * v[j][0] + v[j][1] * v[j][1]) + (v[j][2] * v[j][2] + v[j][3] * v[j][3]); }
#pragma unroll
        for (int o = 1; o < 64; o <<= 1) ss += __shfl_xor(ss, o);
        const float rinv = rsqrtf(ss * (1.f / 1024.f) + EPSV);
#pragma unroll
        for (int j = 0; j < 4; ++j) { const int idx = 4 * lane + 256 * j; const f32x4 sh = *(const f32x4*)(md + idx), scl = *(const f32x4*)(md + 1024 + idx);
            const f32x4 o = v[j] * rinv * (scl + 1.f) + sh; u32x2 w; w.x = cvtpk(o[0], o[1]); w.y = cvtpk(o[2], o[3]); *(u32x2*)(H + (size_t)row * DM + idx) = w; }
    }
}

__device__ __forceinline__ void attn_item(LAS unsigned char* lds, const bf16_t* QKV, bf16_t* Z, const float* sinkl,
                                          int b, int blk, int kvh, int hp, bool isctx, int tid, int lane, int wave, bool dry = false) {
    constexpr int RS = 144;
    LAS unsigned char* Qs = lds; LAS unsigned char* Ks = lds + 256 * RS; LAS unsigned char* Vs = Ks + 128 * RS;
    const int qrow0 = isctx ? (ML + b * 256 + blk * 128) : (b * SEQ + blk * 128);
    __syncthreads();
#pragma unroll
    for (int it = 0; it < 4; ++it) { const int id = it * 512 + tid, r = id >> 3, c16 = id & 7, hl = r >> 7, tq = r & 127;
        *(LAS u32x4*)(Qs + r * RS + c16 * 16) = *(const u32x4*)(QKV + (size_t)(qrow0 + tq) * 768 + (kvh * 4 + hp * 2 + hl) * 64 + c16 * 8); }
    const int hl = wave >> 2, qq = wave & 3, gq = hp * 2 + hl, g = lane >> 4, c = lane & 15;
    const LAS unsigned char* qbase = Qs + (hl * 128 + qq * 32 + c) * RS + 16 * g;
    f32x4 O[4][2]; float m_run[2], l_run[2];
    const float sinkv = sinkl[kvh * 4 + gq] * LOG2E;
#pragma unroll
    for (int qi = 0; qi < 2; ++qi) { m_run[qi] = sinkv; l_run[qi] = (g == 0) ? 1.f : 0.f;
#pragma unroll
        for (int df = 0; df < 4; ++df) O[df][qi] = (f32x4){0.f, 0.f, 0.f, 0.f}; }
    const LAS unsigned char* vbase = Vs + (4 * g + (c >> 2)) * RS + (4 * (c & 3)) * 2;
#pragma unroll 1
    for (int ti = 0; ti < 5; ++ti) {
        int krow0;
        if (ti < 3) { if (isctx) continue; if (ti == 0) { if (blk == 0) continue; krow0 = qrow0 - 128; } else if (ti == 1) krow0 = qrow0; else { if (blk == 63) continue; krow0 = qrow0 + 128; } }
        else krow0 = ML + b * 256 + (ti - 3) * 128;
        __syncthreads();
#pragma unroll
        for (int it = 0; it < 2; ++it) { const int id = tid + 512 * it, r = id >> 3, c16 = id & 7; const bf16_t* src = QKV + (size_t)(krow0 + r) * 768 + 512 + kvh * 64 + c16 * 8;
            *(LAS u32x4*)(Ks + r * RS + c16 * 16) = *(const u32x4*)src;
            *(LAS u32x4*)(Vs + r * RS + c16 * 16) = *(const u32x4*)(src + 128); }
        __syncthreads();
#pragma unroll
        for (int qi = 0; qi < 2; ++qi) {
            asm volatile("" ::: "memory"); __builtin_amdgcn_sched_barrier(0);
            f32x4 s[8];
            const bf16x8 qf0 = *(const LAS bf16x8*)(qbase + (16 * qi) * RS), qf1 = *(const LAS bf16x8*)(qbase + (16 * qi) * RS + 64);
#pragma unroll
            for (int kf = 0; kf < 8; ++kf) { const LAS unsigned char* kp = Ks + (16 * kf + c) * RS + 16 * g;
                const bf16x8 k0 = *(const LAS bf16x8*)kp, k1 = *(const LAS bf16x8*)(kp + 64);
                s[kf] = __builtin_amdgcn_mfma_f32_16x16x32_bf16(k0, qf0, (f32x4){0.f, 0.f, 0.f, 0.f}, 0, 0, 0);
                s[kf] = __builtin_amdgcn_mfma_f32_16x16x32_bf16(k1, qf1, s[kf], 0, 0, 0); }
            if (ti == 0 || ti == 2) { int qidx = qq * 32 + 16 * qi + c; asm volatile("" : "+v"(qidx));
#pragma unroll
                for (int kf = 0; kf < 8; ++kf)
#pragma unroll
                    for (int r = 0; r < 4; ++r) { const int key = 16 * kf + 4 * g + r; const bool valid = (ti == 0) ? (key >= qidx) : (key <= qidx); if (!valid) s[kf][r] = -1e30f; } }
            float mx = s[0][0];
#pragma unroll
            for (int kf = 0; kf < 8; ++kf)
#pragma unroll
                for (int r = 0; r < 4; ++r) mx = fmaxf(mx, s[kf][r]);
            mx = fmaxf(mx, __shfl_xor(mx, 16)); mx = fmaxf(mx, __shfl_xor(mx, 32));
            const float mnew = fmaxf(m_run[qi], mx), alpha = __builtin_amdgcn_exp2f(m_run[qi] - mnew); m_run[qi] = mnew;
            float psum = 0.f;
#pragma unroll
            for (int kf = 0; kf < 8; ++kf)
#pragma unroll
                for (int r = 0; r < 4; ++r) { const float pv = __builtin_amdgcn_exp2f(s[kf][r] - mnew); s[kf][r] = pv; psum += pv; }
            l_run[qi] = l_run[qi] * alpha + psum;
#pragma unroll
            for (int df = 0; df < 4; ++df) O[df][qi] *= alpha;
#pragma unroll
            for (int ks = 0; ks < 4; ++ks) {
                u32x4 pw; pw.x = cvtpk(s[2 * ks][0], s[2 * ks][1]); pw.y = cvtpk(s[2 * ks][2], s[2 * ks][3]); pw.z = cvtpk(s[2 * ks + 1][0], s[2 * ks + 1][1]); pw.w = cvtpk(s[2 * ks + 1][2], s[2 * ks + 1][3]);
                const bf16x8 pf = __builtin_bit_cast(bf16x8, pw);
#pragma unroll
                for (int df = 0; df < 4; ++df) { const LAS unsigned char* vp = vbase + (ks * 32) * RS + df * 32;
                    const bf16x8 vf = cat8(lds_tr(vp), lds_tr(vp + 16 * RS));
                    O[df][qi] = __builtin_amdgcn_mfma_f32_16x16x32_bf16(vf, pf, O[df][qi], 0, 0, 0); }
            }
        }
    }
#pragma unroll
    for (int qi = 0; qi < 2; ++qi) { float lt = l_run[qi]; lt += __shfl_xor(lt, 16); lt += __shfl_xor(lt, 32); const float inv = 1.f / lt;
        const size_t row = (size_t)(qrow0 + qq * 32 + 16 * qi + c);
#pragma unroll
        for (int df = 0; df < 4; ++df) mul_store4(Z + row * 1024 + 512 + (kvh * 4 + gq) * 64 + 16 * df + 4 * g, O[df][qi] * inv, dry); }
}

__device__ __forceinline__ void f1_item(LAS unsigned char* lds, const bf16_t* Gb, bf16_t* Afft, const bf16_t* t128, int b, int l2, int tid, int lane, int wave) {
    constexpr int RS = 528;
    __syncthreads();
#pragma unroll 4
    for (int it = 0; it < 16; ++it) { const int id = it * 512 + tid, row = id >> 5, c16 = id & 31, pp = row >> 7, l1 = row & 127;
        *(LAS u32x4*)(lds + row * RS + c16 * 16) = *(const u32x4*)(Gb + (size_t)(b * SEQ + 64 * l1 + l2) * 512 + pp * 256 + c16 * 8); }
    __syncthreads();
    const int g = lane >> 4, c = lane & 15;
    for (int mh = 0; mh < 2; ++mh) {
        f32x4 acc[2][8]; zero_acc<2, 8>(acc);
        act_gemm<2, 8, 8>(acc, lds, RS, 32 * wave, t128 + (size_t)(mh * 128) * 256, 256, lane);
#pragma unroll
        for (int i = 0; i < 2; ++i)
#pragma unroll
            for (int j = 0; j < 8; ++j) { const int k1 = 16 * j + c, ch = 32 * wave + 16 * i + 4 * g; const size_t arow = ((size_t)(b * 128 + k1) * 64 + l2) * 2 + mh;
                u32x2 o; o.x = cvtpk(acc[i][j][0], acc[i][j][1]); o.y = cvtpk(acc[i][j][2], acc[i][j][3]); *(u32x2*)(Afft + arow * 256 + ch) = o; }
    }
}
__device__ __forceinline__ void sgu_item(LAS unsigned char* lds, const bf16_t* Ub, bf16_t* Z, const bf16_t* sguw, const float* sgub, int ci, int tid, int lane, int wave, bool dry = false) {
    constexpr int RS = 528;
    const int row0 = ci * 128;
    __syncthreads();
    { const int t = tid >> 2, qd = tid & 3; const bf16_t* vp = Ub + (size_t)(row0 + t) * 512 + 256 + qd * 64;
      u32x4 w[8]; float ss = 0.f;
#pragma unroll
      for (int i = 0; i < 8; ++i) { w[i] = *(const u32x4*)(vp + 8 * i);
          const float a0 = bflo(w[i].x), a1 = bfhi(w[i].x), a2 = bflo(w[i].y), a3 = bfhi(w[i].y), a4 = bflo(w[i].z), a5 = bfhi(w[i].z), a6 = bflo(w[i].w), a7 = bfhi(w[i].w);
          ss += (a0 * a0 + a1 * a1) + (a2 * a2 + a3 * a3) + (a4 * a4 + a5 * a5) + (a6 * a6 + a7 * a7); }
      ss += __shfl_xor(ss, 1); ss += __shfl_xor(ss, 2);
      const float rinv = rsqrtf(ss * (1.f / 256.f) + EPSV);
#pragma unroll
      for (int i = 0; i < 8; ++i) { u32x4 o; o.x = cvtpk(bflo(w[i].x) * rinv, bfhi(w[i].x) * rinv); o.y = cvtpk(bflo(w[i].y) * rinv, bfhi(w[i].y) * rinv); o.z = cvtpk(bflo(w[i].z) * rinv, bfhi(w[i].z) * rinv); o.w = cvtpk(bflo(w[i].w) * rinv, bfhi(w[i].w) * rinv);
          *(LAS u32x4*)(lds + t * RS + qd * 128 + i * 16) = o; } }
    __syncthreads();
    const int grp = wave >> 1, sh = wave & 1, g = lane >> 4, c = lane & 15;
    f32x4 acc[4][4]; zero_acc<4, 4>(acc);
    act_gemm<4, 4, 4>(acc, lds, RS, grp * 64, sguw + (size_t)grp * 16384 + (size_t)(sh * 64) * 128, 128, lane);
#pragma unroll
    for (int j = 0; j < 4; ++j) { const int s = sh * 64 + 16 * j + c; const float bias = sgub[grp * 128 + s]; const size_t row = (size_t)(row0 + s);
#pragma unroll
        for (int i = 0; i < 4; ++i) { const int col = grp * 64 + 16 * i + 4 * g; const u32x2 uw = *(const u32x2*)(Ub + row * 512 + col);
            f32x4 v = acc[i][j]; v[0] = (v[0] + bias) * bflo(uw.x); v[1] = (v[1] + bias) * bfhi(uw.x); v[2] = (v[2] + bias) * bflo(uw.y); v[3] = (v[3] + bias) * bfhi(uw.y);
            mul_store4(Z + row * 1024 + 256 + col, v, dry); } }
}
__device__ __forceinline__ void f3_item(LAS unsigned char* lds, const bf16_t* Afft, bf16_t* Z, const bf16_t* t3, int b, int k1, int tid, int lane, int wave, bool dry = false) {
    constexpr int RS = 528;
    __syncthreads();
    const bf16_t* src = Afft + (size_t)(b * 128 + k1) * 128 * 256;
#pragma unroll 4
    for (int it = 0; it < 8; ++it) { const int id = it * 512 + tid, row = id >> 5, c16 = id & 31;
        *(LAS u32x4*)(lds + row * RS + c16 * 16) = *(const u32x4*)(src + (size_t)row * 256 + c16 * 8); }
    __syncthreads();
    const int g = lane >> 4, c = lane & 15;
    f32x4 acc[2][4]; zero_acc<2, 4>(acc);
    act_gemm<2, 4, 4>(acc, lds, RS, 32 * wave, t3 + (size_t)k1 * 64 * 128, 128, lane);
#pragma unroll
    for (int j = 0; j < 4; ++j) { const int k2 = 16 * j + c; const size_t row = (size_t)b * SEQ + k1 + 128 * k2;
#pragma unroll
        for (int i = 0; i < 2; ++i) mul_store4(Z + row * 1024 + 32 * wave + 16 * i + 4 * g, acc[i][j], dry); }
}
__device__ __forceinline__ void fc_item(LAS unsigned char* lds, const bf16_t* Gb, bf16_t* Z, const bf16_t* tc, int b, int hh, int tid, int lane, int wave, bool dry = false) {
    constexpr int RS = 272;
    __syncthreads();
#pragma unroll 4
    for (int it = 0; it < 16; ++it) { const int id = it * 512 + tid, row = id >> 4, c16 = id & 15, part = row >> 8, ll = row & 255;
        *(LAS u32x4*)(lds + row * RS + c16 * 16) = *(const u32x4*)(Gb + (size_t)(ML + b * 256 + ll) * 512 + part * 256 + hh * 128 + c16 * 8); }
    __syncthreads();
    const int g = lane >> 4, c = lane & 15;
    f32x4 acc[1][16]; zero_acc<1, 16>(acc);
    act_gemm<1, 16, 16>(acc, lds, RS, 16 * wave, tc, 512, lane);
#pragma unroll
    for (int j = 0; j < 16; ++j) { const size_t row = (size_t)(ML + b * 256 + 16 * j + c); mul_store4(Z + row * 1024 + hh * 128 + 16 * wave + 4 * g, acc[0][j], dry); }
}


#define XB_TMO      128
#define XB_XCNT(j)  (256  + 64 * (j))
#define XB_XSUB(j)  (1280 + 64 * (j))
#define XB_XGEN(j)  (2304 + 64 * (j))
#define XB_TOP      3328
#define XB_TOPGEN   3392
#define XCD_BAR_WORDS 3456
#define XB_SPIN_CAP (1u << 18)
__device__ __forceinline__ unsigned xb_ld(unsigned* p)              { return __hip_atomic_load(p, __ATOMIC_RELAXED, __HIP_MEMORY_SCOPE_AGENT); }
__device__ __forceinline__ unsigned xb_add(unsigned* p, unsigned v) { return __hip_atomic_fetch_add(p, v, __ATOMIC_RELAXED, __HIP_MEMORY_SCOPE_AGENT); }
__device__ __forceinline__ unsigned xb_xcc_id() { return (unsigned)__builtin_amdgcn_s_getreg((3 << 11) | 20) & 0xFu; }
#define XB_SPIN(cond, bar) do { unsigned _sp = 0; while (cond) { __builtin_amdgcn_s_sleep(1); \
    if ((++_sp & 255u) == 0u) { if (xb_ld(&(bar)[XB_TMO])) break; if (_sp > XB_SPIN_CAP) { atomicAdd(&(bar)[XB_TMO], 1u); break; } } } } while (0)
struct XcdBarrier { unsigned* bar; unsigned x; volatile LAS unsigned* st; };
__device__ __forceinline__ XcdBarrier xcd_barrier_post(unsigned* bar, volatile LAS unsigned* st) {
    XcdBarrier b; b.bar = bar; b.x = xb_xcc_id(); b.st = st;
    if (threadIdx.x == 0) (void)xb_add(&bar[XB_XCNT(b.x)], 1u);
    return b;
}
__device__ __forceinline__ void xcd_barrier_complete(unsigned* bar, unsigned x, unsigned& nloc, unsigned& nx) {
    const unsigned G = gridDim.x * gridDim.y * gridDim.z;
    unsigned sum, cnt, mine, sp = 0u;
    for (;;) {
        sum = 0u; cnt = 0u; mine = 0u;
#pragma unroll
        for (unsigned j = 0; j < 16; ++j) { const unsigned c = xb_ld(&bar[XB_XCNT(j)]); sum += c; cnt += (c > 0u) ? 1u : 0u; mine = (j == x) ? c : mine; }
        if (sum == G) break;
        __builtin_amdgcn_s_sleep(1);
        if ((++sp & 255u) == 0u) { if (xb_ld(&bar[XB_TMO])) break; if (sp > XB_SPIN_CAP) { atomicAdd(&bar[XB_TMO], 1u); break; } }
    }
    nloc = mine > 0u ? mine : 1u; nx = cnt > 0u ? cnt : 1u;
}
__device__ __forceinline__ void xcd_barrier(const XcdBarrier& b) {
    asm volatile("s_waitcnt vmcnt(0)" ::: "memory");
    __syncthreads();
    if (threadIdx.x == 0) {
        unsigned* bar = b.bar;
        __builtin_amdgcn_s_waitcnt(0);
        unsigned nloc = b.st[0], nx = b.st[1];
        if (nloc == 0u) { xcd_barrier_complete(bar, b.x, nloc, nx); b.st[0] = nloc; b.st[1] = nx; }
        const unsigned old = xb_add(&bar[XB_XSUB(b.x)], 1u);
        const unsigned gen = old / nloc;
        if (old + 1u == (gen + 1u) * nloc) {
            __builtin_amdgcn_fence(__ATOMIC_RELEASE, "agent");
            asm volatile("s_waitcnt vmcnt(0)" ::: "memory");
            const unsigned og = xb_add(&bar[XB_TOP], 1u);
            const unsigned tg = og / nx;
            if (og + 1u == (tg + 1u) * nx) xb_add(&bar[XB_TOPGEN], 1u);
            else XB_SPIN(xb_ld(&bar[XB_TOPGEN]) == tg, bar);
            __builtin_amdgcn_fence(__ATOMIC_ACQUIRE, "agent");
            xb_add(&bar[XB_XGEN(b.x)], 1u);
            asm volatile("s_waitcnt vmcnt(0)" ::: "memory");
        } else {
            XB_SPIN(xb_ld(&bar[XB_XGEN(b.x)]) == gen, bar);
            __builtin_amdgcn_fence(__ATOMIC_ACQUIRE, "agent");
            asm volatile("s_waitcnt vmcnt(0)" ::: "memory");
        }
    }
    __syncthreads();
}

#define PHASE_IDS() int t__ = threadIdx.x, b__ = blockIdx.x, g__ = gridDim.x; asm volatile("" : "+v"(t__)); asm volatile("" : "+s"(b__), "+s"(g__)); \
    unsigned char* ws = p.ws; asm volatile("" : "+s"(ws)); \
    const int tid = t__, lane = tid & 63, wave = __builtin_amdgcn_readfirstlane(tid >> 6), bid = b__, G = g__; (void)lane; (void)wave; (void)bid; (void)G
__global__ void __launch_bounds__(512, 2) fwd_megakernel(Params p) {
    extern __shared__ __attribute__((aligned(16))) unsigned char lds_raw[];
    LAS unsigned char* lds = (LAS unsigned char*)lds_raw;
    cg::grid_group grid = cg::this_grid();
    volatile LAS unsigned* bst = (volatile LAS unsigned*)(lds + LDS_BYTES - 16);
    if (threadIdx.x < 4) bst[threadIdx.x] = 0u;
    __syncthreads();
    const XcdBarrier xbar = xcd_barrier_post((unsigned*)(p.ws + WS_BAR), bst);
#define GSYNC() do { xcd_barrier(xbar); if (PROBE_DUP == 7) xcd_barrier(xbar); } while (0)
#ifndef SKIP_P0
    { PHASE_IDS(); phase0(p, lds, tid, bid, G); }
#endif
    grid.sync();
#pragma unroll 1
    for (int l = 0; l < DEPTH; ++l) {
        const bool last = (l == DEPTH - 1);
#ifndef SKIP_P1
        for (int rep = (PROBE_DUP == 1 ? 0 : 1); rep < 2; ++rep) { PHASE_IDS(); phase1(p, lds, l, tid, lane, wave, bid, G); }
#endif
        GSYNC();
#ifndef SKIP_P2
#pragma unroll 1
        for (int rep = (PROBE_DUP == 2 ? 0 : 1); rep < 2; ++rep) { PHASE_IDS();
          pg8::Gemm g{(const bf16_t*)(ws + WS_H), (const bf16_t*)(ws + WS_W + W_IN_OFF), MT, NIN, 1024, 1024}; pg8::StaticOrder S; S.init(MT, NIN, G, bid);
          pg8::EpiProj E{(bf16_t*)(ws + WS_G), (bf16_t*)(ws + WS_Z), (bf16_t*)(ws + WS_U), (bf16_t*)(ws + WS_QKV), (bf16_t*)(ws + WS_GT), (const float*)(ws + WS_ROPE), p.in[9] + l * 64, p.in[10] + l * 64};
          pg8::gemm_phase<pg8::EpiProj>(lds, g, S, E, tid); }
#endif
        GSYNC();
#ifndef SKIP_P3
#pragma unroll 1
        for (int rep = (PROBE_DUP == 3 ? 0 : 1); rep < 2; ++rep) { PHASE_IDS(); const bool dry = rep == 0;
          bf16_t* Zb = (bf16_t*)(ws + WS_Z); const bf16_t* QKVb = (const bf16_t*)(ws + WS_QKV);
          const int n_attn = last ? 1024 : 1056, n_f1 = 256, n_sgu = last ? 256 : 264, total = n_attn + n_f1 + n_sgu;
          const float* sinkl = p.in[11] + l * 8; const float* sgub = p.in[8] + l * 512;
          for (int item = bid; item < total; item += G) {
              if (item < n_attn) { const bool ic = item >= 1024; const int i2 = item - 1024;
                                   attn_item(lds, QKVb, Zb, sinkl, ic ? (i2 >> 3) : (item >> 8), ic ? ((i2 >> 2) & 1) : ((item >> 2) & 63), (item >> 1) & 1, item & 1, ic, tid, lane, wave, dry); }
              else if (item < n_attn + n_f1) { const int i2 = item - n_attn; f1_item(lds, (const bf16_t*)(ws + WS_G), (bf16_t*)(ws + WS_H), (const bf16_t*)(ws + WS_T128), i2 >> 6, i2 & 63, tid, lane, wave); }
              else { sgu_item(lds, (const bf16_t*)(ws + WS_U), Zb, (const bf16_t*)(ws + WS_SGUW), sgub, item - n_attn - n_f1, tid, lane, wave, dry); }
          } }
#endif
        GSYNC();
#ifndef SKIP_P4
#pragma unroll 1
        for (int rep = (PROBE_DUP == 4 ? 0 : 1); rep < 2; ++rep) { PHASE_IDS(); const bool dry = rep == 0;
          bf16_t* Zb = (bf16_t*)(ws + WS_Z);
          const int total = last ? 512 : 520;
          for (int item = bid; item < total; item += G) {
              if (item < 512) f3_item(lds, (const bf16_t*)(ws + WS_H), Zb, (const bf16_t*)(ws + WS_T3), item >> 7, item & 127, tid, lane, wave, dry);
              else { const int i2 = item - 512; fc_item(lds, (const bf16_t*)(ws + WS_G), Zb, (const bf16_t*)(ws + WS_TC), i2 >> 1, i2 & 1, tid, lane, wave, dry); }
          } }
#endif
        GSYNC();
#ifndef SKIP_P5
#pragma unroll 1
        for (int seg = (PROBE_DUP == 5 ? -3 : 0); seg < 3; ++seg) { PHASE_IDS(); const int sg_ = seg < 0 ? seg + 3 : seg;
          const int Mrows = last ? ML : MT; pg8::StaticOrder S; S.init(Mrows, 1024, G, bid);
          const bf16_t* Zb = (const bf16_t*)(ws + WS_Z);
          const size_t woff = sg_ == 0 ? W_PA_OFF : (sg_ == 1 ? W_PB_OFF : W_PC_OFF);
          pg8::Gemm g{Zb + sg_ * 256, (const bf16_t*)(ws + WS_W + woff), Mrows, 1024, sg_ == 2 ? 512 : 256, 1024};
          pg8::EpiMerge E{(const bf16_t*)(ws + WS_GT), (bf16_t*)(ws + WS_H), sg_};
          pg8::gemm_phase<pg8::EpiMerge>(lds, g, S, E, tid); }
#endif
        GSYNC();
#ifndef SKIP_P6
#pragma unroll 1
        for (int rep = (PROBE_DUP == 6 ? 0 : 1); rep < 2; ++rep) { PHASE_IDS();
          const int Mrows = last ? ML : MT; pg8::StaticOrder S; S.init(Mrows, 1024, G, bid);
          pg8::Gemm g{(const bf16_t*)(ws + WS_H), (const bf16_t*)(ws + WS_W + W_OUT_OFF), Mrows, 1024, 1024, 1024};
          float* XC = (float*)(ws + WS_XC);
          pg8::EpiRes E{l == 0 ? p.in[0] : p.out, p.out, l == 0 ? p.in[2] : XC, XC, rep == 0 ? (const float*)(ws + WS_ROPE + 65536) : (const float*)(ws + WS_MOD) + (size_t)l * 5 * 3072};
          pg8::gemm_phase<pg8::EpiRes>(lds, g, S, E, tid); }
#endif
        if (!last) GSYNC();
    }
}

extern "C" void kernel_launch(void* const* d_in, const int* in_sizes, int n_in, void* d_out, int out_size, void* d_ws, size_t ws_size, hipStream_t stream) {
    static int grid = 0;
    if (grid == 0) {
        if (n_in != 16 || ws_size < WS_END) { fprintf(stderr, "kernel_launch: unexpected inputs (n_in %d, ws %zu)\n", n_in, ws_size); grid = -1; return; }
        int dev = 0, cus = 0, per_cu = 0;
        hipGetDevice(&dev);
        hipDeviceGetAttribute(&cus, hipDeviceAttributeMultiprocessorCount, dev);
        hipFuncSetAttribute((const void*)fwd_megakernel, hipFuncAttributeMaxDynamicSharedMemorySize, LDS_BYTES);
        hipOccupancyMaxActiveBlocksPerMultiprocessor(&per_cu, (const void*)fwd_megakernel, 512, LDS_BYTES);
        if (per_cu < 1 || cus < 1) { fprintf(stderr, "kernel_launch: occupancy query gave %d blocks/CU on %d CUs\n", per_cu, cus); grid = -1; return; }
        grid = cus;
    }
    if (grid < 0) return;
    if (hipMemsetAsync((char*)d_ws + WS_BAR, 0, XCD_BAR_WORDS * 4, stream) != hipSuccess) { fprintf(stderr, "kernel_launch: memset of barrier words failed\n"); return; }
    Params p{};
    for (int i = 0; i < 16; ++i) p.in[i] = (const float*)d_in[i];
    p.out = (float*)d_out; p.ws = (unsigned char*)d_ws;
    void* args[] = {&p};
    hipError_t e = hipLaunchCooperativeKernel((const void*)fwd_megakernel, dim3(grid), dim3(512), args, LDS_BYTES, stream);
    if (e != hipSuccess) fprintf(stderr, "cooperative launch failed: %s (grid %d)\n", hipGetErrorString(e), grid);
}
```

```cpp
#include <hip/hip_runtime.h>
#include <hip/hip_cooperative_groups.h>
#include <cstdio>
#include <cstdint>
namespace cg = cooperative_groups;

#define LAS __attribute__((address_space(3)))
typedef unsigned short bf16_t;
typedef short bf16x8 __attribute__((ext_vector_type(8)));
typedef short s16x4 __attribute__((ext_vector_type(4)));
typedef float f32x4 __attribute__((ext_vector_type(4)));
typedef unsigned u32x4 __attribute__((ext_vector_type(4)));
typedef unsigned u32x2 __attribute__((ext_vector_type(2)));
typedef float f32x2_t __attribute__((ext_vector_type(2)));
typedef __bf16 bf16x2_t __attribute__((ext_vector_type(2)));

constexpr int DM = 1024, NB = 4, SEQ = 8192, DEPTH = 4, CTXL = 256;
constexpr int ML = NB * SEQ;
constexpr int MC = NB * CTXL;
constexpr int MT = ML + MC;
constexpr int INW = 5632;
constexpr int NIN = 5888;
constexpr float EPSV = 1e-6f;
constexpr float LOG2E = 1.4426950408889634f;

constexpr size_t MiB = 1u << 20;
constexpr size_t WS_MOD = 0;
constexpr size_t WS_ROPE = 256 * 1024;
constexpr size_t WS_T128 = 512 * 1024;
constexpr size_t WS_TC = 1 * MiB;
constexpr size_t WS_T3 = 2 * MiB;
constexpr size_t WS_SGUW = 4 * MiB;
constexpr size_t WS_BAR = 6 * MiB;
constexpr size_t WS_XC = 8 * MiB;
constexpr size_t WS_W = 16 * MiB;
constexpr size_t W_IN_OFF = 0, W_PA_OFF = (size_t)NIN * 1024 * 2, W_PB_OFF = W_PA_OFF + 1024 * 256 * 2, W_PC_OFF = W_PB_OFF + 1024 * 256 * 2, W_OUT_OFF = W_PC_OFF + 1024 * 512 * 2;
constexpr size_t WS_H = 32 * MiB;
constexpr size_t WS_G = 98 * MiB;
constexpr size_t WS_Z = 131 * MiB;
constexpr size_t WS_U = 197 * MiB;
constexpr size_t WS_QKV = 230 * MiB;
constexpr size_t WS_GT = 280 * MiB;
constexpr size_t WS_END = 478 * MiB;
static_assert(W_OUT_OFF + 1024 * 1024 * 2 <= 16 * MiB, "weights fit");

constexpr int LDS_BYTES = 147456;
#ifndef PROBE_DUP
#define PROBE_DUP 0
#endif

__device__ __forceinline__ unsigned cvtpk(float lo, float hi) { f32x2_t v = {lo, hi}; bf16x2_t b = __builtin_convertvector(v, bf16x2_t); return __builtin_bit_cast(unsigned, b); }
__device__ __forceinline__ float bflo(unsigned w) { return __uint_as_float(w << 16); }
__device__ __forceinline__ float bfhi(unsigned w) { return __uint_as_float(w & 0xffff0000u); }
__device__ __forceinline__ float silu_f(float v) { return v * __builtin_amdgcn_rcpf(1.f + __expf(-v)); }
__device__ __forceinline__ float sigm_f(float v) { return __builtin_amdgcn_rcpf(1.f + __expf(-v)); }
typedef short v4i16_t __attribute__((ext_vector_type(4)));
__device__ __forceinline__ s16x4 lds_tr(const LAS unsigned char* p) { return __builtin_bit_cast(s16x4, __builtin_amdgcn_ds_read_tr16_b64_v4i16((LAS v4i16_t*)p)); }
__device__ __forceinline__ bf16x8 cat8(s16x4 a, s16x4 b) { return (bf16x8){a[0], a[1], a[2], a[3], b[0], b[1], b[2], b[3]}; }

namespace pg8 {
constexpr int BM = 256, BK = 64, HALF = 128, HTB = HALF * BK * 2, STAGE_BYTES = 8 * HTB, NXCD = 8, WGM = 8;
__host__ __device__ __forceinline__ int lds_byte(int r, int c) { const int st = (r >> 4) * 2 + (c >> 5), rr = r & 15, cc = c & 31, ob = rr * 64 + cc * 2; return st * 1024 + (ob ^ (((ob >> 9) & 1) << 5)); }
__host__ __device__ __forceinline__ void stage_rc(int b, int& R, int& C) { const int st = b / 1024, sb = b % 1024, swz = sb ^ (((sb >> 9) & 1) << 5); R = (st >> 1) * 16 + swz / 64; C = (st & 1) * 32 + (swz % 64) / 2; }
__host__ __device__ __forceinline__ int perm32(int rho) { const int n = rho >> 4, i = rho & 15; return 8 * (i >> 2) + 4 * n + (i & 3); }
struct Unit { int pm, pn; };
struct Gemm { const bf16_t* A; const bf16_t* Bt; int M, N, K, lda; };
struct StaticOrder {
    int nM, nN, nwg, G, c;
    __host__ __device__ void init(int M, int N, int G_, int c_) { nM = M / BM; nN = N / BM; nwg = nM * nN; G = G_; c = c_; }
    __host__ __device__ bool next(int i, Unit& u) const {
        const long L = (long)i * G + c; if (L >= nwg) return false;
        int wgid = (int)L; { const int q = nwg / NXCD, r = nwg % NXCD, xcd = wgid % NXCD, off = wgid / NXCD; wgid = (xcd < r ? xcd * (q + 1) : r * (q + 1) + (xcd - r) * q) + off; }
        const int nig = WGM * nN, gid = wgid / nig, fm = gid * WGM, gsz = (nM - fm) < WGM ? (nM - fm) : WGM;
        u.pm = fm + ((wgid % nig) % gsz); u.pn = (wgid % nig) / gsz; return true;
    }
};
template <class Epi>
__device__ __forceinline__ void gemm_phase(LAS unsigned char* lds, const Gemm g, const StaticOrder& S, const Epi& E, const int tid) {
    const int wid = __builtin_amdgcn_readfirstlane(tid >> 6), lane = tid & 63, wr = wid >> 2, wc = wid & 3, fr = lane & 15, fq = lane >> 4;
    const int K = g.K, nt = K / BK, lda = g.lda;
    unsigned voffA[2], voffB[2];
#pragma unroll
    for (int i = 0; i < 2; ++i) { int R, C; stage_rc(tid * 16 + i * 8192, R, C); const int Rb = Epi::PERM ? ((R & ~31) + perm32(R & 31)) : R;
        voffA[i] = (unsigned)(R * lda + C) * 2u; voffB[i] = (unsigned)(Rb * K + C) * 2u; }
    const size_t kstep = (size_t)(BK * 2);
    const size_t hstepA = (size_t)HALF * lda * 2, hstepB = (size_t)HALF * K * 2;
    const size_t tstepA = 2 * hstepA, tstepB = 2 * hstepB;
    const unsigned ldsw = (unsigned)wid * 1024u;
    const int aoff = lds_byte(wr * 64 + fr, fq * 8), boff = lds_byte(wc * 32 + fr, fq * 8);
#define PG8_SA(b, h) (((b) * 2 + (h)) * HTB)
#define PG8_SB(b, h) ((4 + (b) * 2 + (h)) * HTB)
#define PG8_STAGE(bufoff, gbase, voff) do { _Pragma("unroll") for (int _i = 0; _i < 2; ++_i) \
        __builtin_amdgcn_global_load_lds((const unsigned*)((const char*)(gbase) + (voff)[_i]), (LAS unsigned*)(lds + (bufoff) + ldsw + _i * 8192), 16, 0, 0); } while (0)
#define PG8_LDA(dst, b, h) do { _Pragma("unroll") for (int m = 0; m < 4; ++m) _Pragma("unroll") for (int k = 0; k < 2; ++k) dst[m][k] = *(const LAS bf16x8*)(lds + PG8_SA(b, h) + aoff + m * 2048 + k * 1024); } while (0)
#define PG8_LDB(dst, b, h) do { _Pragma("unroll") for (int n = 0; n < 2; ++n) _Pragma("unroll") for (int k = 0; k < 2; ++k) dst[n][k] = *(const LAS bf16x8*)(lds + PG8_SB(b, h) + boff + n * 2048 + k * 1024); } while (0)
#define PG8_MMA(ai, bj, At, Bt) do { __builtin_amdgcn_s_setprio(1); _Pragma("unroll") for (int m = 0; m < 4; ++m) _Pragma("unroll") for (int n = 0; n < 2; ++n) _Pragma("unroll") for (int k = 0; k < 2; ++k) \
        acc[ai][bj][m][n] = __builtin_amdgcn_mfma_f32_16x16x32_bf16(Bt[n][k], At[m][k], acc[ai][bj][m][n], 0, 0, 0); __builtin_amdgcn_s_setprio(0); } while (0)
#define PG8_WAIT_V(n) asm volatile("s_waitcnt vmcnt(" #n ")" ::: "memory")
#define PG8_WAIT_L(n) asm volatile("s_waitcnt lgkmcnt(" #n ")" ::: "memory")
#define PG8_BAR __builtin_amdgcn_s_barrier()
#define PG8_SCHED __builtin_amdgcn_sched_barrier(0)
    Unit cur, nxt; int ui = 0;
    if (!S.next(0, cur)) return;
    f32x4 acc[2][2][4][2];
#pragma unroll
    for (int a = 0; a < 2; ++a)
#pragma unroll
        for (int b = 0; b < 2; ++b)
#pragma unroll
            for (int m = 0; m < 4; ++m)
#pragma unroll
                for (int n = 0; n < 2; ++n) acc[a][b][m][n] = (f32x4){0.f, 0.f, 0.f, 0.f};
    bf16x8 At[4][2], B0[2][2], B1[2][2];
    const char* cA = (const char*)g.A + (size_t)cur.pm * tstepA; const char* cB = (const char*)g.Bt + (size_t)cur.pn * tstepB;
    PG8_STAGE(PG8_SB(0, 0), cB, voffB); PG8_STAGE(PG8_SB(0, 1), cB + hstepB, voffB); PG8_STAGE(PG8_SA(0, 0), cA, voffA); PG8_STAGE(PG8_SA(0, 1), cA + hstepA, voffA);
    if (wr == 1) PG8_BAR;
    PG8_WAIT_V(2); PG8_BAR;
    PG8_STAGE(PG8_SB(1, 0), cB + kstep, voffB); PG8_STAGE(PG8_SA(1, 0), cA + kstep, voffA); PG8_STAGE(PG8_SB(1, 1), cB + hstepB + kstep, voffB);
    PG8_WAIT_V(6); PG8_BAR;
    for (;;) {
        const bool has_next = S.next(ui + 1, nxt);
        const char* nA = has_next ? (const char*)g.A + (size_t)nxt.pm * tstepA : cA; const char* nB = has_next ? (const char*)g.Bt + (size_t)nxt.pn * tstepB : cB;
        for (int t = 0; t < nt; t += 2) {
            const bool last = (t == nt - 2);
            const char* a1 = cA + (size_t)(t + 1) * kstep;
            const char* a2 = last ? nA : cA + (size_t)(t + 2) * kstep; const char* b2 = last ? nB : cB + (size_t)(t + 2) * kstep;
            const char* a3 = a2 + kstep; const char* b3 = b2 + kstep;
            PG8_LDB(B0, 0, 0); PG8_LDB(B1, 0, 1); PG8_SCHED; PG8_LDA(At, 0, 0); PG8_STAGE(PG8_SA(1, 1), a1 + hstepA, voffA);
            PG8_WAIT_V(8); PG8_WAIT_L(0); PG8_BAR; PG8_MMA(0, 0, At, B0); PG8_MMA(0, 1, At, B1); PG8_BAR; PG8_SCHED;
            PG8_LDA(At, 0, 1); PG8_STAGE(PG8_SB(0, 0), b2, voffB); PG8_STAGE(PG8_SB(0, 1), b2 + hstepB, voffB); PG8_STAGE(PG8_SA(0, 0), a2, voffA);
            PG8_WAIT_V(8); PG8_WAIT_L(0); PG8_BAR; PG8_MMA(1, 0, At, B0); PG8_MMA(1, 1, At, B1); PG8_BAR; PG8_SCHED;
            PG8_LDB(B0, 1, 0); PG8_LDB(B1, 1, 1); PG8_SCHED; PG8_LDA(At, 1, 0); PG8_STAGE(PG8_SA(0, 1), a2 + hstepA, voffA);
            PG8_WAIT_V(8); PG8_WAIT_L(0); PG8_BAR; PG8_MMA(0, 0, At, B0); PG8_MMA(0, 1, At, B1); PG8_BAR; PG8_SCHED;
            PG8_LDA(At, 1, 1); PG8_STAGE(PG8_SB(1, 0), b3, voffB); PG8_STAGE(PG8_SB(1, 1), b3 + hstepB, voffB); PG8_STAGE(PG8_SA(1, 0), a3, voffA);
            PG8_WAIT_V(8); PG8_WAIT_L(0); PG8_BAR; PG8_MMA(1, 0, At, B0); PG8_MMA(1, 1, At, B1); PG8_BAR; PG8_SCHED;
        }
        if (wr == 0) PG8_BAR;
        E(acc, cur, wr, wc, fr, fq);
        if (!has_next) break;
#pragma unroll
        for (int a = 0; a < 2; ++a)
#pragma unroll
            for (int b = 0; b < 2; ++b)
#pragma unroll
                for (int m = 0; m < 4; ++m)
#pragma unroll
                    for (int n = 0; n < 2; ++n) acc[a][b][m][n] = (f32x4){0.f, 0.f, 0.f, 0.f};
        cur = nxt; cA = nA; cB = nB; ++ui;
        if (wr == 1) PG8_BAR;
    }
    PG8_WAIT_V(0);
    PG8_BAR;
#undef PG8_SA
#undef PG8_SB
#undef PG8_STAGE
#undef PG8_LDA
#undef PG8_LDB
#undef PG8_MMA
#undef PG8_WAIT_V
#undef PG8_WAIT_L
#undef PG8_BAR
#undef PG8_SCHED
}

struct EpiProj {
    static constexpr bool PERM = true;
    bf16_t *Gb, *Zb, *Ub, *QKVb, *GTb; const float *rope, *qg, *kg;
    __device__ __forceinline__ void operator()(const f32x4 (&acc)[2][2][4][2], const Unit& u, int wr, int wc, int fr, int fq) const {
        const int pn = u.pn;
        const int row0 = u.pm * BM + wr * 64 + fr;
        if (pn >= 6 && pn <= 8) {
            const bool isq = pn < 8;
            if (!isq && wc >= 2) {
#pragma unroll
                for (int ai = 0; ai < 2; ++ai)
#pragma unroll
                    for (int m = 0; m < 4; ++m) { bf16_t* rowp = QKVb + (size_t)(row0 + ai * HALF + m * 16) * 768 + 640 + (wc - 2) * 64 + 8 * fq;
#pragma unroll
                        for (int bj = 0; bj < 2; ++bj) { const f32x4 v0 = acc[ai][bj][m][0], v1 = acc[ai][bj][m][1];
                            u32x4 w; w.x = cvtpk(v0[0], v0[1]); w.y = cvtpk(v0[2], v0[3]); w.z = cvtpk(v1[0], v1[1]); w.w = cvtpk(v1[2], v1[3]);
                            *(u32x4*)(rowp + bj * 32) = w; } }
            } else {
                const int head = isq ? (pn - 6) * 4 + wc : wc;
                const float* gain = isq ? qg : kg;
                const int cbase = (isq ? 0 : 512) + head * 64 + 4 * fq;
                const float scale = isq ? 0.125f * LOG2E : 1.f;
                const bool dorope = u.pm < (ML / BM);
                const f32x4 g1a = *(const f32x4*)(gain + 4 * fq), g2a = *(const f32x4*)(gain + 16 + 4 * fq), g1b = *(const f32x4*)(gain + 32 + 4 * fq), g2b = *(const f32x4*)(gain + 48 + 4 * fq);
#pragma unroll
                for (int ai = 0; ai < 2; ++ai)
#pragma unroll
                    for (int m = 0; m < 4; ++m) { const int row = row0 + ai * HALF + m * 16;
                        f32x4 x1a = acc[ai][0][m][0], x2a = acc[ai][0][m][1], x1b = acc[ai][1][m][0], x2b = acc[ai][1][m][1];
                        float ss = 0.f;
#pragma unroll
                        for (int e = 0; e < 4; ++e) ss += (x1a[e] * x1a[e] + x2a[e] * x2a[e]) + (x1b[e] * x1b[e] + x2b[e] * x2b[e]);
                        ss += __shfl_xor(ss, 16); ss += __shfl_xor(ss, 32);
                        const float rinv = rsqrtf(ss * (1.f / 64.f) + EPSV);
                        x1a = x1a * rinv * g1a; x2a = x2a * rinv * g2a; x1b = x1b * rinv * g1b; x2b = x2b * rinv * g2b;
                        if (dorope) { const int t = row & (SEQ - 1);
                            const float* ra = rope + ((t >> 6) * 16 + 4 * fq) * 2; const f32x4 a0 = *(const f32x4*)ra, a1 = *(const f32x4*)(ra + 4);
                            const float* rb = rope + ((t & 63) * 16 + 4 * fq) * 2; const f32x4 b0 = *(const f32x4*)rb, b1 = *(const f32x4*)(rb + 4);
                            const f32x4 ca = {a0[0], a0[2], a1[0], a1[2]}, sa = {a0[1], a0[3], a1[1], a1[3]}, cb = {b0[0], b0[2], b1[0], b1[2]}, sb = {b0[1], b0[3], b1[1], b1[3]};
                            const f32x4 y1a = x1a * ca - x2a * sa, y2a = x2a * ca + x1a * sa, y1b = x1b * cb - x2b * sb, y2b = x2b * cb + x1b * sb;
                            x1a = y1a; x2a = y2a; x1b = y1b; x2b = y2b; }
                        x1a = x1a * scale; x2a = x2a * scale; x1b = x1b * scale; x2b = x2b * scale;
                        bf16_t* dp = QKVb + (size_t)row * 768 + cbase;
                        u32x2 w;
                        w.x = cvtpk(x1a[0], x1a[1]); w.y = cvtpk(x1a[2], x1a[3]); *(u32x2*)dp = w;
                        w.x = cvtpk(x2a[0], x2a[1]); w.y = cvtpk(x2a[2], x2a[3]); *(u32x2*)(dp + 16) = w;
                        w.x = cvtpk(x1b[0], x1b[1]); w.y = cvtpk(x1b[2], x1b[3]); *(u32x2*)(dp + 32) = w;
                        w.x = cvtpk(x2b[0], x2b[1]); w.y = cvtpk(x2b[2], x2b[3]); *(u32x2*)(dp + 48) = w; }
            }
            return;
        }
        bf16_t* base; int ld, c0, act;
        if (pn < 2) { base = Gb; ld = 512; c0 = pn * 256; act = 0; }
        else if (pn == 2) { base = Zb; ld = 1024; c0 = 0; act = 1; }
        else if (pn == 3) { base = Ub; ld = 512; c0 = 0; act = 0; }
        else if (pn == 4) { base = Ub; ld = 512; c0 = 256; act = 0; }
        else if (pn == 5) { base = Zb; ld = 1024; c0 = 256; act = 1; }
        else if (pn < 11) { base = Zb; ld = 1024; c0 = 512 + (pn - 9) * 256; act = 1; }
        else { base = GTb; ld = 3072; c0 = (pn - 11) * 256; act = 2; }
        const int col0 = c0 + wc * 32 + 8 * fq;
#pragma unroll
        for (int ai = 0; ai < 2; ++ai)
#pragma unroll
            for (int m = 0; m < 4; ++m) { bf16_t* rowp = base + (size_t)(row0 + ai * HALF + m * 16) * ld + col0;
#pragma unroll
                for (int bj = 0; bj < 2; ++bj) { f32x4 v0 = acc[ai][bj][m][0], v1 = acc[ai][bj][m][1];
                    if (act == 1) {
#pragma unroll
                        for (int e = 0; e < 4; ++e) { v0[e] = silu_f(v0[e]); v1[e] = silu_f(v1[e]); } }
                    else if (act == 2) {
#pragma unroll
                        for (int e = 0; e < 4; ++e) { v0[e] = sigm_f(v0[e]); v1[e] = sigm_f(v1[e]); } }
                    u32x4 w; w.x = cvtpk(v0[0], v0[1]); w.y = cvtpk(v0[2], v0[3]); w.z = cvtpk(v1[0], v1[1]); w.w = cvtpk(v1[2], v1[3]);
                    *(u32x4*)(rowp + bj * HALF) = w; } }
    }
};
struct EpiMerge {
    static constexpr bool PERM = true;
    const bf16_t* GTb; bf16_t* MG; int seg;
    __device__ __forceinline__ void operator()(const f32x4 (&acc)[2][2][4][2], const Unit& u, int wr, int wc, int fr, int fq) const {
        const int row0 = u.pm * BM + wr * 64 + fr, col0 = u.pn * BM + wc * 32 + 8 * fq;
#pragma unroll
        for (int ai = 0; ai < 2; ++ai)
#pragma unroll
            for (int m = 0; m < 4; ++m) { const size_t row = (size_t)(row0 + ai * HALF + m * 16);
#pragma unroll
                for (int bj = 0; bj < 2; ++bj) { const int col = col0 + bj * HALF;
                    const u32x4 gw = *(const u32x4*)(GTb + row * 3072 + seg * 1024 + col);
                    f32x4 v0 = acc[ai][bj][m][0], v1 = acc[ai][bj][m][1];
                    v0[0] *= bflo(gw.x); v0[1] *= bfhi(gw.x); v0[2] *= bflo(gw.y); v0[3] *= bfhi(gw.y);
                    v1[0] *= bflo(gw.z); v1[1] *= bfhi(gw.z); v1[2] *= bflo(gw.w); v1[3] *= bfhi(gw.w);
                    bf16_t* mp = MG + row * 1024 + col;
                    if (seg != 0) { const u32x4 mw = *(const u32x4*)mp;
                        v0[0] += bflo(mw.x); v0[1] += bfhi(mw.x); v0[2] += bflo(mw.y); v0[3] += bfhi(mw.y);
                        v1[0] += bflo(mw.z); v1[1] += bfhi(mw.z); v1[2] += bflo(mw.w); v1[3] += bfhi(mw.w); }
                    u32x4 w; w.x = cvtpk(v0[0], v0[1]); w.y = cvtpk(v0[2], v0[3]); w.z = cvtpk(v1[0], v1[1]); w.w = cvtpk(v1[2], v1[3]);
                    *(u32x4*)mp = w; } }
    }
};
struct EpiRes {
    static constexpr bool PERM = false;
    const float* xsrc; float* xdst; const float* csrc; float* cdst; const float* modl;
    __device__ __forceinline__ void operator()(const f32x4 (&acc)[2][2][4][2], const Unit& u, int wr, int wc, int fr, int fq) const {
        const bool isctx = u.pm >= (ML / BM);
        const int rbase = u.pm * BM + wr * 64 + fr;
        const int bi = isctx ? 4 : (rbase >> 13);
        const float* src = isctx ? csrc + (size_t)(rbase - ML) * DM : xsrc + (size_t)rbase * DM;
        float* dst = isctx ? cdst + (size_t)(rbase - ML) * DM : xdst + (size_t)rbase * DM;
        const int col0 = u.pn * BM + wc * 32 + 4 * fq;
#pragma unroll
        for (int bj = 0; bj < 2; ++bj)
#pragma unroll
            for (int n = 0; n < 2; ++n) { const int col = col0 + bj * HALF + n * 16;
                const f32x4 gt = *(const f32x4*)(modl + bi * 3072 + 2048 + col);
#pragma unroll
                for (int ai = 0; ai < 2; ++ai)
#pragma unroll
                    for (int m = 0; m < 4; ++m) { const size_t off = (size_t)(ai * HALF + m * 16) * DM + col;
                        const f32x4 xs = *(const f32x4*)(src + off);
                        *(f32x4*)(dst + off) = xs + gt * acc[ai][bj][m][n]; } }
    }
};
}

template <int NI, int NJ, int KS>
__device__ __forceinline__ void act_gemm(f32x4 (&acc)[NI][NJ], const LAS unsigned char* act, int RS, int n0, const bf16_t* tab, int ldt, int lane) {
    const int g = lane >> 4, c = lane & 15;
    const LAS unsigned char* abase = act + (8 * g + (c >> 2)) * RS + (n0 + 4 * (c & 3)) * 2;
    const bf16_t* tbase = tab + (size_t)c * ldt + 8 * g;
#pragma unroll 2
    for (int ks = 0; ks < KS; ++ks) {
        bf16x8 a[NI], b[NJ];
#pragma unroll
        for (int i = 0; i < NI; ++i) { const s16x4 lo = lds_tr(abase + ks * 32 * RS + i * 32), hi = lds_tr(abase + (ks * 32 + 4) * RS + i * 32); a[i] = cat8(lo, hi); }
#pragma unroll
        for (int j = 0; j < NJ; ++j) b[j] = *(const bf16x8*)(tbase + (size_t)j * 16 * ldt + ks * 32);
#pragma unroll
        for (int i = 0; i < NI; ++i)
#pragma unroll
            for (int j = 0; j < NJ; ++j) acc[i][j] = __builtin_amdgcn_mfma_f32_16x16x32_bf16(a[i], b[j], acc[i][j], 0, 0, 0);
    }
}
template <int NI, int NJ> __device__ __forceinline__ void zero_acc(f32x4 (&acc)[NI][NJ]) {
#pragma unroll
    for (int i = 0; i < NI; ++i)
#pragma unroll
        for (int j = 0; j < NJ; ++j) acc[i][j] = (f32x4){0.f, 0.f, 0.f, 0.f};
}
__device__ __forceinline__ void mul_store4(bf16_t* p, f32x4 v, bool dry = false) {
    if (dry && v[0] != 1.2345e30f) return;
    const u32x2 z = *(const u32x2*)p;
    u32x2 o; o.x = cvtpk(v[0] * bflo(z.x), v[1] * bfhi(z.x)); o.y = cvtpk(v[2] * bflo(z.y), v[3] * bfhi(z.y));
    *(u32x2*)p = o;
}

struct Params { const float* in[16]; float* out; unsigned char* ws; };

__device__ __forceinline__ void phase0(const Params& p, LAS unsigned char* lds, int tid, int bid, int G) {
    LAS float* sc = (LAS float*)lds;
    LAS float* red = (LAS float*)(lds + 20480);
    for (int i = tid; i < 5120; i += 512) { const float v = i < 4096 ? p.in[1][i] : p.in[3][i - 4096]; sc[i] = v / (1.f + expf(-v)); }
    __syncthreads();
    float* mod = (float*)(p.ws + WS_MOD);
    for (int item = bid; item < 192; item += G) {
        const int l = item / 48, cgp = item % 48, col = tid & 63, kg = tid >> 6, n = cgp * 64 + col;
        const float* w = p.in[4] + ((size_t)l * 1024 + kg * 128) * 3072 + n;
        float a0 = 0.f, a1 = 0.f, a2 = 0.f, a3 = 0.f, a4 = 0.f;
#pragma unroll 8
        for (int k = 0; k < 128; ++k) { const float wv = w[(size_t)k * 3072]; const int kk = kg * 128 + k;
            a0 += sc[kk] * wv; a1 += sc[1024 + kk] * wv; a2 += sc[2048 + kk] * wv; a3 += sc[3072 + kk] * wv; a4 += sc[4096 + kk] * wv; }
        red[(kg * 5 + 0) * 64 + col] = a0; red[(kg * 5 + 1) * 64 + col] = a1; red[(kg * 5 + 2) * 64 + col] = a2; red[(kg * 5 + 3) * 64 + col] = a3; red[(kg * 5 + 4) * 64 + col] = a4;
        __syncthreads();
        if (tid < 320) { const int bi = tid >> 6, c2 = tid & 63; float s = 0.f;
#pragma unroll
            for (int k2 = 0; k2 < 8; ++k2) s += red[(k2 * 5 + bi) * 64 + c2];
            mod[(l * 5 + bi) * 3072 + cgp * 64 + c2] = s + p.in[5][l * 3072 + cgp * 64 + c2]; }
        __syncthreads();
    }
    const int gt = bid * 512 + tid, NT = G * 512;
    float* rope = (float*)(p.ws + WS_ROPE);
    for (int i = gt; i < 5 * 3072; i += NT) ((float*)(p.ws + WS_ROPE + 65536))[i] = 0.f;
    for (int i = gt; i < 2048; i += NT) { const int pos = i >> 4, fi = i & 15; const float inv = powf(10000.f, -(float)fi / 16.f); const float ang = (float)pos * inv; float s, c; sincosf(ang, &s, &c); rope[2 * i] = c; rope[2 * i + 1] = s; }
    bf16_t* t128 = (bf16_t*)(p.ws + WS_T128);
    for (int i = gt; i < 65536; i += NT) { const int m = i >> 8, k = i & 255, part = m >> 7, k1 = m & 127, pp = k >> 7, l1 = k & 127; const int j = (l1 * k1) & 127; float s, c; sincospif((float)j / 64.f, &s, &c);
        const float v = (part == pp) ? c : (part == 0 ? s : -s); t128[i] = (bf16_t)(cvtpk(v, 0.f) & 0xffffu); }
    bf16_t* tc = (bf16_t*)(p.ws + WS_TC);
    for (int i = gt; i < 256 * 512; i += NT) { const int kk = i >> 9, k = i & 511, part = k >> 8, ll = k & 255; const int j = (kk * ll) & 255; float s, c; sincospif((float)j / 128.f, &s, &c);
        const float v = (part ? s : c) * 0.0625f; tc[i] = (bf16_t)(cvtpk(v, 0.f) & 0xffffu); }
    bf16_t* t3 = (bf16_t*)(p.ws + WS_T3);
    for (int i = gt; i < 128 * 64 * 128; i += NT) { const int k1 = i >> 13, k2 = (i >> 7) & 63, kp = i & 127, l2 = kp >> 1, part = kp & 1; const int j = (l2 * (k1 + 128 * k2)) & 8191; float s, c; sincospif((float)j / 4096.f, &s, &c);
        const float v = (part ? s : c) * 0.011048543456039806f; t3[i] = (bf16_t)(cvtpk(v, 0.f) & 0xffffu); }
}

__device__ __forceinline__ void transpose_blk(const float* Wsrc, int ldw, int K, bf16_t* WTdst, int kb, int perm, LAS float* scr, int lane) {
    const int k0 = 64 * kb;
#pragma unroll 8
    for (int i = 0; i < 32; ++i) { const int kk = 2 * i + (lane >> 5); scr[kk * 33 + (lane & 31)] = Wsrc[(size_t)(k0 + kk) * ldw + (lane & 31)]; }
    asm volatile("s_waitcnt lgkmcnt(0)" ::: "memory");
    const int c = lane & 7;
#pragma unroll
    for (int j = 0; j < 4; ++j) { const int n = (lane >> 3) + 8 * j; const int sc = perm ? (16 * ((n >> 2) & 1) + 4 * (n >> 3) + (n & 3)) : n; const LAS float* s = scr + (8 * c) * 33 + sc;
        u32x4 o; o.x = cvtpk(s[0 * 33], s[1 * 33]); o.y = cvtpk(s[2 * 33], s[3 * 33]); o.z = cvtpk(s[4 * 33], s[5 * 33]); o.w = cvtpk(s[6 * 33], s[7 * 33]);
        *(u32x4*)(WTdst + (size_t)n * K + k0 + 8 * c) = o; }
    asm volatile("s_waitcnt lgkmcnt(0)" ::: "memory");
}
__device__ __forceinline__ void phase1(const Params& p, LAS unsigned char* lds, int l, int tid, int lane, int wave, int bid, int G) {
    unsigned char* wsW = p.ws + WS_W;
    bf16_t* WinT = (bf16_t*)(wsW + W_IN_OFF);
    LAS float* scr = (LAS float*)(lds + wave * 8448);
    LAS float* ctab = (LAS float*)(lds + 8 * 8448);
    if (tid < 64) { float s, c; sincospif((float)tid / 32.f, &s, &c); ctab[tid] = c * 0.125f; ctab[64 + tid] = s * 0.125f; }
    __syncthreads();
    const int gw = bid * 8 + wave, NGW = G * 8;
    const float* win = p.in[6] + (size_t)l * 1024 * INW;
    constexpr int I_IN = 16 * 168, I_PA = 4 * 32, I_PC = 8 * 32, I_OUT = 16 * 32;
    for (int it = gw; it < I_IN + 2 * I_PA + I_PC + I_OUT; it += NGW) {
        int r = it;
        if (r < I_IN) { const int rb = 16 + r % 168, kb = r / 168, n = rb * 32; int c0, perm = 0;
            if (n < 1536 || n >= 2304) c0 = n - 256;
            else if (n < 2048) { const int t = n - 1536, tile = t >> 8, tt = t & 255, bj = tt >> 7, wc = (tt >> 5) & 3; c0 = 1280 + (tile * 4 + wc) * 64 + 32 * bj; perm = 1; }
            else { const int tt = n - 2048, bj = tt >> 7, wc = (tt >> 5) & 3; if (wc < 2) { c0 = 1792 + wc * 64 + 32 * bj; perm = 1; } else c0 = 1920 + (wc - 2) * 64 + 32 * bj; }
            transpose_blk(win + c0, INW, 1024, WinT + (size_t)n * 1024, kb, perm, scr, lane); continue; } r -= I_IN;
        if (r < I_PA) { transpose_blk(p.in[12] + (size_t)l * 256 * 1024 + 32 * (r & 31), 1024, 256, (bf16_t*)(wsW + W_PA_OFF) + (size_t)32 * (r & 31) * 256, r >> 5, 0, scr, lane); continue; } r -= I_PA;
        if (r < I_PA) { transpose_blk(p.in[13] + (size_t)l * 256 * 1024 + 32 * (r & 31), 1024, 256, (bf16_t*)(wsW + W_PB_OFF) + (size_t)32 * (r & 31) * 256, r >> 5, 0, scr, lane); continue; } r -= I_PA;
        if (r < I_PC) { transpose_blk(p.in[14] + (size_t)l * 512 * 1024 + 32 * (r & 31), 1024, 512, (bf16_t*)(wsW + W_PC_OFF) + (size_t)32 * (r & 31) * 512, r >> 5, 0, scr, lane); continue; } r -= I_PC;
        transpose_blk(p.in[15] + (size_t)l * 1024 * 1024 + 32 * (r & 31), 1024, 1024, (bf16_t*)(wsW + W_OUT_OFF) + (size_t)32 * (r & 31) * 1024, r >> 5, 0, scr, lane);
    }
    const int gtid = (G - 1 - bid) * 512 + tid, NT = G * 512;
    for (int id = gtid; id < 65536; id += NT) {
        const int n = id >> 7, ko = id & 127, part = n >> 8, grp = (n >> 6) & 3, m = n & 63;
        const LAS float* tb = ctab + part * 64;
        const float* wrow = win + (size_t)(ko * 8) * INW + grp * 64;
        float a[8];
#pragma unroll
        for (int j = 0; j < 8; ++j) a[j] = 0.f;
#pragma unroll 4
        for (int c4 = 0; c4 < 16; ++c4) {
            const float t0 = tb[(m * (4 * c4)) & 63], t1 = tb[(m * (4 * c4 + 1)) & 63], t2 = tb[(m * (4 * c4 + 2)) & 63], t3 = tb[(m * (4 * c4 + 3)) & 63];
#pragma unroll
            for (int j = 0; j < 8; ++j) { const f32x4 wv = *(const f32x4*)(wrow + (size_t)j * INW + c4 * 4); a[j] += wv[0] * t0 + wv[1] * t1 + wv[2] * t2 + wv[3] * t3; }
        }
        const float sg = part ? -1.f : 1.f;
        u32x4 o; o.x = cvtpk(sg * a[0], sg * a[1]); o.y = cvtpk(sg * a[2], sg * a[3]); o.z = cvtpk(sg * a[4], sg * a[5]); o.w = cvtpk(sg * a[6], sg * a[7]);
        *(u32x4*)(WinT + (size_t)n * 1024 + ko * 8) = o;
    }
    { const float* sw = p.in[7] + (size_t)l * 65536; bf16_t* dw = (bf16_t*)(p.ws + WS_SGUW);
      for (int id = gtid; id < 8192; id += NT) { const f32x4 v0 = *(const f32x4*)(sw + id * 8), v1 = *(const f32x4*)(sw + id * 8 + 4);
          u32x4 o; o.x = cvtpk(v0[0], v0[1]); o.y = cvtpk(v0[2], v0[3]); o.z = cvtpk(v1[0], v1[1]); o.w = cvtpk(v1[2], v1[3]); *(u32x4*)(dw + id * 8) = o; } }
    const float* xs = l == 0 ? p.in[0] : p.out;
    const float* cs = l == 0 ? p.in[2] : (const float*)(p.ws + WS_XC);
    const float* mod = (const float*)(p.ws + WS_MOD) + (size_t)l * 5 * 3072;
    bf16_t* H = (bf16_t*)(p.ws + WS_H);
    for (int row = gw; row < MT; row += NGW) {
        const float* src = row < ML ? xs + (size_t)row * DM : cs + (size_t)(row - ML) * DM;
        const int bi = row < ML ? (row >> 13) : 4;
        const float* md = mod + bi * 3072;
        f32x4 v[4]; float ss = 0.f;
#pragma unroll
        for (int j = 0; j < 4; ++j) { v[j] = *(const f32x4*)(src + 4 * lane + 256 * j); ss += (v[j][0] * v[j][0] + v[j][1] * v[j][1]) + (v[j][2] * v[j][2] + v[j][3] * v[j][3]); }
#pragma unroll
        for (int o = 1; o < 64; o <<= 1) ss += __shfl_xor(ss, o);
        const float rinv = rsqrtf(ss * (1.f / 1024.f) + EPSV);
#pragma unroll
        for (int j = 0; j < 4; ++j) { const int idx = 4 * lane + 256 * j; const f32x4 sh = *(const f32x4*)(md + idx), scl = *(const f32x4*)(md + 1024 + idx);
            const f32x4 o = v[j] * rinv * (scl + 1.f) + sh; u32x2 w; w.x = cvtpk(o[0], o[1]); w.y = cvtpk(o[2], o[3]); *(u32x2*)(H + (size_t)row * DM + idx) = w; }
    }
}

__device__ __forceinline__ void attn_item(LAS unsigned char* lds, const bf16_t* QKV, bf16_t* Z, const float* sinkl,
                                          int b, int blk, int kvh, int hp, bool isctx, int tid, int lane, int wave, bool dry = false) {
    constexpr int RS = 144;
    LAS unsigned char* Qs = lds; LAS unsigned char* Ks = lds + 256 * RS; LAS unsigned char* Vs = Ks + 128 * RS;
    const int qrow0 = isctx ? (ML + b * 256 + blk * 128) : (b * SEQ + blk * 128);
    __syncthreads();
#pragma unroll
    for (int it = 0; it < 4; ++it) { const int id = it * 512 + tid, r = id >> 3, c16 = id & 7, hl = r >> 7, tq = r & 127;
        *(LAS u32x4*)(Qs + r * RS + c16 * 16) = *(const u32x4*)(QKV + (size_t)(qrow0 + tq) * 768 + (kvh * 4 + hp * 2 + hl) * 64 + c16 * 8); }
    const int hl = wave >> 2, qq = wave & 3, gq = hp * 2 + hl, g = lane >> 4, c = lane & 15;
    const LAS unsigned char* qbase = Qs + (hl * 128 + qq * 32 + c) * RS + 16 * g;
    f32x4 O[4][2]; float m_run[2], l_run[2];
    const float sinkv = sinkl[kvh * 4 + gq] * LOG2E;
#pragma unroll
    for (int qi = 0; qi < 2; ++qi) { m_run[qi] = sinkv; l_run[qi] = (g == 0) ? 1.f : 0.f;
#pragma unroll
        for (int df = 0; df < 4; ++df) O[df][qi] = (f32x4){0.f, 0.f, 0.f, 0.f}; }
    const LAS unsigned char* vbase = Vs + (4 * g + (c >> 2)) * RS + (4 * (c & 3)) * 2;
    const int kvoff = 512 + kvh * 64 + (tid & 7) * 8, kr0 = tid >> 3;
    int ti = isctx ? 3 : (blk == 0 ? 1 : 0);
    u32x4 kreg[2], vreg[2];
#define ATT_KROW(t) ((t) >= 3 ? ML + b * 256 + ((t) - 3) * 128 : qrow0 + ((t) - 1) * 128)
#define ATT_PRELOAD(t) do { const bf16_t* src_ = QKV + (size_t)(ATT_KROW(t) + kr0) * 768 + kvoff; \
        kreg[0] = *(const u32x4*)src_; vreg[0] = *(const u32x4*)(src_ + 128); kreg[1] = *(const u32x4*)(src_ + (size_t)64 * 768); vreg[1] = *(const u32x4*)(src_ + (size_t)64 * 768 + 128); } while (0)
    ATT_PRELOAD(ti);
#pragma unroll 1
    while (ti < 5) {
        int tn = ti + 1; if (tn == 2 && blk == 63) tn = 3;
        __syncthreads();
#pragma unroll
        for (int it = 0; it < 2; ++it) { *(LAS u32x4*)(Ks + (kr0 + 64 * it) * RS + (tid & 7) * 16) = kreg[it]; *(LAS u32x4*)(Vs + (kr0 + 64 * it) * RS + (tid & 7) * 16) = vreg[it]; }
        if (tn < 5) ATT_PRELOAD(tn);
        __syncthreads();
#pragma unroll
        for (int qi = 0; qi < 2; ++qi) {
            asm volatile("" ::: "memory"); __builtin_amdgcn_sched_barrier(0);
            f32x4 s[8];
            const bf16x8 qf0 = *(const LAS bf16x8*)(qbase + (16 * qi) * RS), qf1 = *(const LAS bf16x8*)(qbase + (16 * qi) * RS + 64);
#pragma unroll
            for (int kf = 0; kf < 8; ++kf) { const LAS unsigned char* kp = Ks + (16 * kf + c) * RS + 16 * g;
                const bf16x8 k0 = *(const LAS bf16x8*)kp, k1 = *(const LAS bf16x8*)(kp + 64);
                s[kf] = __builtin_amdgcn_mfma_f32_16x16x32_bf16(k0, qf0, (f32x4){0.f, 0.f, 0.f, 0.f}, 0, 0, 0);
                s[kf] = __builtin_amdgcn_mfma_f32_16x16x32_bf16(k1, qf1, s[kf], 0, 0, 0); }
            if (ti == 0 || ti == 2) { int qidx = qq * 32 + 16 * qi + c; asm volatile("" : "+v"(qidx));
#pragma unroll
                for (int kf = 0; kf < 8; ++kf)
#pragma unroll
                    for (int r = 0; r < 4; ++r) { const int key = 16 * kf + 4 * g + r; const bool valid = (ti == 0) ? (key >= qidx) : (key <= qidx); if (!valid) s[kf][r] = -1e30f; } }
            float mx = s[0][0];
#pragma unroll
            for (int kf = 0; kf < 8; ++kf)
#pragma unroll
                for (int r = 0; r < 4; ++r) mx = fmaxf(mx, s[kf][r]);
            mx = fmaxf(mx, __shfl_xor(mx, 16)); mx = fmaxf(mx, __shfl_xor(mx, 32));
            const float mnew = fmaxf(m_run[qi], mx), alpha = __builtin_amdgcn_exp2f(m_run[qi] - mnew); m_run[qi] = mnew;
            float psum = 0.f;
#pragma unroll
            for (int kf = 0; kf < 8; ++kf)
#pragma unroll
                for (int r = 0; r < 4; ++r) { const float pv = __builtin_amdgcn_exp2f(s[kf][r] - mnew); s[kf][r] = pv; psum += pv; }
            l_run[qi] = l_run[qi] * alpha + psum;
#pragma unroll
            for (int df = 0; df < 4; ++df) O[df][qi] *= alpha;
#pragma unroll
            for (int ks = 0; ks < 4; ++ks) {
                u32x4 pw; pw.x = cvtpk(s[2 * ks][0], s[2 * ks][1]); pw.y = cvtpk(s[2 * ks][2], s[2 * ks][3]); pw.z = cvtpk(s[2 * ks + 1][0], s[2 * ks + 1][1]); pw.w = cvtpk(s[2 * ks + 1][2], s[2 * ks + 1][3]);
                const bf16x8 pf = __builtin_bit_cast(bf16x8, pw);
#pragma unroll
                for (int df = 0; df < 4; ++df) { const LAS unsigned char* vp = vbase + (ks * 32) * RS + df * 32;
                    const bf16x8 vf = cat8(lds_tr(vp), lds_tr(vp + 16 * RS));
                    O[df][qi] = __builtin_amdgcn_mfma_f32_16x16x32_bf16(vf, pf, O[df][qi], 0, 0, 0); }
            }
        }
        ti = tn;
    }
#undef ATT_KROW
#undef ATT_PRELOAD
#pragma unroll
    for (int qi = 0; qi < 2; ++qi) { float lt = l_run[qi]; lt += __shfl_xor(lt, 16); lt += __shfl_xor(lt, 32); const float inv = 1.f / lt;
        const size_t row = (size_t)(qrow0 + qq * 32 + 16 * qi + c);
#pragma unroll
        for (int df = 0; df < 4; ++df) mul_store4(Z + row * 1024 + 512 + (kvh * 4 + gq) * 64 + 16 * df + 4 * g, O[df][qi] * inv, dry); }
}

__device__ __forceinline__ void f1_item(LAS unsigned char* lds, const bf16_t* Gb, bf16_t* Afft, const bf16_t* t128, int b, int l2, int tid, int lane, int wave) {
    constexpr int RS = 528;
    __syncthreads();
#pragma unroll 4
    for (int it = 0; it < 16; ++it) { const int id = it * 512 + tid, row = id >> 5, c16 = id & 31, pp = row >> 7, l1 = row & 127;
        *(LAS u32x4*)(lds + row * RS + c16 * 16) = *(const u32x4*)(Gb + (size_t)(b * SEQ + 64 * l1 + l2) * 512 + pp * 256 + c16 * 8); }
    __syncthreads();
    const int g = lane >> 4, c = lane & 15;
    for (int mh = 0; mh < 2; ++mh) {
        f32x4 acc[2][8]; zero_acc<2, 8>(acc);
        act_gemm<2, 8, 8>(acc, lds, RS, 32 * wave, t128 + (size_t)(mh * 128) * 256, 256, lane);
#pragma unroll
        for (int i = 0; i < 2; ++i)
#pragma unroll
            for (int j = 0; j < 8; ++j) { const int k1 = 16 * j + c, ch = 32 * wave + 16 * i + 4 * g; const size_t arow = ((size_t)(b * 128 + k1) * 64 + l2) * 2 + mh;
                u32x2 o; o.x = cvtpk(acc[i][j][0], acc[i][j][1]); o.y = cvtpk(acc[i][j][2], acc[i][j][3]); *(u32x2*)(Afft + arow * 256 + ch) = o; }
    }
}
__device__ __forceinline__ void sgu_item(LAS unsigned char* lds, const bf16_t* Ub, bf16_t* Z, const bf16_t* sguw, const float* sgub, int ci, int tid, int lane, int wave, bool dry = false) {
    constexpr int RS = 528;
    const int row0 = ci * 128;
    __syncthreads();
    { const int t = tid >> 2, qd = tid & 3; const bf16_t* vp = Ub + (size_t)(row0 + t) * 512 + 256 + qd * 64;
      u32x4 w[8]; float ss = 0.f;
#pragma unroll
      for (int i = 0; i < 8; ++i) { w[i] = *(const u32x4*)(vp + 8 * i);
          const float a0 = bflo(w[i].x), a1 = bfhi(w[i].x), a2 = bflo(w[i].y), a3 = bfhi(w[i].y), a4 = bflo(w[i].z), a5 = bfhi(w[i].z), a6 = bflo(w[i].w), a7 = bfhi(w[i].w);
          ss += (a0 * a0 + a1 * a1) + (a2 * a2 + a3 * a3) + (a4 * a4 + a5 * a5) + (a6 * a6 + a7 * a7); }
      ss += __shfl_xor(ss, 1); ss += __shfl_xor(ss, 2);
      const float rinv = rsqrtf(ss * (1.f / 256.f) + EPSV);
#pragma unroll
      for (int i = 0; i < 8; ++i) { u32x4 o; o.x = cvtpk(bflo(w[i].x) * rinv, bfhi(w[i].x) * rinv); o.y = cvtpk(bflo(w[i].y) * rinv, bfhi(w[i].y) * rinv); o.z = cvtpk(bflo(w[i].z) * rinv, bfhi(w[i].z) * rinv); o.w = cvtpk(bflo(w[i].w) * rinv, bfhi(w[i].w) * rinv);
          *(LAS u32x4*)(lds + t * RS + qd * 128 + i * 16) = o; } }
    __syncthreads();
    const int grp = wave >> 1, sh = wave & 1, g = lane >> 4, c = lane & 15;
    f32x4 acc[4][4]; zero_acc<4, 4>(acc);
    act_gemm<4, 4, 4>(acc, lds, RS, grp * 64, sguw + (size_t)grp * 16384 + (size_t)(sh * 64) * 128, 128, lane);
#pragma unroll
    for (int j = 0; j < 4; ++j) { const int s = sh * 64 + 16 * j + c; const float bias = sgub[grp * 128 + s]; const size_t row = (size_t)(row0 + s);
#pragma unroll
        for (int i = 0; i < 4; ++i) { const int col = grp * 64 + 16 * i + 4 * g; const u32x2 uw = *(const u32x2*)(Ub + row * 512 + col);
            f32x4 v = acc[i][j]; v[0] = (v[0] + bias) * bflo(uw.x); v[1] = (v[1] + bias) * bfhi(uw.x); v[2] = (v[2] + bias) * bflo(uw.y); v[3] = (v[3] + bias) * bfhi(uw.y);
            mul_store4(Z + row * 1024 + 256 + col, v, dry); } }
}
__device__ __forceinline__ void f3_item(LAS unsigned char* lds, const bf16_t* Afft, bf16_t* Z, const bf16_t* t3, int b, int k1, int tid, int lane, int wave, bool dry = false) {
    constexpr int RS = 528;
    __syncthreads();
    const bf16_t* src = Afft + (size_t)(b * 128 + k1) * 128 * 256;
#pragma unroll 4
    for (int it = 0; it < 8; ++it) { const int id = it * 512 + tid, row = id >> 5, c16 = id & 31;
        *(LAS u32x4*)(lds + row * RS + c16 * 16) = *(const u32x4*)(src + (size_t)row * 256 + c16 * 8); }
    __syncthreads();
    const int g = lane >> 4, c = lane & 15;
    f32x4 acc[2][4]; zero_acc<2, 4>(acc);
    act_gemm<2, 4, 4>(acc, lds, RS, 32 * wave, t3 + (size_t)k1 * 64 * 128, 128, lane);
#pragma unroll
    for (int j = 0; j < 4; ++j) { const int k2 = 16 * j + c; const size_t row = (size_t)b * SEQ + k1 + 128 * k2;
#pragma unroll
        for (int i = 0; i < 2; ++i) mul_store4(Z + row * 1024 + 32 * wave + 16 * i + 4 * g, acc[i][j], dry); }
}
__device__ __forceinline__ void fc_item(LAS unsigned char* lds, const bf16_t* Gb, bf16_t* Z, const bf16_t* tc, int b, int hh, int tid, int lane, int wave, bool dry = false) {
    constexpr int RS = 272;
    __syncthreads();
#pragma unroll 4
    for (int it = 0; it < 16; ++it) { const int id = it * 512 + tid, row = id >> 4, c16 = id & 15, part = row >> 8, ll = row & 255;
        *(LAS u32x4*)(lds + row * RS + c16 * 16) = *(const u32x4*)(Gb + (size_t)(ML + b * 256 + ll) * 512 + part * 256 + hh * 128 + c16 * 8); }
    __syncthreads();
    const int g = lane >> 4, c = lane & 15;
    f32x4 acc[1][16]; zero_acc<1, 16>(acc);
    act_gemm<1, 16, 16>(acc, lds, RS, 16 * wave, tc, 512, lane);
#pragma unroll
    for (int j = 0; j < 16; ++j) { const size_t row = (size_t)(ML + b * 256 + 16 * j + c); mul_store4(Z + row * 1024 + hh * 128 + 16 * wave + 4 * g, acc[0][j], dry); }
}


__device__ __forceinline__ void ctx_merge_tile(const bf16_t* Y, const bf16_t* GT, bf16_t* MG, const unsigned char* wsW, int tile, int lane, int wave) {
    const int m = ML + 64 * (tile >> 4) + 16 * (wave >> 1) + (lane & 15), nb = 64 * (tile & 15) + 32 * (wave & 1), g = lane >> 4, c = lane & 15;
    f32x4 mg[2] = {(f32x4){0.f, 0.f, 0.f, 0.f}, (f32x4){0.f, 0.f, 0.f, 0.f}};
#pragma unroll
    for (int seg = 0; seg < 3; ++seg) {
        const int Kseg = seg == 2 ? 512 : 256;
        const bf16_t* Wt = (const bf16_t*)(wsW + (seg == 0 ? W_PA_OFF : (seg == 1 ? W_PB_OFF : W_PC_OFF)));
        const bf16_t* yp = Y + (size_t)m * 1024 + seg * 256 + 8 * g;
        const bf16_t* wp = Wt + (size_t)(nb + c) * Kseg + 8 * g;
        f32x4 acc[2] = {(f32x4){0.f, 0.f, 0.f, 0.f}, (f32x4){0.f, 0.f, 0.f, 0.f}};
#pragma unroll 8
        for (int ks = 0; ks < Kseg / 32; ++ks) {
            const bf16x8 yf = *(const bf16x8*)(yp + ks * 32);
#pragma unroll
            for (int j = 0; j < 2; ++j) { const bf16x8 wf = *(const bf16x8*)(wp + (size_t)j * 16 * Kseg + ks * 32); acc[j] = __builtin_amdgcn_mfma_f32_16x16x32_bf16(wf, yf, acc[j], 0, 0, 0); }
        }
#pragma unroll
        for (int j = 0; j < 2; ++j) { const u32x2 gw = *(const u32x2*)(GT + (size_t)m * 3072 + seg * 1024 + nb + 16 * j + 4 * g);
            mg[j][0] += acc[j][0] * bflo(gw.x); mg[j][1] += acc[j][1] * bfhi(gw.x); mg[j][2] += acc[j][2] * bflo(gw.y); mg[j][3] += acc[j][3] * bfhi(gw.y); }
    }
#pragma unroll
    for (int j = 0; j < 2; ++j) { u32x2 o; o.x = cvtpk(mg[j][0], mg[j][1]); o.y = cvtpk(mg[j][2], mg[j][3]); *(u32x2*)(MG + (size_t)m * 1024 + nb + 16 * j + 4 * g) = o; }
}
__device__ __forceinline__ void ctx_out_tile(const bf16_t* MG, const bf16_t* WoT, const float* csrc, float* cdst, const float* gate_c, int tile, int lane, int wave) {
    const int mr = 64 * (tile >> 4) + 16 * (wave >> 1) + (lane & 15), nb = 64 * (tile & 15) + 32 * (wave & 1), g = lane >> 4, c = lane & 15;
    const bf16_t* ap = MG + (size_t)(ML + mr) * 1024 + 8 * g;
    const bf16_t* wp = WoT + (size_t)(nb + c) * 1024 + 8 * g;
    f32x4 acc[2] = {(f32x4){0.f, 0.f, 0.f, 0.f}, (f32x4){0.f, 0.f, 0.f, 0.f}};
#pragma unroll 8
    for (int ks = 0; ks < 32; ++ks) {
        const bf16x8 yf = *(const bf16x8*)(ap + ks * 32);
#pragma unroll
        for (int j = 0; j < 2; ++j) { const bf16x8 wf = *(const bf16x8*)(wp + (size_t)j * 16 * 1024 + ks * 32); acc[j] = __builtin_amdgcn_mfma_f32_16x16x32_bf16(wf, yf, acc[j], 0, 0, 0); }
    }
#pragma unroll
    for (int j = 0; j < 2; ++j) { const int n = nb + 16 * j + 4 * g; const f32x4 gt = *(const f32x4*)(gate_c + n); const f32x4 xs = *(const f32x4*)(csrc + (size_t)mr * DM + n);
        *(f32x4*)(cdst + (size_t)mr * DM + n) = xs + gt * acc[j]; }
}

#define XB_TMO      128
#define XB_XCNT(j)  (256  + 64 * (j))
#define XB_XSUB(j)  (1280 + 64 * (j))
#define XB_XGEN(j)  (2304 + 64 * (j))
#define XB_TOP      3328
#define XB_TOPGEN   3392
#define XCD_BAR_WORDS 3456
#define XB_SPIN_CAP (1u << 18)
__device__ __forceinline__ unsigned xb_ld(unsigned* p)              { return __hip_atomic_load(p, __ATOMIC_RELAXED, __HIP_MEMORY_SCOPE_AGENT); }
__device__ __forceinline__ unsigned xb_add(unsigned* p, unsigned v) { return __hip_atomic_fetch_add(p, v, __ATOMIC_RELAXED, __HIP_MEMORY_SCOPE_AGENT); }
__device__ __forceinline__ unsigned xb_xcc_id() { return (unsigned)__builtin_amdgcn_s_getreg((3 << 11) | 20) & 0xFu; }
#define XB_SPIN(cond, bar) do { unsigned _sp = 0; while (cond) { __builtin_amdgcn_s_sleep(1); \
    if ((++_sp & 255u) == 0u) { if (xb_ld(&(bar)[XB_TMO])) break; if (_sp > XB_SPIN_CAP) { atomicAdd(&(bar)[XB_TMO], 1u); break; } } } } while (0)
struct XcdBarrier { unsigned* bar; unsigned x; volatile LAS unsigned* st; };
__device__ __forceinline__ XcdBarrier xcd_barrier_post(unsigned* bar, volatile LAS unsigned* st) {
    XcdBarrier b; b.bar = bar; b.x = xb_xcc_id(); b.st = st;
    if (threadIdx.x == 0) (void)xb_add(&bar[XB_XCNT(b.x)], 1u);
    return b;
}
__device__ __forceinline__ void xcd_barrier_complete(unsigned* bar, unsigned x, unsigned& nloc, unsigned& nx) {
    const unsigned G = gridDim.x * gridDim.y * gridDim.z;
    unsigned sum, cnt, mine, sp = 0u;
    for (;;) {
        sum = 0u; cnt = 0u; mine = 0u;
#pragma unroll
        for (unsigned j = 0; j < 16; ++j) { const unsigned c = xb_ld(&bar[XB_XCNT(j)]); sum += c; cnt += (c > 0u) ? 1u : 0u; mine = (j == x) ? c : mine; }
        if (sum == G) break;
        __builtin_amdgcn_s_sleep(1);
        if ((++sp & 255u) == 0u) { if (xb_ld(&bar[XB_TMO])) break; if (sp > XB_SPIN_CAP) { atomicAdd(&bar[XB_TMO], 1u); break; } }
    }
    nloc = mine > 0u ? mine : 1u; nx = cnt > 0u ? cnt : 1u;
}
__device__ __forceinline__ void xcd_barrier(const XcdBarrier& b) {
    asm volatile("s_waitcnt vmcnt(0)" ::: "memory");
    __syncthreads();
    if (threadIdx.x == 0) {
        unsigned* bar = b.bar;
        __builtin_amdgcn_s_waitcnt(0);
        unsigned nloc = b.st[0], nx = b.st[1];
        if (nloc == 0u) { xcd_barrier_complete(bar, b.x, nloc, nx); b.st[0] = nloc; b.st[1] = nx; }
        const unsigned old = xb_add(&bar[XB_XSUB(b.x)], 1u);
        const unsigned gen = old / nloc;
        if (old + 1u == (gen + 1u) * nloc) {
            __builtin_amdgcn_fence(__ATOMIC_RELEASE, "agent");
            asm volatile("s_waitcnt vmcnt(0)" ::: "memory");
            const unsigned og = xb_add(&bar[XB_TOP], 1u);
            const unsigned tg = og / nx;
            if (og + 1u == (tg + 1u) * nx) xb_add(&bar[XB_TOPGEN], 1u);
            else XB_SPIN(xb_ld(&bar[XB_TOPGEN]) == tg, bar);
            __builtin_amdgcn_fence(__ATOMIC_ACQUIRE, "agent");
            xb_add(&bar[XB_XGEN(b.x)], 1u);
            asm volatile("s_waitcnt vmcnt(0)" ::: "memory");
        } else {
            XB_SPIN(xb_ld(&bar[XB_XGEN(b.x)]) == gen, bar);
            __builtin_amdgcn_fence(__ATOMIC_ACQUIRE, "agent");
            asm volatile("s_waitcnt vmcnt(0)" ::: "memory");
        }
    }
    __syncthreads();
}

#define PHASE_IDS() int t__ = threadIdx.x, b__ = blockIdx.x, g__ = gridDim.x; asm volatile("" : "+v"(t__)); asm volatile("" : "+s"(b__), "+s"(g__)); \
    unsigned char* ws = p.ws; asm volatile("" : "+s"(ws)); \
    const int tid = t__, lane = tid & 63, wave = __builtin_amdgcn_readfirstlane(tid >> 6), bid = b__, G = g__; (void)lane; (void)wave; (void)bid; (void)G
__global__ void __launch_bounds__(512, 2) fwd_megakernel(Params p) {
    extern __shared__ __attribute__((aligned(16))) unsigned char lds_raw[];
    LAS unsigned char* lds = (LAS unsigned char*)lds_raw;
    cg::grid_group grid = cg::this_grid();
    volatile LAS unsigned* bst = (volatile LAS unsigned*)(lds + LDS_BYTES - 16);
    if (threadIdx.x < 4) bst[threadIdx.x] = 0u;
    __syncthreads();
    const XcdBarrier xbar = xcd_barrier_post((unsigned*)(p.ws + WS_BAR), bst);
#define GSYNC() do { xcd_barrier(xbar); if (PROBE_DUP == 7) xcd_barrier(xbar); } while (0)
#ifndef SKIP_P0
    { PHASE_IDS(); phase0(p, lds, tid, bid, G); }
#endif
    grid.sync();
#pragma unroll 1
    for (int l = 0; l < DEPTH; ++l) {
        const bool last = (l == DEPTH - 1);
#ifndef SKIP_P1
        for (int rep = (PROBE_DUP == 1 ? 0 : 1); rep < 2; ++rep) { PHASE_IDS(); phase1(p, lds, l, tid, lane, wave, bid, G); }
#endif
        GSYNC();
#ifndef SKIP_P2
#pragma unroll 1
        for (int rep = (PROBE_DUP == 2 ? 0 : 1); rep < 2; ++rep) { PHASE_IDS();
          pg8::Gemm g{(const bf16_t*)(ws + WS_H), (const bf16_t*)(ws + WS_W + W_IN_OFF), MT, NIN, 1024, 1024}; pg8::StaticOrder S; S.init(MT, NIN, G, bid);
          pg8::EpiProj E{(bf16_t*)(ws + WS_G), (bf16_t*)(ws + WS_Z), (bf16_t*)(ws + WS_U), (bf16_t*)(ws + WS_QKV), (bf16_t*)(ws + WS_GT), (const float*)(ws + WS_ROPE), p.in[9] + l * 64, p.in[10] + l * 64};
          pg8::gemm_phase<pg8::EpiProj>(lds, g, S, E, tid); }
#endif
        GSYNC();
#ifndef SKIP_P3
#pragma unroll 1
        for (int rep = (PROBE_DUP == 3 ? 0 : 1); rep < 2; ++rep) { PHASE_IDS(); const bool dry = rep == 0;
          bf16_t* Zb = (bf16_t*)(ws + WS_Z); const bf16_t* QKVb = (const bf16_t*)(ws + WS_QKV);
          const int n_attn = last ? 1024 : 1056, n_f1 = 256, n_sgu = last ? 256 : 264, total = n_attn + n_f1 + n_sgu;
          const float* sinkl = p.in[11] + l * 8; const float* sgub = p.in[8] + l * 512;
          for (int item = bid; item < total; item += G) {
              if (item < n_attn) { const bool ic = item >= 1024; const int i2 = item - 1024;
                                   attn_item(lds, QKVb, Zb, sinkl, ic ? (i2 >> 3) : (item >> 8), ic ? ((i2 >> 2) & 1) : ((item >> 2) & 63), (item >> 1) & 1, item & 1, ic, tid, lane, wave, dry); }
              else if (item < n_attn + n_f1) { const int i2 = item - n_attn; f1_item(lds, (const bf16_t*)(ws + WS_G), (bf16_t*)(ws + WS_H), (const bf16_t*)(ws + WS_T128), i2 >> 6, i2 & 63, tid, lane, wave); }
              else { sgu_item(lds, (const bf16_t*)(ws + WS_U), Zb, (const bf16_t*)(ws + WS_SGUW), sgub, item - n_attn - n_f1, tid, lane, wave, dry); }
          } }
#endif
        GSYNC();
#ifndef SKIP_P4
#pragma unroll 1
        for (int rep = (PROBE_DUP == 4 ? 0 : 1); rep < 2; ++rep) { PHASE_IDS(); const bool dry = rep == 0;
          bf16_t* Zb = (bf16_t*)(ws + WS_Z);
          const int total = last ? 512 : 520;
          for (int item = bid; item < total; item += G) {
              if (item < 512) f3_item(lds, (const bf16_t*)(ws + WS_H), Zb, (const bf16_t*)(ws + WS_T3), item >> 7, item & 127, tid, lane, wave, dry);
              else { const int i2 = item - 512; fc_item(lds, (const bf16_t*)(ws + WS_G), Zb, (const bf16_t*)(ws + WS_TC), i2 >> 1, i2 & 1, tid, lane, wave, dry); }
          } }
#endif
        GSYNC();
#ifndef SKIP_P5
        if (!last) { PHASE_IDS();
          for (int t = bid; t < 256; t += G) ctx_merge_tile((const bf16_t*)(ws + WS_Z), (const bf16_t*)(ws + WS_GT), (bf16_t*)(ws + WS_H), ws + WS_W, t, lane, wave); }
#pragma unroll 1
        for (int seg = (PROBE_DUP == 5 ? -3 : 0); seg < 3; ++seg) { PHASE_IDS(); const int sg_ = seg < 0 ? seg + 3 : seg;
          const int Mrows = ML; pg8::StaticOrder S; S.init(Mrows, 1024, G, bid);
          const bf16_t* Zb = (const bf16_t*)(ws + WS_Z);
          const size_t woff = sg_ == 0 ? W_PA_OFF : (sg_ == 1 ? W_PB_OFF : W_PC_OFF);
          pg8::Gemm g{Zb + sg_ * 256, (const bf16_t*)(ws + WS_W + woff), Mrows, 1024, sg_ == 2 ? 512 : 256, 1024};
          pg8::EpiMerge E{(const bf16_t*)(ws + WS_GT), (bf16_t*)(ws + WS_H), sg_};
          pg8::gemm_phase<pg8::EpiMerge>(lds, g, S, E, tid); }
#endif
        GSYNC();
#ifndef SKIP_P6
#pragma unroll 1
        for (int rep = (PROBE_DUP == 6 ? 0 : 1); rep < 2; ++rep) { PHASE_IDS();
          const int Mrows = ML; pg8::StaticOrder S; S.init(Mrows, 1024, G, bid);
          pg8::Gemm g{(const bf16_t*)(ws + WS_H), (const bf16_t*)(ws + WS_W + W_OUT_OFF), Mrows, 1024, 1024, 1024};
          float* XC = (float*)(ws + WS_XC);
          if (!last && rep == 1) { for (int t = bid; t < 256; t += G) ctx_out_tile((const bf16_t*)(ws + WS_H), (const bf16_t*)(ws + WS_W + W_OUT_OFF), l == 0 ? p.in[2] : XC, XC, (const float*)(ws + WS_MOD) + (size_t)(l * 5 + 4) * 3072 + 2048, t, lane, wave); }
          pg8::EpiRes E{l == 0 ? p.in[0] : p.out, p.out, l == 0 ? p.in[2] : XC, XC, rep == 0 ? (const float*)(ws + WS_ROPE + 65536) : (const float*)(ws + WS_MOD) + (size_t)l * 5 * 3072};
          pg8::gemm_phase<pg8::EpiRes>(lds, g, S, E, tid); }
#endif
        if (!last) GSYNC();
    }
}

extern "C" void kernel_launch(void* const* d_in, const int* in_sizes, int n_in, void* d_out, int out_size, void* d_ws, size_t ws_size, hipStream_t stream) {
    static int grid = 0;
    if (grid == 0) {
        if (n_in != 16 || ws_size < WS_END) { fprintf(stderr, "kernel_launch: unexpected inputs (n_in %d, ws %zu)\n", n_in, ws_size); grid = -1; return; }
        int dev = 0, cus = 0, per_cu = 0;
        hipGetDevice(&dev);
        hipDeviceGetAttribute(&cus, hipDeviceAttributeMultiprocessorCount, dev);
        hipFuncSetAttribute((const void*)fwd_megakernel, hipFuncAttributeMaxDynamicSharedMemorySize, LDS_BYTES);
        hipOccupancyMaxActiveBlocksPerMultiprocessor(&per_cu, (const void*)fwd_megakernel, 512, LDS_BYTES);
        if (per_cu < 1 || cus < 1) { fprintf(stderr, "kernel_launch: occupancy query gave %d blocks/CU on %d CUs\n", per_cu, cus); grid = -1; return; }
        grid = cus;
    }
    if (grid < 0) return;
    if (hipMemsetAsync((char*)d_ws + WS_BAR, 0, XCD_BAR_WORDS * 4, stream) != hipSuccess) { fprintf(stderr, "kernel_launch: memset of barrier words failed\n"); return; }
    Params p{};
    for (int i = 0; i < 16; ++i) p.in[i] = (const float*)d_in[i];
    p.out = (float*)d_out; p.ws = (unsigned char*)d_ws;
    void* args[] = {&p};
    hipError_t e = hipLaunchCooperativeKernel((const void*)fwd_megakernel, dim3(grid), dim3(512), args, LDS_BYTES, stream);
    if (e != hipSuccess) fprintf(stderr, "cooperative launch failed: %s (grid %d)\n", hipGetErrorString(e), grid);
}
```

```cpp
#include <hip/hip_runtime.h>
#include <hip/hip_cooperative_groups.h>
#include <cstdio>
#include <cstdint>
namespace cg = cooperative_groups;

#define LAS __attribute__((address_space(3)))
typedef unsigned short bf16_t;
typedef short bf16x8 __attribute__((ext_vector_type(8)));
typedef short s16x4 __attribute__((ext_vector_type(4)));
typedef float f32x4 __attribute__((ext_vector_type(4)));
typedef unsigned u32x4 __attribute__((ext_vector_type(4)));
typedef unsigned u32x2 __attribute__((ext_vector_type(2)));
typedef float f32x2_t __attribute__((ext_vector_type(2)));
typedef __bf16 bf16x2_t __attribute__((ext_vector_type(2)));

constexpr int DM = 1024, NB = 4, SEQ = 8192, DEPTH = 4, CTXL = 256;
constexpr int ML = NB * SEQ;
constexpr int MC = NB * CTXL;
constexpr int MT = ML + MC;
constexpr int INW = 5632;
constexpr int NIN = 5888;
constexpr float EPSV = 1e-6f;
constexpr float LOG2E = 1.4426950408889634f;

constexpr size_t MiB = 1u << 20;
constexpr size_t WS_MOD = 0;
constexpr size_t WS_ROPE = 256 * 1024;
constexpr size_t WS_T128 = 512 * 1024;
constexpr size_t WS_TC = 1 * MiB;
constexpr size_t WS_T3 = 2 * MiB;
constexpr size_t WS_SGUW = 4 * MiB;
constexpr size_t WS_BAR = 6 * MiB;
constexpr size_t WS_XC = 8 * MiB;
constexpr size_t WS_W = 16 * MiB;
constexpr size_t W_IN_OFF = 0, W_PA_OFF = (size_t)NIN * 1024 * 2, W_PB_OFF = W_PA_OFF + 1024 * 256 * 2, W_PC_OFF = W_PB_OFF + 1024 * 256 * 2, W_OUT_OFF = W_PC_OFF + 1024 * 512 * 2;
constexpr size_t WS_H = 32 * MiB;
constexpr size_t WS_G = 98 * MiB;
constexpr size_t WS_Z = 131 * MiB;
constexpr size_t WS_U = 197 * MiB;
constexpr size_t WS_QKV = 230 * MiB;
constexpr size_t WS_GT = 280 * MiB;
constexpr size_t WS_W1 = 478 * MiB;
constexpr size_t WS_END = 494 * MiB;
static_assert(W_OUT_OFF + 1024 * 1024 * 2 <= 16 * MiB, "weights fit");

constexpr int LDS_BYTES = 147456;
#ifndef PROBE_DUP
#define PROBE_DUP 0
#endif

__device__ __forceinline__ unsigned cvtpk(float lo, float hi) { f32x2_t v = {lo, hi}; bf16x2_t b = __builtin_convertvector(v, bf16x2_t); return __builtin_bit_cast(unsigned, b); }
__device__ __forceinline__ float bflo(unsigned w) { return __uint_as_float(w << 16); }
__device__ __forceinline__ float bfhi(unsigned w) { return __uint_as_float(w & 0xffff0000u); }
__device__ __forceinline__ float silu_f(float v) { return v * __builtin_amdgcn_rcpf(1.f + __expf(-v)); }
__device__ __forceinline__ float sigm_f(float v) { return __builtin_amdgcn_rcpf(1.f + __expf(-v)); }
typedef short v4i16_t __attribute__((ext_vector_type(4)));
__device__ __forceinline__ s16x4 lds_tr(const LAS unsigned char* p) { return __builtin_bit_cast(s16x4, __builtin_amdgcn_ds_read_tr16_b64_v4i16((LAS v4i16_t*)p)); }
__device__ __forceinline__ bf16x8 cat8(s16x4 a, s16x4 b) { return (bf16x8){a[0], a[1], a[2], a[3], b[0], b[1], b[2], b[3]}; }

namespace pg8 {
constexpr int BM = 256, BK = 64, HALF = 128, HTB = HALF * BK * 2, STAGE_BYTES = 8 * HTB, NXCD = 8, WGM = 8;
__host__ __device__ __forceinline__ int lds_byte(int r, int c) { const int st = (r >> 4) * 2 + (c >> 5), rr = r & 15, cc = c & 31, ob = rr * 64 + cc * 2; return st * 1024 + (ob ^ (((ob >> 9) & 1) << 5)); }
__host__ __device__ __forceinline__ void stage_rc(int b, int& R, int& C) { const int st = b / 1024, sb = b % 1024, swz = sb ^ (((sb >> 9) & 1) << 5); R = (st >> 1) * 16 + swz / 64; C = (st & 1) * 32 + (swz % 64) / 2; }
__host__ __device__ __forceinline__ int perm32(int rho) { const int n = rho >> 4, i = rho & 15; return 8 * (i >> 2) + 4 * n + (i & 3); }
struct Unit { int pm, pn; };
struct Gemm { const bf16_t* A; const bf16_t* Bt; int M, N, K, lda; };
struct StaticOrder {
    int nM, nN, nwg, G, c;
    __host__ __device__ void init(int M, int N, int G_, int c_) { nM = M / BM; nN = N / BM; nwg = nM * nN; G = G_; c = c_; }
    __host__ __device__ bool next(int i, Unit& u) const {
        const long L = (long)i * G + c; if (L >= nwg) return false;
        int wgid = (int)L; { const int q = nwg / NXCD, r = nwg % NXCD, xcd = wgid % NXCD, off = wgid / NXCD; wgid = (xcd < r ? xcd * (q + 1) : r * (q + 1) + (xcd - r) * q) + off; }
        const int nig = WGM * nN, gid = wgid / nig, fm = gid * WGM, gsz = (nM - fm) < WGM ? (nM - fm) : WGM;
        u.pm = fm + ((wgid % nig) % gsz); u.pn = (wgid % nig) / gsz; return true;
    }
};
template <class Epi>
__device__ __forceinline__ void gemm_phase(LAS unsigned char* lds, const Gemm g, const StaticOrder& S, const Epi& E, const int tid) {
    const int wid = __builtin_amdgcn_readfirstlane(tid >> 6), lane = tid & 63, wr = wid >> 2, wc = wid & 3, fr = lane & 15, fq = lane >> 4;
    const int K = g.K, nt = K / BK, lda = g.lda;
    unsigned voffA[2], voffB[2];
#pragma unroll
    for (int i = 0; i < 2; ++i) { int R, C; stage_rc(tid * 16 + i * 8192, R, C); const int Rb = Epi::PERM ? ((R & ~31) + perm32(R & 31)) : R;
        voffA[i] = (unsigned)(R * lda + C) * 2u; voffB[i] = (unsigned)(Rb * K + C) * 2u; }
    const size_t kstep = (size_t)(BK * 2);
    const size_t hstepA = (size_t)HALF * lda * 2, hstepB = (size_t)HALF * K * 2;
    const size_t tstepA = 2 * hstepA, tstepB = 2 * hstepB;
    const unsigned ldsw = (unsigned)wid * 1024u;
    const int aoff = lds_byte(wr * 64 + fr, fq * 8), boff = lds_byte(wc * 32 + fr, fq * 8);
#define PG8_SA(b, h) (((b) * 2 + (h)) * HTB)
#define PG8_SB(b, h) ((4 + (b) * 2 + (h)) * HTB)
#define PG8_STAGE(bufoff, gbase, voff) do { _Pragma("unroll") for (int _i = 0; _i < 2; ++_i) \
        __builtin_amdgcn_global_load_lds((const unsigned*)((const char*)(gbase) + (voff)[_i]), (LAS unsigned*)(lds + (bufoff) + ldsw + _i * 8192), 16, 0, 0); } while (0)
#define PG8_LDA(dst, b, h) do { _Pragma("unroll") for (int m = 0; m < 4; ++m) _Pragma("unroll") for (int k = 0; k < 2; ++k) dst[m][k] = *(const LAS bf16x8*)(lds + PG8_SA(b, h) + aoff + m * 2048 + k * 1024); } while (0)
#define PG8_LDB(dst, b, h) do { _Pragma("unroll") for (int n = 0; n < 2; ++n) _Pragma("unroll") for (int k = 0; k < 2; ++k) dst[n][k] = *(const LAS bf16x8*)(lds + PG8_SB(b, h) + boff + n * 2048 + k * 1024); } while (0)
#define PG8_MMA(ai, bj, At, Bt) do { __builtin_amdgcn_s_setprio(1); _Pragma("unroll") for (int m = 0; m < 4; ++m) _Pragma("unroll") for (int n = 0; n < 2; ++n) _Pragma("unroll") for (int k = 0; k < 2; ++k) \
        acc[ai][bj][m][n] = __builtin_amdgcn_mfma_f32_16x16x32_bf16(Bt[n][k], At[m][k], acc[ai][bj][m][n], 0, 0, 0); __builtin_amdgcn_s_setprio(0); } while (0)
#define PG8_WAIT_V(n) asm volatile("s_waitcnt vmcnt(" #n ")" ::: "memory")
#define PG8_WAIT_L(n) asm volatile("s_waitcnt lgkmcnt(" #n ")" ::: "memory")
#define PG8_BAR __builtin_amdgcn_s_barrier()
#define PG8_SCHED __builtin_amdgcn_sched_barrier(0)
    Unit cur, nxt; int ui = 0;
    if (!S.next(0, cur)) return;
    f32x4 acc[2][2][4][2];
#pragma unroll
    for (int a = 0; a < 2; ++a)
#pragma unroll
        for (int b = 0; b < 2; ++b)
#pragma unroll
            for (int m = 0; m < 4; ++m)
#pragma unroll
                for (int n = 0; n < 2; ++n) acc[a][b][m][n] = (f32x4){0.f, 0.f, 0.f, 0.f};
    bf16x8 At[4][2], B0[2][2], B1[2][2];
    const char* cA = (const char*)g.A + (size_t)cur.pm * tstepA; const char* cB = (const char*)g.Bt + (size_t)cur.pn * tstepB;
    PG8_STAGE(PG8_SB(0, 0), cB, voffB); PG8_STAGE(PG8_SB(0, 1), cB + hstepB, voffB); PG8_STAGE(PG8_SA(0, 0), cA, voffA); PG8_STAGE(PG8_SA(0, 1), cA + hstepA, voffA);
    if (wr == 1) PG8_BAR;
    PG8_WAIT_V(2); PG8_BAR;
    PG8_STAGE(PG8_SB(1, 0), cB + kstep, voffB); PG8_STAGE(PG8_SA(1, 0), cA + kstep, voffA); PG8_STAGE(PG8_SB(1, 1), cB + hstepB + kstep, voffB);
    PG8_WAIT_V(6); PG8_BAR;
    for (;;) {
        const bool has_next = S.next(ui + 1, nxt);
        const char* nA = has_next ? (const char*)g.A + (size_t)nxt.pm * tstepA : cA; const char* nB = has_next ? (const char*)g.Bt + (size_t)nxt.pn * tstepB : cB;
        for (int t = 0; t < nt; t += 2) {
            const bool last = (t == nt - 2);
            const char* a1 = cA + (size_t)(t + 1) * kstep;
            const char* a2 = last ? nA : cA + (size_t)(t + 2) * kstep; const char* b2 = last ? nB : cB + (size_t)(t + 2) * kstep;
            const char* a3 = a2 + kstep; const char* b3 = b2 + kstep;
            PG8_LDB(B0, 0, 0); PG8_LDB(B1, 0, 1); PG8_SCHED; PG8_LDA(At, 0, 0); PG8_STAGE(PG8_SA(1, 1), a1 + hstepA, voffA);
            PG8_WAIT_V(8); PG8_WAIT_L(0); PG8_BAR; PG8_MMA(0, 0, At, B0); PG8_MMA(0, 1, At, B1); PG8_BAR; PG8_SCHED;
            PG8_LDA(At, 0, 1); PG8_STAGE(PG8_SB(0, 0), b2, voffB); PG8_STAGE(PG8_SB(0, 1), b2 + hstepB, voffB); PG8_STAGE(PG8_SA(0, 0), a2, voffA);
            PG8_WAIT_V(8); PG8_WAIT_L(0); PG8_BAR; PG8_MMA(1, 0, At, B0); PG8_MMA(1, 1, At, B1); PG8_BAR; PG8_SCHED;
            PG8_LDB(B0, 1, 0); PG8_LDB(B1, 1, 1); PG8_SCHED; PG8_LDA(At, 1, 0); PG8_STAGE(PG8_SA(0, 1), a2 + hstepA, voffA);
            PG8_WAIT_V(8); PG8_WAIT_L(0); PG8_BAR; PG8_MMA(0, 0, At, B0); PG8_MMA(0, 1, At, B1); PG8_BAR; PG8_SCHED;
            PG8_LDA(At, 1, 1); PG8_STAGE(PG8_SB(1, 0), b3, voffB); PG8_STAGE(PG8_SB(1, 1), b3 + hstepB, voffB); PG8_STAGE(PG8_SA(1, 0), a3, voffA);
            PG8_WAIT_V(8); PG8_WAIT_L(0); PG8_BAR; PG8_MMA(1, 0, At, B0); PG8_MMA(1, 1, At, B1); PG8_BAR; PG8_SCHED;
        }
        if (wr == 0) PG8_BAR;
        E(acc, cur, wr, wc, fr, fq);
        if (!has_next) break;
#pragma unroll
        for (int a = 0; a < 2; ++a)
#pragma unroll
            for (int b = 0; b < 2; ++b)
#pragma unroll
                for (int m = 0; m < 4; ++m)
#pragma unroll
                    for (int n = 0; n < 2; ++n) acc[a][b][m][n] = (f32x4){0.f, 0.f, 0.f, 0.f};
        cur = nxt; cA = nA; cB = nB; ++ui;
        if (wr == 1) PG8_BAR;
    }
    PG8_WAIT_V(0);
    PG8_BAR;
#undef PG8_SA
#undef PG8_SB
#undef PG8_STAGE
#undef PG8_LDA
#undef PG8_LDB
#undef PG8_MMA
#undef PG8_WAIT_V
#undef PG8_WAIT_L
#undef PG8_BAR
#undef PG8_SCHED
}

struct EpiProj {
    static constexpr bool PERM = true;
    bf16_t *Gb, *Zb, *Ub, *QKVb, *GTb; const float *rope, *qg, *kg;
    __device__ __forceinline__ void operator()(const f32x4 (&acc)[2][2][4][2], const Unit& u, int wr, int wc, int fr, int fq) const {
        const int pn = u.pn;
        const int row0 = u.pm * BM + wr * 64 + fr;
        if (pn >= 6 && pn <= 8) {
            const bool isq = pn < 8;
            if (!isq && wc >= 2) {
#pragma unroll
                for (int ai = 0; ai < 2; ++ai)
#pragma unroll
                    for (int m = 0; m < 4; ++m) { bf16_t* rowp = QKVb + (size_t)(row0 + ai * HALF + m * 16) * 768 + 640 + (wc - 2) * 64 + 8 * fq;
#pragma unroll
                        for (int bj = 0; bj < 2; ++bj) { const f32x4 v0 = acc[ai][bj][m][0], v1 = acc[ai][bj][m][1];
                            u32x4 w; w.x = cvtpk(v0[0], v0[1]); w.y = cvtpk(v0[2], v0[3]); w.z = cvtpk(v1[0], v1[1]); w.w = cvtpk(v1[2], v1[3]);
                            *(u32x4*)(rowp + bj * 32) = w; } }
            } else {
                const int head = isq ? (pn - 6) * 4 + wc : wc;
                const float* gain = isq ? qg : kg;
                const int cbase = (isq ? 0 : 512) + head * 64 + 4 * fq;
                const float scale = isq ? 0.125f * LOG2E : 1.f;
                const bool dorope = u.pm < (ML / BM);
                const f32x4 g1a = *(const f32x4*)(gain + 4 * fq), g2a = *(const f32x4*)(gain + 16 + 4 * fq), g1b = *(const f32x4*)(gain + 32 + 4 * fq), g2b = *(const f32x4*)(gain + 48 + 4 * fq);
#pragma unroll
                for (int ai = 0; ai < 2; ++ai)
#pragma unroll
                    for (int m = 0; m < 4; ++m) { const int row = row0 + ai * HALF + m * 16;
                        f32x4 x1a = acc[ai][0][m][0], x2a = acc[ai][0][m][1], x1b = acc[ai][1][m][0], x2b = acc[ai][1][m][1];
                        float ss = 0.f;
#pragma unroll
                        for (int e = 0; e < 4; ++e) ss += (x1a[e] * x1a[e] + x2a[e] * x2a[e]) + (x1b[e] * x1b[e] + x2b[e] * x2b[e]);
                        ss += __shfl_xor(ss, 16); ss += __shfl_xor(ss, 32);
                        const float rinv = rsqrtf(ss * (1.f / 64.f) + EPSV);
                        x1a = x1a * rinv * g1a; x2a = x2a * rinv * g2a; x1b = x1b * rinv * g1b; x2b = x2b * rinv * g2b;
                        if (dorope) { const int t = row & (SEQ - 1);
                            const float* ra = rope + ((t >> 6) * 16 + 4 * fq) * 2; const f32x4 a0 = *(const f32x4*)ra, a1 = *(const f32x4*)(ra + 4);
                            const float* rb = rope + ((t & 63) * 16 + 4 * fq) * 2; const f32x4 b0 = *(const f32x4*)rb, b1 = *(const f32x4*)(rb + 4);
                            const f32x4 ca = {a0[0], a0[2], a1[0], a1[2]}, sa = {a0[1], a0[3], a1[1], a1[3]}, cb = {b0[0], b0[2], b1[0], b1[2]}, sb = {b0[1], b0[3], b1[1], b1[3]};
                            const f32x4 y1a = x1a * ca - x2a * sa, y2a = x2a * ca + x1a * sa, y1b = x1b * cb - x2b * sb, y2b = x2b * cb + x1b * sb;
                            x1a = y1a; x2a = y2a; x1b = y1b; x2b = y2b; }
                        x1a = x1a * scale; x2a = x2a * scale; x1b = x1b * scale; x2b = x2b * scale;
                        bf16_t* dp = QKVb + (size_t)row * 768 + cbase;
                        u32x2 w;
                        w.x = cvtpk(x1a[0], x1a[1]); w.y = cvtpk(x1a[2], x1a[3]); *(u32x2*)dp = w;
                        w.x = cvtpk(x2a[0], x2a[1]); w.y = cvtpk(x2a[2], x2a[3]); *(u32x2*)(dp + 16) = w;
                        w.x = cvtpk(x1b[0], x1b[1]); w.y = cvtpk(x1b[2], x1b[3]); *(u32x2*)(dp + 32) = w;
                        w.x = cvtpk(x2b[0], x2b[1]); w.y = cvtpk(x2b[2], x2b[3]); *(u32x2*)(dp + 48) = w; }
            }
            return;
        }
        bf16_t* base; int ld, c0, act;
        if (pn < 2) { base = Gb; ld = 512; c0 = pn * 256; act = 0; }
        else if (pn == 2) { base = Zb; ld = 1024; c0 = 0; act = 1; }
        else if (pn == 3) { base = Ub; ld = 512; c0 = 0; act = 0; }
        else if (pn == 4) { base = Ub; ld = 512; c0 = 256; act = 0; }
        else if (pn == 5) { base = Zb; ld = 1024; c0 = 256; act = 1; }
        else if (pn < 11) { base = Zb; ld = 1024; c0 = 512 + (pn - 9) * 256; act = 1; }
        else { base = GTb; ld = 3072; c0 = (pn - 11) * 256; act = 2; }
        const int col0 = c0 + wc * 32 + 8 * fq;
#pragma unroll
        for (int ai = 0; ai < 2; ++ai)
#pragma unroll
            for (int m = 0; m < 4; ++m) { bf16_t* rowp = base + (size_t)(row0 + ai * HALF + m * 16) * ld + col0;
#pragma unroll
                for (int bj = 0; bj < 2; ++bj) { f32x4 v0 = acc[ai][bj][m][0], v1 = acc[ai][bj][m][1];
                    if (act == 1) {
#pragma unroll
                        for (int e = 0; e < 4; ++e) { v0[e] = silu_f(v0[e]); v1[e] = silu_f(v1[e]); } }
                    else if (act == 2) {
#pragma unroll
                        for (int e = 0; e < 4; ++e) { v0[e] = sigm_f(v0[e]); v1[e] = sigm_f(v1[e]); } }
                    u32x4 w; w.x = cvtpk(v0[0], v0[1]); w.y = cvtpk(v0[2], v0[3]); w.z = cvtpk(v1[0], v1[1]); w.w = cvtpk(v1[2], v1[3]);
                    *(u32x4*)(rowp + bj * HALF) = w; } }
    }
};
struct EpiMerge {
    static constexpr bool PERM = true;
    const bf16_t* GTb; bf16_t* MG; int seg;
    __device__ __forceinline__ void operator()(const f32x4 (&acc)[2][2][4][2], const Unit& u, int wr, int wc, int fr, int fq) const {
        const int row0 = u.pm * BM + wr * 64 + fr, col0 = u.pn * BM + wc * 32 + 8 * fq;
#pragma unroll
        for (int ai = 0; ai < 2; ++ai)
#pragma unroll
            for (int m = 0; m < 4; ++m) { const size_t row = (size_t)(row0 + ai * HALF + m * 16);
#pragma unroll
                for (int bj = 0; bj < 2; ++bj) { const int col = col0 + bj * HALF;
                    const u32x4 gw = *(const u32x4*)(GTb + row * 3072 + seg * 1024 + col);
                    f32x4 v0 = acc[ai][bj][m][0], v1 = acc[ai][bj][m][1];
                    v0[0] *= bflo(gw.x); v0[1] *= bfhi(gw.x); v0[2] *= bflo(gw.y); v0[3] *= bfhi(gw.y);
                    v1[0] *= bflo(gw.z); v1[1] *= bfhi(gw.z); v1[2] *= bflo(gw.w); v1[3] *= bfhi(gw.w);
                    bf16_t* mp = MG + row * 1024 + col;
                    if (seg != 0) { const u32x4 mw = *(const u32x4*)mp;
                        v0[0] += bflo(mw.x); v0[1] += bfhi(mw.x); v0[2] += bflo(mw.y); v0[3] += bfhi(mw.y);
                        v1[0] += bflo(mw.z); v1[1] += bfhi(mw.z); v1[2] += bflo(mw.w); v1[3] += bfhi(mw.w); }
                    u32x4 w; w.x = cvtpk(v0[0], v0[1]); w.y = cvtpk(v0[2], v0[3]); w.z = cvtpk(v1[0], v1[1]); w.w = cvtpk(v1[2], v1[3]);
                    *(u32x4*)mp = w; } }
    }
};
struct EpiRes {
    static constexpr bool PERM = false;
    const float* xsrc; float* xdst; const float* csrc; float* cdst; const float* modl;
    __device__ __forceinline__ void operator()(const f32x4 (&acc)[2][2][4][2], const Unit& u, int wr, int wc, int fr, int fq) const {
        const bool isctx = u.pm >= (ML / BM);
        const int rbase = u.pm * BM + wr * 64 + fr;
        const int bi = isctx ? 4 : (rbase >> 13);
        const float* src = isctx ? csrc + (size_t)(rbase - ML) * DM : xsrc + (size_t)rbase * DM;
        float* dst = isctx ? cdst + (size_t)(rbase - ML) * DM : xdst + (size_t)rbase * DM;
        const int col0 = u.pn * BM + wc * 32 + 4 * fq;
#pragma unroll
        for (int bj = 0; bj < 2; ++bj)
#pragma unroll
            for (int n = 0; n < 2; ++n) { const int col = col0 + bj * HALF + n * 16;
                const f32x4 gt = *(const f32x4*)(modl + bi * 3072 + 2048 + col);
#pragma unroll
                for (int ai = 0; ai < 2; ++ai)
#pragma unroll
                    for (int m = 0; m < 4; ++m) { const size_t off = (size_t)(ai * HALF + m * 16) * DM + col;
                        const f32x4 xs = *(const f32x4*)(src + off);
                        *(f32x4*)(dst + off) = xs + gt * acc[ai][bj][m][n]; } }
    }
};
}

template <int NJ, int KC>
__device__ __forceinline__ void ag_load(bf16x8 (&bb)[KC][NJ], const bf16_t* tbase, int ldt, int ch) {
#pragma unroll
    for (int kk = 0; kk < KC; ++kk)
#pragma unroll
        for (int j = 0; j < NJ; ++j) bb[kk][j] = *(const bf16x8*)(tbase + (size_t)j * 16 * ldt + (ch * KC + kk) * 32);
}
template <int NI, int NJ, int KC>
__device__ __forceinline__ void ag_mma(f32x4 (&acc)[NI][NJ], const bf16x8 (&bb)[KC][NJ], const LAS unsigned char* abase, int RS, int ch) {
#pragma unroll
    for (int kk = 0; kk < KC; ++kk) { const LAS unsigned char* ap = abase + (ch * KC + kk) * 32 * RS;
        bf16x8 a[NI];
#pragma unroll
        for (int i = 0; i < NI; ++i) { const s16x4 lo = lds_tr(ap + i * 32), hi = lds_tr(ap + 4 * RS + i * 32); a[i] = cat8(lo, hi); }
#pragma unroll
        for (int i = 0; i < NI; ++i)
#pragma unroll
            for (int j = 0; j < NJ; ++j) acc[i][j] = __builtin_amdgcn_mfma_f32_16x16x32_bf16(a[i], bb[kk][j], acc[i][j], 0, 0, 0);
    }
}
template <int NI, int NJ, int KS, int KC>
__device__ __forceinline__ void act_gemm(f32x4 (&acc)[NI][NJ], const LAS unsigned char* act, int RS, int n0, const bf16_t* tab, int ldt, int lane) {
    constexpr int NC = KS / KC;
    static_assert(NC == 1 || NC % 2 == 0, "chunk count");
    const int g = lane >> 4, c = lane & 15;
    const LAS unsigned char* abase = act + (8 * g + (c >> 2)) * RS + (n0 + 4 * (c & 3)) * 2;
    const bf16_t* tbase = tab + (size_t)c * ldt + 8 * g;
    bf16x8 b0[KC][NJ];
    ag_load<NJ, KC>(b0, tbase, ldt, 0);
    if constexpr (NC == 1) { ag_mma<NI, NJ, KC>(acc, b0, abase, RS, 0); }
    else {
        bf16x8 b1[KC][NJ];
#pragma unroll 1
        for (int ch = 0; ch < NC; ch += 2) {
            ag_load<NJ, KC>(b1, tbase, ldt, ch + 1);
            ag_mma<NI, NJ, KC>(acc, b0, abase, RS, ch);
            if (ch + 2 < NC) ag_load<NJ, KC>(b0, tbase, ldt, ch + 2);
            ag_mma<NI, NJ, KC>(acc, b1, abase, RS, ch + 1);
        }
    }
}
template <int NI, int NJ> __device__ __forceinline__ void zero_acc(f32x4 (&acc)[NI][NJ]) {
#pragma unroll
    for (int i = 0; i < NI; ++i)
#pragma unroll
        for (int j = 0; j < NJ; ++j) acc[i][j] = (f32x4){0.f, 0.f, 0.f, 0.f};
}
__device__ __forceinline__ void mul_store4(bf16_t* p, f32x4 v, bool dry = false) {
    if (dry && v[0] != 1.2345e30f) return;
    const u32x2 z = *(const u32x2*)p;
    u32x2 o; o.x = cvtpk(v[0] * bflo(z.x), v[1] * bfhi(z.x)); o.y = cvtpk(v[2] * bflo(z.y), v[3] * bfhi(z.y));
    *(u32x2*)p = o;
}

struct Params { const float* in[16]; float* out; unsigned char* ws; };

__device__ __forceinline__ void phase0(const Params& p, LAS unsigned char* lds, int tid, int bid, int G) {
    LAS float* sc = (LAS float*)lds;
    LAS float* red = (LAS float*)(lds + 20480);
    for (int i = tid; i < 5120; i += 512) { const float v = i < 4096 ? p.in[1][i] : p.in[3][i - 4096]; sc[i] = v / (1.f + expf(-v)); }
    __syncthreads();
    float* mod = (float*)(p.ws + WS_MOD);
    for (int item = bid; item < 192; item += G) {
        const int l = item / 48, cgp = item % 48, col = tid & 63, kg = tid >> 6, n = cgp * 64 + col;
        const float* w = p.in[4] + ((size_t)l * 1024 + kg * 128) * 3072 + n;
        float a0 = 0.f, a1 = 0.f, a2 = 0.f, a3 = 0.f, a4 = 0.f;
#pragma unroll 8
        for (int k = 0; k < 128; ++k) { const float wv = w[(size_t)k * 3072]; const int kk = kg * 128 + k;
            a0 += sc[kk] * wv; a1 += sc[1024 + kk] * wv; a2 += sc[2048 + kk] * wv; a3 += sc[3072 + kk] * wv; a4 += sc[4096 + kk] * wv; }
        red[(kg * 5 + 0) * 64 + col] = a0; red[(kg * 5 + 1) * 64 + col] = a1; red[(kg * 5 + 2) * 64 + col] = a2; red[(kg * 5 + 3) * 64 + col] = a3; red[(kg * 5 + 4) * 64 + col] = a4;
        __syncthreads();
        if (tid < 320) { const int bi = tid >> 6, c2 = tid & 63; float s = 0.f;
#pragma unroll
            for (int k2 = 0; k2 < 8; ++k2) s += red[(k2 * 5 + bi) * 64 + c2];
            mod[(l * 5 + bi) * 3072 + cgp * 64 + c2] = s + p.in[5][l * 3072 + cgp * 64 + c2]; }
        __syncthreads();
    }
    const int gt = bid * 512 + tid, NT = G * 512;
    float* rope = (float*)(p.ws + WS_ROPE);
    for (int i = gt; i < 5 * 3072; i += NT) ((float*)(p.ws + WS_ROPE + 65536))[i] = 0.f;
    for (int i = gt; i < 2048; i += NT) { const int pos = i >> 4, fi = i & 15; const float inv = powf(10000.f, -(float)fi / 16.f); const float ang = (float)pos * inv; float s, c; sincosf(ang, &s, &c); rope[2 * i] = c; rope[2 * i + 1] = s; }
    if (gt < DEPTH * 64) {
        const int l = gt >> 6, d = gt & 63; float mq = fabsf(p.in[9][l * 64 + d]), mk = fabsf(p.in[10][l * 64 + d]);
#pragma unroll
        for (int o = 1; o < 64; o <<= 1) { mq = fmaxf(mq, __shfl_xor(mq, o)); mk = fmaxf(mk, __shfl_xor(mk, o)); }
        if (d == 0) ((float*)(p.ws + WS_ROPE + 131072))[l] = 8.f * LOG2E * mq * mk * 1.02f; }
    bf16_t* t128 = (bf16_t*)(p.ws + WS_T128);
    for (int i = gt; i < 65536; i += NT) { const int m = i >> 8, k = i & 255, part = m >> 7, k1 = m & 127, pp = k >> 7, l1 = k & 127; const int j = (l1 * k1) & 127; float s, c; sincospif((float)j / 64.f, &s, &c);
        const float v = (part == pp) ? c : (part == 0 ? s : -s); t128[i] = (bf16_t)(cvtpk(v, 0.f) & 0xffffu); }
    bf16_t* tc = (bf16_t*)(p.ws + WS_TC);
    for (int i = gt; i < 256 * 512; i += NT) { const int kk = i >> 9, k = i & 511, part = k >> 8, ll = k & 255; const int j = (kk * ll) & 255; float s, c; sincospif((float)j / 128.f, &s, &c);
        const float v = (part ? s : c) * 0.0625f; tc[i] = (bf16_t)(cvtpk(v, 0.f) & 0xffffu); }
    bf16_t* t3 = (bf16_t*)(p.ws + WS_T3);
    for (int i = gt; i < 128 * 64 * 128; i += NT) { const int k1 = i >> 13, k2 = (i >> 7) & 63, kp = i & 127, l2 = kp >> 1, part = kp & 1; const int j = (l2 * (k1 + 128 * k2)) & 8191; float s, c; sincospif((float)j / 4096.f, &s, &c);
        const float v = (part ? s : c) * 0.011048543456039806f; t3[i] = (bf16_t)(cvtpk(v, 0.f) & 0xffffu); }
}

__device__ __forceinline__ void transpose_blk(const float* Wsrc, int ldw, int K, bf16_t* WTdst, int kb, int perm, LAS float* scr, int lane) {
    const int k0 = 64 * kb;
#pragma unroll 8
    for (int i = 0; i < 32; ++i) { const int kk = 2 * i + (lane >> 5); scr[kk * 33 + (lane & 31)] = Wsrc[(size_t)(k0 + kk) * ldw + (lane & 31)]; }
    asm volatile("s_waitcnt lgkmcnt(0)" ::: "memory");
    const int c = lane & 7;
#pragma unroll
    for (int j = 0; j < 4; ++j) { const int n = (lane >> 3) + 8 * j; const int sc = perm ? (16 * ((n >> 2) & 1) + 4 * (n >> 3) + (n & 3)) : n; const LAS float* s = scr + (8 * c) * 33 + sc;
        u32x4 o; o.x = cvtpk(s[0 * 33], s[1 * 33]); o.y = cvtpk(s[2 * 33], s[3 * 33]); o.z = cvtpk(s[4 * 33], s[5 * 33]); o.w = cvtpk(s[6 * 33], s[7 * 33]);
        *(u32x4*)(WTdst + (size_t)n * K + k0 + 8 * c) = o; }
    asm volatile("s_waitcnt lgkmcnt(0)" ::: "memory");
}
__device__ __forceinline__ void conv_weights(const Params& p, LAS unsigned char* lds, int l, int tid, int lane, int wave, int bid, int G) {
    unsigned char* wsW = p.ws + ((l & 1) ? WS_W1 : WS_W);
    bf16_t* WinT = (bf16_t*)(wsW + W_IN_OFF);
    LAS float* scr = (LAS float*)(lds + wave * 8448);
    LAS float* ctab = (LAS float*)(lds + 8 * 8448);
    if (tid < 64) { float s, c; sincospif((float)tid / 32.f, &s, &c); ctab[tid] = c * 0.125f; ctab[64 + tid] = s * 0.125f; }
    __syncthreads();
    const int gw = bid * 8 + wave, NGW = G * 8;
    const float* win = p.in[6] + (size_t)l * 1024 * INW;
    constexpr int I_IN = 16 * 168, I_PA = 4 * 32, I_PC = 8 * 32, I_OUT = 16 * 32;
    for (int it = gw; it < I_IN + 2 * I_PA + I_PC + I_OUT; it += NGW) {
        int r = it;
        if (r < I_IN) { const int rb = 16 + r % 168, kb = r / 168, n = rb * 32; int c0, perm = 0;
            if (n < 1536 || n >= 2304) c0 = n - 256;
            else if (n < 2048) { const int t = n - 1536, tile = t >> 8, tt = t & 255, bj = tt >> 7, wc = (tt >> 5) & 3; c0 = 1280 + (tile * 4 + wc) * 64 + 32 * bj; perm = 1; }
            else { const int tt = n - 2048, bj = tt >> 7, wc = (tt >> 5) & 3; if (wc < 2) { c0 = 1792 + wc * 64 + 32 * bj; perm = 1; } else c0 = 1920 + (wc - 2) * 64 + 32 * bj; }
            transpose_blk(win + c0, INW, 1024, WinT + (size_t)n * 1024, kb, perm, scr, lane); continue; } r -= I_IN;
        if (r < I_PA) { transpose_blk(p.in[12] + (size_t)l * 256 * 1024 + 32 * (r & 31), 1024, 256, (bf16_t*)(wsW + W_PA_OFF) + (size_t)32 * (r & 31) * 256, r >> 5, 0, scr, lane); continue; } r -= I_PA;
        if (r < I_PA) { transpose_blk(p.in[13] + (size_t)l * 256 * 1024 + 32 * (r & 31), 1024, 256, (bf16_t*)(wsW + W_PB_OFF) + (size_t)32 * (r & 31) * 256, r >> 5, 0, scr, lane); continue; } r -= I_PA;
        if (r < I_PC) { transpose_blk(p.in[14] + (size_t)l * 512 * 1024 + 32 * (r & 31), 1024, 512, (bf16_t*)(wsW + W_PC_OFF) + (size_t)32 * (r & 31) * 512, r >> 5, 0, scr, lane); continue; } r -= I_PC;
        transpose_blk(p.in[15] + (size_t)l * 1024 * 1024 + 32 * (r & 31), 1024, 1024, (bf16_t*)(wsW + W_OUT_OFF) + (size_t)32 * (r & 31) * 1024, r >> 5, 0, scr, lane);
    }
    const int gtid = (G - 1 - bid) * 512 + tid, NT = G * 512;
    for (int id = gtid; id < 65536; id += NT) {
        const int n = id >> 7, ko = id & 127, part = n >> 8, grp = (n >> 6) & 3, m = n & 63;
        const LAS float* tb = ctab + part * 64;
        const float* wrow = win + (size_t)(ko * 8) * INW + grp * 64;
        float a[8];
#pragma unroll
        for (int j = 0; j < 8; ++j) a[j] = 0.f;
#pragma unroll 4
        for (int c4 = 0; c4 < 16; ++c4) {
            const float t0 = tb[(m * (4 * c4)) & 63], t1 = tb[(m * (4 * c4 + 1)) & 63], t2 = tb[(m * (4 * c4 + 2)) & 63], t3 = tb[(m * (4 * c4 + 3)) & 63];
#pragma unroll
            for (int j = 0; j < 8; ++j) { const f32x4 wv = *(const f32x4*)(wrow + (size_t)j * INW + c4 * 4); a[j] += wv[0] * t0 + wv[1] * t1 + wv[2] * t2 + wv[3] * t3; }
        }
        const float sg = part ? -1.f : 1.f;
        u32x4 o; o.x = cvtpk(sg * a[0], sg * a[1]); o.y = cvtpk(sg * a[2], sg * a[3]); o.z = cvtpk(sg * a[4], sg * a[5]); o.w = cvtpk(sg * a[6], sg * a[7]);
        *(u32x4*)(WinT + (size_t)n * 1024 + ko * 8) = o;
    }
    { const float* sw = p.in[7] + (size_t)l * 65536; bf16_t* dw = (bf16_t*)(p.ws + WS_SGUW);
      for (int id = gtid; id < 8192; id += NT) { const f32x4 v0 = *(const f32x4*)(sw + id * 8), v1 = *(const f32x4*)(sw + id * 8 + 4);
          u32x4 o; o.x = cvtpk(v0[0], v0[1]); o.y = cvtpk(v0[2], v0[3]); o.z = cvtpk(v1[0], v1[1]); o.w = cvtpk(v1[2], v1[3]); *(u32x4*)(dw + id * 8) = o; } }
}
__device__ __forceinline__ void h_rows(const Params& p, int l, int lane, int wave, int bid, int G) {
    const int gw = bid * 8 + wave, NGW = G * 8;
    const float* xs = l == 0 ? p.in[0] : p.out;
    const float* cs = l == 0 ? p.in[2] : (const float*)(p.ws + WS_XC);
    const float* mod = (const float*)(p.ws + WS_MOD) + (size_t)l * 5 * 3072;
    bf16_t* H = (bf16_t*)(p.ws + WS_H);
    for (int row = gw; row < MT; row += NGW) {
        const float* src = row < ML ? xs + (size_t)row * DM : cs + (size_t)(row - ML) * DM;
        const int bi = row < ML ? (row >> 13) : 4;
        const float* md = mod + bi * 3072;
        f32x4 v[4]; float ss = 0.f;
#pragma unroll
        for (int j = 0; j < 4; ++j) { v[j] = *(const f32x4*)(src + 4 * lane + 256 * j); ss += (v[j][0] * v[j][0] + v[j][1] * v[j][1]) + (v[j][2] * v[j][2] + v[j][3] * v[j][3]); }
#pragma unroll
        for (int o = 1; o < 64; o <<= 1) ss += __shfl_xor(ss, o);
        const float rinv = rsqrtf(ss * (1.f / 1024.f) + EPSV);
#pragma unroll
        for (int j = 0; j < 4; ++j) { const int idx = 4 * lane + 256 * j; const f32x4 sh = *(const f32x4*)(md + idx), scl = *(const f32x4*)(md + 1024 + idx);
            const f32x4 o = v[j] * rinv * (scl + 1.f) + sh; u32x2 w; w.x = cvtpk(o[0], o[1]); w.y = cvtpk(o[2], o[3]); *(u32x2*)(H + (size_t)row * DM + idx) = w; }
    }
}

__device__ __forceinline__ void attn_item(LAS unsigned char* lds, const bf16_t* QKV, bf16_t* Z, const float* sinkl, const float m0,
                                          int b, int blk, int kvh, int hp, bool isctx, int tid, int lane, int wave, bool dry = false) {
    constexpr int RS = 144;
    LAS unsigned char* Qs = lds; LAS unsigned char* Ks = lds + 256 * RS; LAS unsigned char* Vs = Ks + 128 * RS;
    const int qrow0 = isctx ? (ML + b * 256 + blk * 128) : (b * SEQ + blk * 128);
    __syncthreads();
#pragma unroll
    for (int it = 0; it < 4; ++it) { const int id = it * 512 + tid, r = id >> 3, c16 = id & 7, hl = r >> 7, tq = r & 127;
        *(LAS u32x4*)(Qs + r * RS + c16 * 16) = *(const u32x4*)(QKV + (size_t)(qrow0 + tq) * 768 + (kvh * 4 + hp * 2 + hl) * 64 + c16 * 8); }
    const int hl = wave >> 2, qq = wave & 3, gq = hp * 2 + hl, g = lane >> 4, c = lane & 15;
    const LAS unsigned char* qbase = Qs + (hl * 128 + qq * 32 + c) * RS + 16 * g;
    f32x4 O[4][2]; float l_run[2];
    const float sinkv = sinkl[kvh * 4 + gq] * LOG2E;
    const float mshift = fmaxf(m0, sinkv), nm = -mshift;
    const f32x4 negm = {nm, nm, nm, nm};
#pragma unroll
    for (int qi = 0; qi < 2; ++qi) { l_run[qi] = (g == 0) ? __builtin_amdgcn_exp2f(sinkv - mshift) : 0.f;
#pragma unroll
        for (int df = 0; df < 4; ++df) O[df][qi] = (f32x4){0.f, 0.f, 0.f, 0.f}; }
    const LAS unsigned char* vbase = Vs + (4 * g + (c >> 2)) * RS + (4 * (c & 3)) * 2;
    const int kvoff = 512 + kvh * 64 + (tid & 7) * 8, kr0 = tid >> 3;
    int ti = isctx ? 3 : (blk == 0 ? 1 : 0);
    u32x4 kreg[2], vreg[2];
#define ATT_KROW(t) ((t) >= 3 ? ML + b * 256 + ((t) - 3) * 128 : qrow0 + ((t) - 1) * 128)
#define ATT_PRELOAD(t) do { const bf16_t* src_ = QKV + (size_t)(ATT_KROW(t) + kr0) * 768 + kvoff; \
        kreg[0] = *(const u32x4*)src_; vreg[0] = *(const u32x4*)(src_ + 128); kreg[1] = *(const u32x4*)(src_ + (size_t)64 * 768); vreg[1] = *(const u32x4*)(src_ + (size_t)64 * 768 + 128); } while (0)
    ATT_PRELOAD(ti);
#pragma unroll 1
    while (ti < 5) {
        int tn = ti + 1; if (tn == 2 && blk == 63) tn = 3;
        __syncthreads();
#pragma unroll
        for (int it = 0; it < 2; ++it) { *(LAS u32x4*)(Ks + (kr0 + 64 * it) * RS + (tid & 7) * 16) = kreg[it]; *(LAS u32x4*)(Vs + (kr0 + 64 * it) * RS + (tid & 7) * 16) = vreg[it]; }
        if (tn < 5) ATT_PRELOAD(tn);
        __syncthreads();
#pragma unroll
        for (int qi = 0; qi < 2; ++qi) {
            asm volatile("" ::: "memory"); __builtin_amdgcn_sched_barrier(0);
            f32x4 s[8];
            const bf16x8 qf0 = *(const LAS bf16x8*)(qbase + (16 * qi) * RS), qf1 = *(const LAS bf16x8*)(qbase + (16 * qi) * RS + 64);
#pragma unroll
            for (int kf = 0; kf < 8; ++kf) { const LAS unsigned char* kp = Ks + (16 * kf + c) * RS + 16 * g;
                const bf16x8 k0 = *(const LAS bf16x8*)kp, k1 = *(const LAS bf16x8*)(kp + 64);
                s[kf] = __builtin_amdgcn_mfma_f32_16x16x32_bf16(k0, qf0, negm, 0, 0, 0);
                s[kf] = __builtin_amdgcn_mfma_f32_16x16x32_bf16(k1, qf1, s[kf], 0, 0, 0); }
            if (ti == 0 || ti == 2) { int qidx = qq * 32 + 16 * qi + c; asm volatile("" : "+v"(qidx));
#pragma unroll
                for (int kf = 0; kf < 8; ++kf)
#pragma unroll
                    for (int r = 0; r < 4; ++r) { const int key = 16 * kf + 4 * g + r; const bool valid = (ti == 0) ? (key >= qidx) : (key <= qidx); if (!valid) s[kf][r] = -1e30f; } }
            float psum = 0.f;
#pragma unroll
            for (int kf = 0; kf < 8; ++kf)
#pragma unroll
                for (int r = 0; r < 4; ++r) { const float pv = __builtin_amdgcn_exp2f(s[kf][r]); s[kf][r] = pv; psum += pv; }
            l_run[qi] += psum;
#pragma unroll
            for (int ks = 0; ks < 4; ++ks) {
                u32x4 pw; pw.x = cvtpk(s[2 * ks][0], s[2 * ks][1]); pw.y = cvtpk(s[2 * ks][2], s[2 * ks][3]); pw.z = cvtpk(s[2 * ks + 1][0], s[2 * ks + 1][1]); pw.w = cvtpk(s[2 * ks + 1][2], s[2 * ks + 1][3]);
                const bf16x8 pf = __builtin_bit_cast(bf16x8, pw);
#pragma unroll
                for (int df = 0; df < 4; ++df) { const LAS unsigned char* vp = vbase + (ks * 32) * RS + df * 32;
                    const bf16x8 vf = cat8(lds_tr(vp), lds_tr(vp + 16 * RS));
                    O[df][qi] = __builtin_amdgcn_mfma_f32_16x16x32_bf16(vf, pf, O[df][qi], 0, 0, 0); }
            }
        }
        ti = tn;
    }
#undef ATT_KROW
#undef ATT_PRELOAD
#pragma unroll
    for (int qi = 0; qi < 2; ++qi) { float lt = l_run[qi]; lt += __shfl_xor(lt, 16); lt += __shfl_xor(lt, 32); const float inv = 1.f / lt;
        const size_t row = (size_t)(qrow0 + qq * 32 + 16 * qi + c);
#pragma unroll
        for (int df = 0; df < 4; ++df) mul_store4(Z + row * 1024 + 512 + (kvh * 4 + gq) * 64 + 16 * df + 4 * g, O[df][qi] * inv, dry); }
}

__device__ __forceinline__ void f1_item(LAS unsigned char* lds, const bf16_t* Gb, bf16_t* Afft, const bf16_t* t128, int b, int l2, int tid, int lane, int wave) {
    constexpr int RS = 528;
    __syncthreads();
#pragma unroll
    for (int it = 0; it < 16; ++it) { const int id = it * 512 + tid, row = id >> 5, c16 = id & 31, pp = row >> 7, l1 = row & 127;
        *(LAS u32x4*)(lds + row * RS + c16 * 16) = *(const u32x4*)(Gb + (size_t)(b * SEQ + 64 * l1 + l2) * 512 + pp * 256 + c16 * 8); }
    __syncthreads();
    const int g = lane >> 4, c = lane & 15;
#pragma unroll 1
    for (int mq = 0; mq < 4; ++mq) {
        f32x4 acc[2][4]; zero_acc<2, 4>(acc);
        act_gemm<2, 4, 8, 2>(acc, lds, RS, 32 * wave, t128 + (size_t)(mq * 64) * 256, 256, lane);
#pragma unroll
        for (int i = 0; i < 2; ++i)
#pragma unroll
            for (int j = 0; j < 4; ++j) { const int k1 = (mq & 1) * 64 + 16 * j + c, ch = 32 * wave + 16 * i + 4 * g; const size_t arow = ((size_t)(b * 128 + k1) * 64 + l2) * 2 + (mq >> 1);
                u32x2 o; o.x = cvtpk(acc[i][j][0], acc[i][j][1]); o.y = cvtpk(acc[i][j][2], acc[i][j][3]); *(u32x2*)(Afft + arow * 256 + ch) = o; }
    }
}
__device__ __forceinline__ void sgu_item(LAS unsigned char* lds, const bf16_t* Ub, bf16_t* Z, const bf16_t* sguw, const float* sgub, int ci, int tid, int lane, int wave, bool dry = false) {
    constexpr int RS = 528;
    const int row0 = ci * 128;
    __syncthreads();
    { const int t = tid >> 2, qd = tid & 3; const bf16_t* vp = Ub + (size_t)(row0 + t) * 512 + 256 + qd * 64;
      u32x4 w[8]; float ss = 0.f;
#pragma unroll
      for (int i = 0; i < 8; ++i) { w[i] = *(const u32x4*)(vp + 8 * i);
          const float a0 = bflo(w[i].x), a1 = bfhi(w[i].x), a2 = bflo(w[i].y), a3 = bfhi(w[i].y), a4 = bflo(w[i].z), a5 = bfhi(w[i].z), a6 = bflo(w[i].w), a7 = bfhi(w[i].w);
          ss += (a0 * a0 + a1 * a1) + (a2 * a2 + a3 * a3) + (a4 * a4 + a5 * a5) + (a6 * a6 + a7 * a7); }
      ss += __shfl_xor(ss, 1); ss += __shfl_xor(ss, 2);
      const float rinv = rsqrtf(ss * (1.f / 256.f) + EPSV);
#pragma unroll
      for (int i = 0; i < 8; ++i) { u32x4 o; o.x = cvtpk(bflo(w[i].x) * rinv, bfhi(w[i].x) * rinv); o.y = cvtpk(bflo(w[i].y) * rinv, bfhi(w[i].y) * rinv); o.z = cvtpk(bflo(w[i].z) * rinv, bfhi(w[i].z) * rinv); o.w = cvtpk(bflo(w[i].w) * rinv, bfhi(w[i].w) * rinv);
          *(LAS u32x4*)(lds + t * RS + qd * 128 + i * 16) = o; } }
    __syncthreads();
    const int grp = wave >> 1, sh = wave & 1, g = lane >> 4, c = lane & 15;
    f32x4 acc[4][4]; zero_acc<4, 4>(acc);
    act_gemm<4, 4, 4, 4>(acc, lds, RS, grp * 64, sguw + (size_t)grp * 16384 + (size_t)(sh * 64) * 128, 128, lane);
#pragma unroll
    for (int j = 0; j < 4; ++j) { const int s = sh * 64 + 16 * j + c; const float bias = sgub[grp * 128 + s]; const size_t row = (size_t)(row0 + s);
#pragma unroll
        for (int i = 0; i < 4; ++i) { const int col = grp * 64 + 16 * i + 4 * g; const u32x2 uw = *(const u32x2*)(Ub + row * 512 + col);
            f32x4 v = acc[i][j]; v[0] = (v[0] + bias) * bflo(uw.x); v[1] = (v[1] + bias) * bfhi(uw.x); v[2] = (v[2] + bias) * bflo(uw.y); v[3] = (v[3] + bias) * bfhi(uw.y);
            mul_store4(Z + row * 1024 + 256 + col, v, dry); } }
}
__device__ __forceinline__ void f3_item(LAS unsigned char* lds, const bf16_t* Afft, bf16_t* Z, const bf16_t* t3, int b, int k1, int tid, int lane, int wave, bool dry = false) {
    constexpr int RS = 528;
    __syncthreads();
    const bf16_t* src = Afft + (size_t)(b * 128 + k1) * 128 * 256;
#pragma unroll
    for (int it = 0; it < 8; ++it) { const int id = it * 512 + tid, row = id >> 5, c16 = id & 31;
        *(LAS u32x4*)(lds + row * RS + c16 * 16) = *(const u32x4*)(src + (size_t)row * 256 + c16 * 8); }
    __syncthreads();
    const int g = lane >> 4, c = lane & 15;
    f32x4 acc[2][4]; zero_acc<2, 4>(acc);
    act_gemm<2, 4, 4, 4>(acc, lds, RS, 32 * wave, t3 + (size_t)k1 * 64 * 128, 128, lane);
#pragma unroll
    for (int j = 0; j < 4; ++j) { const int k2 = 16 * j + c; const size_t row = (size_t)b * SEQ + k1 + 128 * k2;
#pragma unroll
        for (int i = 0; i < 2; ++i) mul_store4(Z + row * 1024 + 32 * wave + 16 * i + 4 * g, acc[i][j], dry); }
}
__device__ __forceinline__ void fc_item(LAS unsigned char* lds, const bf16_t* Gb, bf16_t* Z, const bf16_t* tc, int b, int hh, int tid, int lane, int wave, bool dry = false) {
    constexpr int RS = 272;
    __syncthreads();
#pragma unroll 4
    for (int it = 0; it < 16; ++it) { const int id = it * 512 + tid, row = id >> 4, c16 = id & 15, part = row >> 8, ll = row & 255;
        *(LAS u32x4*)(lds + row * RS + c16 * 16) = *(const u32x4*)(Gb + (size_t)(ML + b * 256 + ll) * 512 + part * 256 + hh * 128 + c16 * 8); }
    __syncthreads();
    const int g = lane >> 4, c = lane & 15;
#pragma unroll 1
    for (int jh = 0; jh < 2; ++jh) {
        f32x4 acc[1][8]; zero_acc<1, 8>(acc);
        act_gemm<1, 8, 16, 1>(acc, lds, RS, 16 * wave, tc + (size_t)(jh * 128) * 512, 512, lane);
#pragma unroll
        for (int j = 0; j < 8; ++j) { const size_t row = (size_t)(ML + b * 256 + jh * 128 + 16 * j + c); mul_store4(Z + row * 1024 + hh * 128 + 16 * wave + 4 * g, acc[0][j], dry); }
    }
}

__device__ __forceinline__ void ctx_merge_tile(const bf16_t* Y, const bf16_t* GT, bf16_t* MG, const unsigned char* wsW, int tile, int lane, int wave) {
    const int m = ML + 64 * (tile >> 4) + 16 * (wave >> 1) + (lane & 15), nb = 64 * (tile & 15) + 32 * (wave & 1), g = lane >> 4, c = lane & 15;
    f32x4 mg[2] = {(f32x4){0.f, 0.f, 0.f, 0.f}, (f32x4){0.f, 0.f, 0.f, 0.f}};
#pragma unroll
    for (int seg = 0; seg < 3; ++seg) {
        const int Kseg = seg == 2 ? 512 : 256;
        const bf16_t* Wt = (const bf16_t*)(wsW + (seg == 0 ? W_PA_OFF : (seg == 1 ? W_PB_OFF : W_PC_OFF)));
        const bf16_t* yp = Y + (size_t)m * 1024 + seg * 256 + 8 * g;
        const bf16_t* wp = Wt + (size_t)(nb + c) * Kseg + 8 * g;
        f32x4 acc[2] = {(f32x4){0.f, 0.f, 0.f, 0.f}, (f32x4){0.f, 0.f, 0.f, 0.f}};
#pragma unroll 8
        for (int ks = 0; ks < Kseg / 32; ++ks) {
            const bf16x8 yf = *(const bf16x8*)(yp + ks * 32);
#pragma unroll
            for (int j = 0; j < 2; ++j) { const bf16x8 wf = *(const bf16x8*)(wp + (size_t)j * 16 * Kseg + ks * 32); acc[j] = __builtin_amdgcn_mfma_f32_16x16x32_bf16(wf, yf, acc[j], 0, 0, 0); }
        }
#pragma unroll
        for (int j = 0; j < 2; ++j) { const u32x2 gw = *(const u32x2*)(GT + (size_t)m * 3072 + seg * 1024 + nb + 16 * j + 4 * g);
            mg[j][0] += acc[j][0] * bflo(gw.x); mg[j][1] += acc[j][1] * bfhi(gw.x); mg[j][2] += acc[j][2] * bflo(gw.y); mg[j][3] += acc[j][3] * bfhi(gw.y); }
    }
#pragma unroll
    for (int j = 0; j < 2; ++j) { u32x2 o; o.x = cvtpk(mg[j][0], mg[j][1]); o.y = cvtpk(mg[j][2], mg[j][3]); *(u32x2*)(MG + (size_t)m * 1024 + nb + 16 * j + 4 * g) = o; }
}
__device__ __forceinline__ void ctx_out_tile(const bf16_t* MG, const bf16_t* WoT, const float* csrc, float* cdst, const float* gate_c, int tile, int lane, int wave) {
    const int mr = 64 * (tile >> 4) + 16 * (wave >> 1) + (lane & 15), nb = 64 * (tile & 15) + 32 * (wave & 1), g = lane >> 4, c = lane & 15;
    const bf16_t* ap = MG + (size_t)(ML + mr) * 1024 + 8 * g;
    const bf16_t* wp = WoT + (size_t)(nb + c) * 1024 + 8 * g;
    f32x4 acc[2] = {(f32x4){0.f, 0.f, 0.f, 0.f}, (f32x4){0.f, 0.f, 0.f, 0.f}};
#pragma unroll 8
    for (int ks = 0; ks < 32; ++ks) {
        const bf16x8 yf = *(const bf16x8*)(ap + ks * 32);
#pragma unroll
        for (int j = 0; j < 2; ++j) { const bf16x8 wf = *(const bf16x8*)(wp + (size_t)j * 16 * 1024 + ks * 32); acc[j] = __builtin_amdgcn_mfma_f32_16x16x32_bf16(wf, yf, acc[j], 0, 0, 0); }
    }
#pragma unroll
    for (int j = 0; j < 2; ++j) { const int n = nb + 16 * j + 4 * g; const f32x4 gt = *(const f32x4*)(gate_c + n); const f32x4 xs = *(const f32x4*)(csrc + (size_t)mr * DM + n);
        *(f32x4*)(cdst + (size_t)mr * DM + n) = xs + gt * acc[j]; }
}

#define XB_TMO      128
#define XB_XCNT(j)  (256  + 64 * (j))
#define XB_XSUB(j)  (1280 + 64 * (j))
#define XB_XGEN(j)  (2304 + 64 * (j))
#define XB_TOP      3328
#define XB_TOPGEN   3392
#define XCD_BAR_WORDS 3456
#define XB_SPIN_CAP (1u << 18)
__device__ __forceinline__ unsigned xb_ld(unsigned* p)              { return __hip_atomic_load(p, __ATOMIC_RELAXED, __HIP_MEMORY_SCOPE_AGENT); }
__device__ __forceinline__ unsigned xb_add(unsigned* p, unsigned v) { return __hip_atomic_fetch_add(p, v, __ATOMIC_RELAXED, __HIP_MEMORY_SCOPE_AGENT); }
__device__ __forceinline__ unsigned xb_xcc_id() { return (unsigned)__builtin_amdgcn_s_getreg((3 << 11) | 20) & 0xFu; }
#define XB_SPIN(cond, bar) do { unsigned _sp = 0; while (cond) { __builtin_amdgcn_s_sleep(1); \
    if ((++_sp & 255u) == 0u) { if (xb_ld(&(bar)[XB_TMO])) break; if (_sp > XB_SPIN_CAP) { atomicAdd(&(bar)[XB_TMO], 1u); break; } } } } while (0)
struct XcdBarrier { unsigned* bar; unsigned x; volatile LAS unsigned* st; };
__device__ __forceinline__ XcdBarrier xcd_barrier_post(unsigned* bar, volatile LAS unsigned* st) {
    XcdBarrier b; b.bar = bar; b.x = xb_xcc_id(); b.st = st;
    if (threadIdx.x == 0) (void)xb_add(&bar[XB_XCNT(b.x)], 1u);
    return b;
}
__device__ __forceinline__ void xcd_barrier_complete(unsigned* bar, unsigned x, unsigned& nloc, unsigned& nx) {
    const unsigned G = gridDim.x * gridDim.y * gridDim.z;
    unsigned sum, cnt, mine, sp = 0u;
    for (;;) {
        sum = 0u; cnt = 0u; mine = 0u;
#pragma unroll
        for (unsigned j = 0; j < 16; ++j) { const unsigned c = xb_ld(&bar[XB_XCNT(j)]); sum += c; cnt += (c > 0u) ? 1u : 0u; mine = (j == x) ? c : mine; }
        if (sum == G) break;
        __builtin_amdgcn_s_sleep(1);
        if ((++sp & 255u) == 0u) { if (xb_ld(&bar[XB_TMO])) break; if (sp > XB_SPIN_CAP) { atomicAdd(&bar[XB_TMO], 1u); break; } }
    }
    nloc = mine > 0u ? mine : 1u; nx = cnt > 0u ? cnt : 1u;
}
__device__ __forceinline__ void xcd_barrier(const XcdBarrier& b) {
    asm volatile("s_waitcnt vmcnt(0)" ::: "memory");
    __syncthreads();
    if (threadIdx.x == 0) {
        unsigned* bar = b.bar;
        __builtin_amdgcn_s_waitcnt(0);
        unsigned nloc = b.st[0], nx = b.st[1];
        if (nloc == 0u) { xcd_barrier_complete(bar, b.x, nloc, nx); b.st[0] = nloc; b.st[1] = nx; }
        const unsigned old = xb_add(&bar[XB_XSUB(b.x)], 1u);
        const unsigned gen = old / nloc;
        if (old + 1u == (gen + 1u) * nloc) {
            __builtin_amdgcn_fence(__ATOMIC_RELEASE, "agent");
            asm volatile("s_waitcnt vmcnt(0)" ::: "memory");
            const unsigned og = xb_add(&bar[XB_TOP], 1u);
            const unsigned tg = og / nx;
            if (og + 1u == (tg + 1u) * nx) xb_add(&bar[XB_TOPGEN], 1u);
            else XB_SPIN(xb_ld(&bar[XB_TOPGEN]) == tg, bar);
            __builtin_amdgcn_fence(__ATOMIC_ACQUIRE, "agent");
            xb_add(&bar[XB_XGEN(b.x)], 1u);
            asm volatile("s_waitcnt vmcnt(0)" ::: "memory");
        } else {
            XB_SPIN(xb_ld(&bar[XB_XGEN(b.x)]) == gen, bar);
            __builtin_amdgcn_fence(__ATOMIC_ACQUIRE, "agent");
            asm volatile("s_waitcnt vmcnt(0)" ::: "memory");
        }
    }
    __syncthreads();
}

#define PHASE_IDS() int t__ = threadIdx.x, b__ = blockIdx.x, g__ = gridDim.x; asm volatile("" : "+v"(t__)); asm volatile("" : "+s"(b__), "+s"(g__)); \
    unsigned char* ws = p.ws; asm volatile("" : "+s"(ws)); \
    const int tid = t__, lane = tid & 63, wave = __builtin_amdgcn_readfirstlane(tid >> 6), bid = b__, G = g__; (void)lane; (void)wave; (void)bid; (void)G
__global__ void __launch_bounds__(512, 2) fwd_megakernel(Params p) {
    extern __shared__ __attribute__((aligned(16))) unsigned char lds_raw[];
    LAS unsigned char* lds = (LAS unsigned char*)lds_raw;
    cg::grid_group grid = cg::this_grid();
    volatile LAS unsigned* bst = (volatile LAS unsigned*)(lds + LDS_BYTES - 16);
    if (threadIdx.x < 4) bst[threadIdx.x] = 0u;
    __syncthreads();
    const XcdBarrier xbar = xcd_barrier_post((unsigned*)(p.ws + WS_BAR), bst);
#define GSYNC() do { xcd_barrier(xbar); if (PROBE_DUP == 7) xcd_barrier(xbar); } while (0)
#ifndef SKIP_P0
    { PHASE_IDS(); phase0(p, lds, tid, bid, G); }
#endif
    grid.sync();
#pragma unroll 1
    for (int l = 0; l < DEPTH; ++l) {
        const bool last = (l == DEPTH - 1);
#ifndef SKIP_P1
        for (int rep = (PROBE_DUP == 1 ? 0 : 1); rep < 2; ++rep) { PHASE_IDS(); if (l == 0) { conv_weights(p, lds, 0, tid, lane, wave, bid, G); } h_rows(p, l, lane, wave, bid, G); }
#endif
        GSYNC();
#ifndef SKIP_P2
#pragma unroll 1
        for (int rep = (PROBE_DUP == 2 ? 0 : 1); rep < 2; ++rep) { PHASE_IDS();
          pg8::Gemm g{(const bf16_t*)(ws + WS_H), (const bf16_t*)(ws + ((l & 1) ? WS_W1 : WS_W) + W_IN_OFF), MT, NIN, 1024, 1024}; pg8::StaticOrder S; S.init(MT, NIN, G, bid);
          pg8::EpiProj E{(bf16_t*)(ws + WS_G), (bf16_t*)(ws + WS_Z), (bf16_t*)(ws + WS_U), (bf16_t*)(ws + WS_QKV), (bf16_t*)(ws + WS_GT), (const float*)(ws + WS_ROPE), p.in[9] + l * 64, p.in[10] + l * 64};
          pg8::gemm_phase<pg8::EpiProj>(lds, g, S, E, tid); }
#endif
        GSYNC();
#ifndef SKIP_P3
#pragma unroll 1
        for (int rep = ((PROBE_DUP == 3 || PROBE_DUP == 8) ? 0 : 1); rep < 2; ++rep) { PHASE_IDS(); const bool dry = rep == 0;
          bf16_t* Zb = (bf16_t*)(ws + WS_Z); const bf16_t* QKVb = (const bf16_t*)(ws + WS_QKV);
          const int n_attn = last ? 1024 : 1056, n_f1 = 256, n_sgu = last ? 256 : 264, total = n_attn + n_f1 + n_sgu;
          const float* sinkl = p.in[11] + l * 8; const float* sgub = p.in[8] + l * 512; const float m0 = ((const float*)(ws + WS_ROPE + 131072))[l];
          for (int item = bid + (PROBE_DUP == 8 && rep == 0 ? n_attn : 0); item < total; item += G) {
              int tid = t__; asm volatile("" : "+v"(tid)); const int lane = tid & 63;
#ifndef NO_ATTN
              if (item < n_attn) { const bool ic = item >= 1024; const int i2 = item - 1024;
                                   attn_item(lds, QKVb, Zb, sinkl, m0, ic ? (i2 >> 3) : (item >> 8), ic ? ((i2 >> 2) & 1) : ((item >> 2) & 63), (item >> 1) & 1, item & 1, ic, tid, lane, wave, dry); }
              else
#endif
#ifndef NO_F1
              if (item < n_attn + n_f1) { const int i2 = item - n_attn; f1_item(lds, (const bf16_t*)(ws + WS_G), (bf16_t*)(ws + WS_H), (const bf16_t*)(ws + WS_T128), i2 >> 6, i2 & 63, tid, lane, wave); }
              else
#endif
#ifndef NO_SGU
              { sgu_item(lds, (const bf16_t*)(ws + WS_U), Zb, (const bf16_t*)(ws + WS_SGUW), sgub, item - n_attn - n_f1, tid, lane, wave, dry); }
#else
              {}
#endif
          } }
#endif
        GSYNC();
#ifndef SKIP_P4
#pragma unroll 1
        for (int rep = (PROBE_DUP == 4 ? 0 : 1); rep < 2; ++rep) { PHASE_IDS(); const bool dry = rep == 0;
          bf16_t* Zb = (bf16_t*)(ws + WS_Z);
          const int total = last ? 512 : 520;
          for (int item = bid; item < total; item += G) {
              if (item < 512) f3_item(lds, (const bf16_t*)(ws + WS_H), Zb, (const bf16_t*)(ws + WS_T3), item >> 7, item & 127, tid, lane, wave, dry);
              else { const int i2 = item - 512; fc_item(lds, (const bf16_t*)(ws + WS_G), Zb, (const bf16_t*)(ws + WS_TC), i2 >> 1, i2 & 1, tid, lane, wave, dry); }
          }
          if (!last && rep == 1) { __syncthreads(); conv_weights(p, lds, l + 1, tid, lane, wave, bid, G); } }
#endif
        GSYNC();
#ifndef SKIP_P5
        if (!last) { PHASE_IDS();
          for (int t = bid; t < 256; t += G) ctx_merge_tile((const bf16_t*)(ws + WS_Z), (const bf16_t*)(ws + WS_GT), (bf16_t*)(ws + WS_H), ws + ((l & 1) ? WS_W1 : WS_W), t, lane, wave); }
#pragma unroll 1
        for (int seg = (PROBE_DUP == 5 ? -3 : 0); seg < 3; ++seg) { PHASE_IDS(); const int sg_ = seg < 0 ? seg + 3 : seg;
          const int Mrows = ML; pg8::StaticOrder S; S.init(Mrows, 1024, G, bid);
          const bf16_t* Zb = (const bf16_t*)(ws + WS_Z);
          const size_t woff = sg_ == 0 ? W_PA_OFF : (sg_ == 1 ? W_PB_OFF : W_PC_OFF);
          pg8::Gemm g{Zb + sg_ * 256, (const bf16_t*)(ws + ((l & 1) ? WS_W1 : WS_W) + woff), Mrows, 1024, sg_ == 2 ? 512 : 256, 1024};
          pg8::EpiMerge E{(const bf16_t*)(ws + WS_GT), (bf16_t*)(ws + WS_H), sg_};
          pg8::gemm_phase<pg8::EpiMerge>(lds, g, S, E, tid); }
#endif
        GSYNC();
#ifndef SKIP_P6
#pragma unroll 1
        for (int rep = (PROBE_DUP == 6 ? 0 : 1); rep < 2; ++rep) { PHASE_IDS();
          const int Mrows = ML; pg8::StaticOrder S; S.init(Mrows, 1024, G, bid);
          pg8::Gemm g{(const bf16_t*)(ws + WS_H), (const bf16_t*)(ws + ((l & 1) ? WS_W1 : WS_W) + W_OUT_OFF), Mrows, 1024, 1024, 1024};
          float* XC = (float*)(ws + WS_XC);
          if (!last && rep == 1) { for (int t = bid; t < 256; t += G) ctx_out_tile((const bf16_t*)(ws + WS_H), (const bf16_t*)(ws + ((l & 1) ? WS_W1 : WS_W) + W_OUT_OFF), l == 0 ? p.in[2] : XC, XC, (const float*)(ws + WS_MOD) + (size_t)(l * 5 + 4) * 3072 + 2048, t, lane, wave); }
          pg8::EpiRes E{l == 0 ? p.in[0] : p.out, p.out, l == 0 ? p.in[2] : XC, XC, rep == 0 ? (const float*)(ws + WS_ROPE + 65536) : (const float*)(ws + WS_MOD) + (size_t)l * 5 * 3072};
          pg8::gemm_phase<pg8::EpiRes>(lds, g, S, E, tid); }
#endif
        if (!last) GSYNC();
    }
}

extern "C" void kernel_launch(void* const* d_in, const int* in_sizes, int n_in, void* d_out, int out_size, void* d_ws, size_t ws_size, hipStream_t stream) {
    static int grid = 0;
    if (grid == 0) {
        if (n_in != 16 || ws_size < WS_END) { fprintf(stderr, "kernel_launch: unexpected inputs (n_in %d, ws %zu)\n", n_in, ws_size); grid = -1; return; }
        int dev = 0, cus = 0, per_cu = 0;
        hipGetDevice(&dev);
        hipDeviceGetAttribute(&cus, hipDeviceAttributeMultiprocessorCount, dev);
        hipFuncSetAttribute((const void*)fwd_megakernel, hipFuncAttributeMaxDynamicSharedMemorySize, LDS_BYTES);
        hipOccupancyMaxActiveBlocksPerMultiprocessor(&per_cu, (const void*)fwd_megakernel, 512, LDS_BYTES);
        if (per_cu < 1 || cus < 1) { fprintf(stderr, "kernel_launch: occupancy query gave %d blocks/CU on %d CUs\n", per_cu, cus); grid = -1; return; }
        grid = cus;
    }
    if (grid < 0) return;
    if (hipMemsetAsync((char*)d_ws + WS_BAR, 0, XCD_BAR_WORDS * 4, stream) != hipSuccess) { fprintf(stderr, "kernel_launch: memset of barrier words failed\n"); return; }
    Params p{};
    for (int i = 0; i < 16; ++i) p.in[i] = (const float*)d_in[i];
    p.out = (float*)d_out; p.ws = (unsigned char*)d_ws;
    void* args[] = {&p};
    hipError_t e = hipLaunchCooperativeKernel((const void*)fwd_megakernel, dim3(grid), dim3(512), args, LDS_BYTES, stream);
    if (e != hipSuccess) fprintf(stderr, "cooperative launch failed: %s (grid %d)\n", hipGetErrorString(e), grid);
}
```

```cpp
#include <hip/hip_runtime.h>
#include <hip/hip_cooperative_groups.h>
#include <cstdio>
#include <cstdint>
namespace cg = cooperative_groups;

#define LAS __attribute__((address_space(3)))
typedef unsigned short bf16_t;
typedef short bf16x8 __attribute__((ext_vector_type(8)));
typedef short s16x4 __attribute__((ext_vector_type(4)));
typedef float f32x4 __attribute__((ext_vector_type(4)));
typedef unsigned u32x4 __attribute__((ext_vector_type(4)));
typedef unsigned u32x2 __attribute__((ext_vector_type(2)));
typedef float f32x2_t __attribute__((ext_vector_type(2)));
typedef __bf16 bf16x2_t __attribute__((ext_vector_type(2)));

constexpr int DM = 1024, NB = 4, SEQ = 8192, DEPTH = 4, CTXL = 256;
constexpr int ML = NB * SEQ;
constexpr int MC = NB * CTXL;
constexpr int MT = ML + MC;
constexpr int INW = 5632;
constexpr int NIN = 5888;
constexpr float EPSV = 1e-6f;
constexpr float LOG2E = 1.4426950408889634f;

constexpr size_t MiB = 1u << 20;
constexpr size_t WS_MOD = 0;
constexpr size_t WS_ROPE = 256 * 1024;
constexpr size_t WS_T128 = 512 * 1024;
constexpr size_t WS_TC = 1 * MiB;
constexpr size_t WS_T3 = 2 * MiB;
constexpr size_t WS_SGUW = 4 * MiB;
constexpr size_t WS_BAR = 6 * MiB;
constexpr size_t WS_XC = 8 * MiB;
constexpr size_t WS_W = 16 * MiB;
constexpr size_t W_IN_OFF = 0, W_PA_OFF = (size_t)NIN * 1024 * 2, W_PB_OFF = W_PA_OFF + 1024 * 256 * 2, W_PC_OFF = W_PB_OFF + 1024 * 256 * 2, W_OUT_OFF = W_PC_OFF + 1024 * 512 * 2;
constexpr size_t WS_H = 32 * MiB;
constexpr size_t WS_G = 98 * MiB;
constexpr size_t WS_Z = 131 * MiB;
constexpr size_t WS_U = 197 * MiB;
constexpr size_t WS_QKV = 230 * MiB;
constexpr size_t WS_GT = 280 * MiB;
constexpr size_t WS_W1 = 478 * MiB;
constexpr size_t WS_END = 494 * MiB;
static_assert(W_OUT_OFF + 1024 * 1024 * 2 <= 16 * MiB, "weights fit");

constexpr int LDS_BYTES = 147456;
#ifndef PROBE_DUP
#define PROBE_DUP 0
#endif

__device__ __forceinline__ unsigned cvtpk(float lo, float hi) { f32x2_t v = {lo, hi}; bf16x2_t b = __builtin_convertvector(v, bf16x2_t); return __builtin_bit_cast(unsigned, b); }
__device__ __forceinline__ float bflo(unsigned w) { return __uint_as_float(w << 16); }
__device__ __forceinline__ float bfhi(unsigned w) { return __uint_as_float(w & 0xffff0000u); }
__device__ __forceinline__ float silu_f(float v) { return v * __builtin_amdgcn_rcpf(1.f + __expf(-v)); }
__device__ __forceinline__ float sigm_f(float v) { return __builtin_amdgcn_rcpf(1.f + __expf(-v)); }
typedef short v4i16_t __attribute__((ext_vector_type(4)));
__device__ __forceinline__ s16x4 lds_tr(const LAS unsigned char* p) { return __builtin_bit_cast(s16x4, __builtin_amdgcn_ds_read_tr16_b64_v4i16((LAS v4i16_t*)p)); }
__device__ __forceinline__ bf16x8 cat8(s16x4 a, s16x4 b) { return (bf16x8){a[0], a[1], a[2], a[3], b[0], b[1], b[2], b[3]}; }

namespace pg8 {
constexpr int BM = 256, BK = 64, HALF = 128, HTB = HALF * BK * 2, STAGE_BYTES = 8 * HTB, NXCD = 8, WGM = 8;
__host__ __device__ __forceinline__ int lds_byte(int r, int c) { const int st = (r >> 4) * 2 + (c >> 5), rr = r & 15, cc = c & 31, ob = rr * 64 + cc * 2; return st * 1024 + (ob ^ (((ob >> 9) & 1) << 5)); }
__host__ __device__ __forceinline__ void stage_rc(int b, int& R, int& C) { const int st = b / 1024, sb = b % 1024, swz = sb ^ (((sb >> 9) & 1) << 5); R = (st >> 1) * 16 + swz / 64; C = (st & 1) * 32 + (swz % 64) / 2; }
__host__ __device__ __forceinline__ int perm32(int rho) { const int n = rho >> 4, i = rho & 15; return 8 * (i >> 2) + 4 * n + (i & 3); }
struct Unit { int pm, pn; };
struct Gemm { const bf16_t* A; const bf16_t* Bt; int M, N, K, lda; };
struct StaticOrder {
    int nM, nN, nwg, G, c;
    __host__ __device__ void init(int M, int N, int G_, int c_) { nM = M / BM; nN = N / BM; nwg = nM * nN; G = G_; c = c_; }
    __host__ __device__ bool next(int i, Unit& u) const {
        const long L = (long)i * G + c; if (L >= nwg) return false;
        int wgid = (int)L; { const int q = nwg / NXCD, r = nwg % NXCD, xcd = wgid % NXCD, off = wgid / NXCD; wgid = (xcd < r ? xcd * (q + 1) : r * (q + 1) + (xcd - r) * q) + off; }
        const int nig = WGM * nN, gid = wgid / nig, fm = gid * WGM, gsz = (nM - fm) < WGM ? (nM - fm) : WGM;
        u.pm = fm + ((wgid % nig) % gsz); u.pn = (wgid % nig) / gsz; return true;
    }
};
template <class Epi>
__device__ __forceinline__ void gemm_phase(LAS unsigned char* lds, const Gemm g, const StaticOrder& S, const Epi& E, const int tid) {
    const int wid = __builtin_amdgcn_readfirstlane(tid >> 6), lane = tid & 63, wr = wid >> 2, wc = wid & 3, fr = lane & 15, fq = lane >> 4;
    const int K = g.K, nt = K / BK, lda = g.lda;
    unsigned voffA[2], voffB[2];
#pragma unroll
    for (int i = 0; i < 2; ++i) { int R, C; stage_rc(tid * 16 + i * 8192, R, C); const int Rb = Epi::PERM ? ((R & ~31) + perm32(R & 31)) : R;
        voffA[i] = (unsigned)(R * lda + C) * 2u; voffB[i] = (unsigned)(Rb * K + C) * 2u; }
    const size_t kstep = (size_t)(BK * 2);
    const size_t hstepA = (size_t)HALF * lda * 2, hstepB = (size_t)HALF * K * 2;
    const size_t tstepA = 2 * hstepA, tstepB = 2 * hstepB;
    const unsigned ldsw = (unsigned)wid * 1024u;
    const int aoff = lds_byte(wr * 64 + fr, fq * 8), boff = lds_byte(wc * 32 + fr, fq * 8);
#define PG8_SA(b, h) (((b) * 2 + (h)) * HTB)
#define PG8_SB(b, h) ((4 + (b) * 2 + (h)) * HTB)
#define PG8_STAGE(bufoff, gbase, voff) do { _Pragma("unroll") for (int _i = 0; _i < 2; ++_i) \
        __builtin_amdgcn_global_load_lds((const unsigned*)((const char*)(gbase) + (voff)[_i]), (LAS unsigned*)(lds + (bufoff) + ldsw + _i * 8192), 16, 0, 0); } while (0)
#define PG8_LDA(dst, b, h) do { _Pragma("unroll") for (int m = 0; m < 4; ++m) _Pragma("unroll") for (int k = 0; k < 2; ++k) dst[m][k] = *(const LAS bf16x8*)(lds + PG8_SA(b, h) + aoff + m * 2048 + k * 1024); } while (0)
#define PG8_LDB(dst, b, h) do { _Pragma("unroll") for (int n = 0; n < 2; ++n) _Pragma("unroll") for (int k = 0; k < 2; ++k) dst[n][k] = *(const LAS bf16x8*)(lds + PG8_SB(b, h) + boff + n * 2048 + k * 1024); } while (0)
#define PG8_MMA(ai, bj, At, Bt) do { __builtin_amdgcn_s_setprio(1); _Pragma("unroll") for (int m = 0; m < 4; ++m) _Pragma("unroll") for (int n = 0; n < 2; ++n) _Pragma("unroll") for (int k = 0; k < 2; ++k) \
        acc[ai][bj][m][n] = __builtin_amdgcn_mfma_f32_16x16x32_bf16(Bt[n][k], At[m][k], acc[ai][bj][m][n], 0, 0, 0); __builtin_amdgcn_s_setprio(0); } while (0)
#define PG8_WAIT_V(n) asm volatile("s_waitcnt vmcnt(" #n ")" ::: "memory")
#define PG8_WAIT_L(n) asm volatile("s_waitcnt lgkmcnt(" #n ")" ::: "memory")
#define PG8_BAR __builtin_amdgcn_s_barrier()
#define PG8_SCHED __builtin_amdgcn_sched_barrier(0)
    Unit cur, nxt; int ui = 0;
    if (!S.next(0, cur)) return;
    f32x4 acc[2][2][4][2];
#pragma unroll
    for (int a = 0; a < 2; ++a)
#pragma unroll
        for (int b = 0; b < 2; ++b)
#pragma unroll
            for (int m = 0; m < 4; ++m)
#pragma unroll
                for (int n = 0; n < 2; ++n) acc[a][b][m][n] = (f32x4){0.f, 0.f, 0.f, 0.f};
    bf16x8 At[4][2], B0[2][2], B1[2][2];
    const char* cA = (const char*)g.A + (size_t)cur.pm * tstepA; const char* cB = (const char*)g.Bt + (size_t)cur.pn * tstepB;
    PG8_STAGE(PG8_SB(0, 0), cB, voffB); PG8_STAGE(PG8_SB(0, 1), cB + hstepB, voffB); PG8_STAGE(PG8_SA(0, 0), cA, voffA); PG8_STAGE(PG8_SA(0, 1), cA + hstepA, voffA);
    if (wr == 1) PG8_BAR;
    PG8_WAIT_V(2); PG8_BAR;
    PG8_STAGE(PG8_SB(1, 0), cB + kstep, voffB); PG8_STAGE(PG8_SA(1, 0), cA + kstep, voffA); PG8_STAGE(PG8_SB(1, 1), cB + hstepB + kstep, voffB);
    PG8_WAIT_V(6); PG8_BAR;
    for (;;) {
        const bool has_next = S.next(ui + 1, nxt);
        const char* nA = has_next ? (const char*)g.A + (size_t)nxt.pm * tstepA : cA; const char* nB = has_next ? (const char*)g.Bt + (size_t)nxt.pn * tstepB : cB;
        for (int t = 0; t < nt; t += 2) {
            const bool last = (t == nt - 2);
            const char* a1 = cA + (size_t)(t + 1) * kstep;
            const char* a2 = last ? nA : cA + (size_t)(t + 2) * kstep; const char* b2 = last ? nB : cB + (size_t)(t + 2) * kstep;
            const char* a3 = a2 + kstep; const char* b3 = b2 + kstep;
            PG8_LDB(B0, 0, 0); PG8_LDB(B1, 0, 1); PG8_SCHED; PG8_LDA(At, 0, 0); PG8_STAGE(PG8_SA(1, 1), a1 + hstepA, voffA);
            PG8_WAIT_V(8); PG8_WAIT_L(0); PG8_BAR; PG8_MMA(0, 0, At, B0); PG8_MMA(0, 1, At, B1); PG8_BAR; PG8_SCHED;
            PG8_LDA(At, 0, 1); PG8_STAGE(PG8_SB(0, 0), b2, voffB); PG8_STAGE(PG8_SB(0, 1), b2 + hstepB, voffB); PG8_STAGE(PG8_SA(0, 0), a2, voffA);
            PG8_WAIT_V(8); PG8_WAIT_L(0); PG8_BAR; PG8_MMA(1, 0, At, B0); PG8_MMA(1, 1, At, B1); PG8_BAR; PG8_SCHED;
            PG8_LDB(B0, 1, 0); PG8_LDB(B1, 1, 1); PG8_SCHED; PG8_LDA(At, 1, 0); PG8_STAGE(PG8_SA(0, 1), a2 + hstepA, voffA);
            PG8_WAIT_V(8); PG8_WAIT_L(0); PG8_BAR; PG8_MMA(0, 0, At, B0); PG8_MMA(0, 1, At, B1); PG8_BAR; PG8_SCHED;
            PG8_LDA(At, 1, 1); PG8_STAGE(PG8_SB(1, 0), b3, voffB); PG8_STAGE(PG8_SB(1, 1), b3 + hstepB, voffB); PG8_STAGE(PG8_SA(1, 0), a3, voffA);
            PG8_WAIT_V(8); PG8_WAIT_L(0); PG8_BAR; PG8_MMA(1, 0, At, B0); PG8_MMA(1, 1, At, B1); PG8_BAR; PG8_SCHED;
        }
        if (wr == 0) PG8_BAR;
        { Unit ue = cur; asm volatile("" : "+s"(ue.pm), "+s"(ue.pn));
          E(acc, ue, wr, wc, fr, fq); }
        if (!has_next) break;
#pragma unroll
        for (int a = 0; a < 2; ++a)
#pragma unroll
            for (int b = 0; b < 2; ++b)
#pragma unroll
                for (int m = 0; m < 4; ++m)
#pragma unroll
                    for (int n = 0; n < 2; ++n) acc[a][b][m][n] = (f32x4){0.f, 0.f, 0.f, 0.f};
        cur = nxt; cA = nA; cB = nB; ++ui;
        if (wr == 1) PG8_BAR;
    }
    PG8_WAIT_V(0);
    PG8_BAR;
#undef PG8_SA
#undef PG8_SB
#undef PG8_STAGE
#undef PG8_LDA
#undef PG8_LDB
#undef PG8_MMA
#undef PG8_WAIT_V
#undef PG8_WAIT_L
#undef PG8_BAR
#undef PG8_SCHED
}

struct EpiProj {
    static constexpr bool PERM = true;
    bf16_t *Gb, *Zb, *Ub, *QKVb, *GTb; const float *rope, *qg, *kg;
    __device__ __forceinline__ void operator()(const f32x4 (&acc)[2][2][4][2], const Unit& u, int wr, int wc, int fr, int fq) const {
        const int pn = u.pn;
        const int row0 = u.pm * BM + wr * 64 + fr;
        if (pn >= 6 && pn <= 8) {
            const bool isq = pn < 8;
            if (!isq && wc >= 2) {
#pragma unroll
                for (int ai = 0; ai < 2; ++ai)
#pragma unroll
                    for (int m = 0; m < 4; ++m) { bf16_t* rowp = QKVb + (size_t)(row0 + ai * HALF + m * 16) * 768 + 640 + (wc - 2) * 64 + 8 * fq;
#pragma unroll
                        for (int bj = 0; bj < 2; ++bj) { const f32x4 v0 = acc[ai][bj][m][0], v1 = acc[ai][bj][m][1];
                            u32x4 w; w.x = cvtpk(v0[0], v0[1]); w.y = cvtpk(v0[2], v0[3]); w.z = cvtpk(v1[0], v1[1]); w.w = cvtpk(v1[2], v1[3]);
                            *(u32x4*)(rowp + bj * 32) = w; } }
            } else {
                const int head = isq ? (pn - 6) * 4 + wc : wc;
                const float* gain = isq ? qg : kg;
                const int cbase = (isq ? 0 : 512) + head * 64 + 4 * fq;
                const float scale = isq ? 0.125f * LOG2E : 1.f;
                const bool dorope = u.pm < (ML / BM);
                const f32x4 g1a = *(const f32x4*)(gain + 4 * fq), g2a = *(const f32x4*)(gain + 16 + 4 * fq), g1b = *(const f32x4*)(gain + 32 + 4 * fq), g2b = *(const f32x4*)(gain + 48 + 4 * fq);
#pragma unroll
                for (int ai = 0; ai < 2; ++ai)
#pragma unroll
                    for (int m = 0; m < 4; ++m) { const int row = row0 + ai * HALF + m * 16;
                        f32x4 x1a = acc[ai][0][m][0], x2a = acc[ai][0][m][1], x1b = acc[ai][1][m][0], x2b = acc[ai][1][m][1];
                        float ss = 0.f;
#pragma unroll
                        for (int e = 0; e < 4; ++e) ss += (x1a[e] * x1a[e] + x2a[e] * x2a[e]) + (x1b[e] * x1b[e] + x2b[e] * x2b[e]);
                        ss += __shfl_xor(ss, 16); ss += __shfl_xor(ss, 32);
                        const float rinv = rsqrtf(ss * (1.f / 64.f) + EPSV);
                        x1a = x1a * rinv * g1a; x2a = x2a * rinv * g2a; x1b = x1b * rinv * g1b; x2b = x2b * rinv * g2b;
                        if (dorope) { const int t = row & (SEQ - 1);
                            const float* ra = rope + ((t >> 6) * 16 + 4 * fq) * 2; const f32x4 a0 = *(const f32x4*)ra, a1 = *(const f32x4*)(ra + 4);
                            const float* rb = rope + ((t & 63) * 16 + 4 * fq) * 2; const f32x4 b0 = *(const f32x4*)rb, b1 = *(const f32x4*)(rb + 4);
                            const f32x4 ca = {a0[0], a0[2], a1[0], a1[2]}, sa = {a0[1], a0[3], a1[1], a1[3]}, cb = {b0[0], b0[2], b1[0], b1[2]}, sb = {b0[1], b0[3], b1[1], b1[3]};
                            const f32x4 y1a = x1a * ca - x2a * sa, y2a = x2a * ca + x1a * sa, y1b = x1b * cb - x2b * sb, y2b = x2b * cb + x1b * sb;
                            x1a = y1a; x2a = y2a; x1b = y1b; x2b = y2b; }
                        x1a = x1a * scale; x2a = x2a * scale; x1b = x1b * scale; x2b = x2b * scale;
                        bf16_t* dp = QKVb + (size_t)row * 768 + cbase;
                        u32x2 w;
                        w.x = cvtpk(x1a[0], x1a[1]); w.y = cvtpk(x1a[2], x1a[3]); *(u32x2*)dp = w;
                        w.x = cvtpk(x2a[0], x2a[1]); w.y = cvtpk(x2a[2], x2a[3]); *(u32x2*)(dp + 16) = w;
                        w.x = cvtpk(x1b[0], x1b[1]); w.y = cvtpk(x1b[2], x1b[3]); *(u32x2*)(dp + 32) = w;
                        w.x = cvtpk(x2b[0], x2b[1]); w.y = cvtpk(x2b[2], x2b[3]); *(u32x2*)(dp + 48) = w; }
            }
            return;
        }
        bf16_t* base; int ld, c0, act;
        if (pn < 2) { base = Gb; ld = 512; c0 = pn * 256; act = 0; }
        else if (pn == 2) { base = Zb; ld = 1024; c0 = 0; act = 1; }
        else if (pn == 3) { base = Ub; ld = 512; c0 = 0; act = 0; }
        else if (pn == 4) { base = Ub; ld = 512; c0 = 256; act = 0; }
        else if (pn == 5) { base = Zb; ld = 1024; c0 = 256; act = 1; }
        else if (pn < 11) { base = Zb; ld = 1024; c0 = 512 + (pn - 9) * 256; act = 1; }
        else { base = GTb; ld = 3072; c0 = (pn - 11) * 256; act = 2; }
        const int col0 = c0 + wc * 32 + 8 * fq;
#pragma unroll
        for (int ai = 0; ai < 2; ++ai)
#pragma unroll
            for (int m = 0; m < 4; ++m) { bf16_t* rowp = base + (size_t)(row0 + ai * HALF + m * 16) * ld + col0;
#pragma unroll
                for (int bj = 0; bj < 2; ++bj) { f32x4 v0 = acc[ai][bj][m][0], v1 = acc[ai][bj][m][1];
                    if (act == 1) {
#pragma unroll
                        for (int e = 0; e < 4; ++e) { v0[e] = silu_f(v0[e]); v1[e] = silu_f(v1[e]); } }
                    else if (act == 2) {
#pragma unroll
                        for (int e = 0; e < 4; ++e) { v0[e] = sigm_f(v0[e]); v1[e] = sigm_f(v1[e]); } }
                    u32x4 w; w.x = cvtpk(v0[0], v0[1]); w.y = cvtpk(v0[2], v0[3]); w.z = cvtpk(v1[0], v1[1]); w.w = cvtpk(v1[2], v1[3]);
                    *(u32x4*)(rowp + bj * HALF) = w; } }
    }
};
struct EpiMerge {
    static constexpr bool PERM = true;
    const bf16_t* GTb; bf16_t* MG; int seg;
    __device__ __forceinline__ void operator()(const f32x4 (&acc)[2][2][4][2], const Unit& u, int wr, int wc, int fr, int fq) const {
        const int row0 = u.pm * BM + wr * 64 + fr, col0 = u.pn * BM + wc * 32 + 8 * fq;
#pragma unroll
        for (int ai = 0; ai < 2; ++ai)
#pragma unroll
            for (int m = 0; m < 4; ++m) { const size_t row = (size_t)(row0 + ai * HALF + m * 16);
#pragma unroll
                for (int bj = 0; bj < 2; ++bj) { const int col = col0 + bj * HALF;
                    const u32x4 gw = *(const u32x4*)(GTb + row * 3072 + seg * 1024 + col);
                    f32x4 v0 = acc[ai][bj][m][0], v1 = acc[ai][bj][m][1];
                    v0[0] *= bflo(gw.x); v0[1] *= bfhi(gw.x); v0[2] *= bflo(gw.y); v0[3] *= bfhi(gw.y);
                    v1[0] *= bflo(gw.z); v1[1] *= bfhi(gw.z); v1[2] *= bflo(gw.w); v1[3] *= bfhi(gw.w);
                    bf16_t* mp = MG + row * 1024 + col;
                    if (seg != 0) { const u32x4 mw = *(const u32x4*)mp;
                        v0[0] += bflo(mw.x); v0[1] += bfhi(mw.x); v0[2] += bflo(mw.y); v0[3] += bfhi(mw.y);
                        v1[0] += bflo(mw.z); v1[1] += bfhi(mw.z); v1[2] += bflo(mw.w); v1[3] += bfhi(mw.w); }
                    u32x4 w; w.x = cvtpk(v0[0], v0[1]); w.y = cvtpk(v0[2], v0[3]); w.z = cvtpk(v1[0], v1[1]); w.w = cvtpk(v1[2], v1[3]);
                    *(u32x4*)mp = w; } }
    }
};
struct EpiRes {
    static constexpr bool PERM = false;
    const float* xsrc; float* xdst; const float* csrc; float* cdst; const float* modl;
    __device__ __forceinline__ void operator()(const f32x4 (&acc)[2][2][4][2], const Unit& u, int wr, int wc, int fr, int fq) const {
        const bool isctx = u.pm >= (ML / BM);
        const int rbase = u.pm * BM + wr * 64 + fr;
        const int bi = isctx ? 4 : (rbase >> 13);
        const float* src = isctx ? csrc + (size_t)(rbase - ML) * DM : xsrc + (size_t)rbase * DM;
        float* dst = isctx ? cdst + (size_t)(rbase - ML) * DM : xdst + (size_t)rbase * DM;
        const int col0 = u.pn * BM + wc * 32 + 4 * fq;
#pragma unroll
        for (int bj = 0; bj < 2; ++bj)
#pragma unroll
            for (int n = 0; n < 2; ++n) { const int col = col0 + bj * HALF + n * 16;
                const f32x4 gt = *(const f32x4*)(modl + bi * 3072 + 2048 + col);
#pragma unroll
                for (int ai = 0; ai < 2; ++ai)
#pragma unroll
                    for (int m = 0; m < 4; ++m) { const size_t off = (size_t)(ai * HALF + m * 16) * DM + col;
                        const f32x4 xs = *(const f32x4*)(src + off);
                        *(f32x4*)(dst + off) = xs + gt * acc[ai][bj][m][n]; } }
    }
};
}

template <int NJ, int KC>
__device__ __forceinline__ void ag_load(bf16x8 (&bb)[KC][NJ], const bf16_t* tbase, int ldt, int ch) {
#pragma unroll
    for (int kk = 0; kk < KC; ++kk)
#pragma unroll
        for (int j = 0; j < NJ; ++j) bb[kk][j] = *(const bf16x8*)(tbase + (size_t)j * 16 * ldt + (ch * KC + kk) * 32);
}
template <int NI, int NJ, int KC>
__device__ __forceinline__ void ag_mma(f32x4 (&acc)[NI][NJ], const bf16x8 (&bb)[KC][NJ], const LAS unsigned char* abase, int RS, int ch) {
#pragma unroll
    for (int kk = 0; kk < KC; ++kk) { const LAS unsigned char* ap = abase + (ch * KC + kk) * 32 * RS;
        bf16x8 a[NI];
#pragma unroll
        for (int i = 0; i < NI; ++i) { const s16x4 lo = lds_tr(ap + i * 32), hi = lds_tr(ap + 4 * RS + i * 32); a[i] = cat8(lo, hi); }
#pragma unroll
        for (int i = 0; i < NI; ++i)
#pragma unroll
            for (int j = 0; j < NJ; ++j) acc[i][j] = __builtin_amdgcn_mfma_f32_16x16x32_bf16(a[i], bb[kk][j], acc[i][j], 0, 0, 0);
    }
}
template <int NI, int NJ, int KS, int KC>
__device__ __forceinline__ void act_gemm(f32x4 (&acc)[NI][NJ], const LAS unsigned char* act, int RS, int n0, const bf16_t* tab, int ldt, int lane) {
    constexpr int NC = KS / KC;
    static_assert(NC == 1 || NC % 2 == 0, "chunk count");
    const int g = lane >> 4, c = lane & 15;
    const LAS unsigned char* abase = act + (8 * g + (c >> 2)) * RS + (n0 + 4 * (c & 3)) * 2;
    const bf16_t* tbase = tab + (size_t)c * ldt + 8 * g;
    bf16x8 b0[KC][NJ];
    ag_load<NJ, KC>(b0, tbase, ldt, 0);
    if constexpr (NC == 1) { ag_mma<NI, NJ, KC>(acc, b0, abase, RS, 0); }
    else {
        bf16x8 b1[KC][NJ];
#pragma unroll 1
        for (int ch = 0; ch < NC; ch += 2) {
            ag_load<NJ, KC>(b1, tbase, ldt, ch + 1);
            ag_mma<NI, NJ, KC>(acc, b0, abase, RS, ch);
            if (ch + 2 < NC) ag_load<NJ, KC>(b0, tbase, ldt, ch + 2);
            ag_mma<NI, NJ, KC>(acc, b1, abase, RS, ch + 1);
        }
    }
}
template <int NI, int NJ> __device__ __forceinline__ void zero_acc(f32x4 (&acc)[NI][NJ]) {
#pragma unroll
    for (int i = 0; i < NI; ++i)
#pragma unroll
        for (int j = 0; j < NJ; ++j) acc[i][j] = (f32x4){0.f, 0.f, 0.f, 0.f};
}
__device__ __forceinline__ void mul_store4(bf16_t* p, f32x4 v, bool dry = false) {
    if (dry && v[0] != 1.2345e30f) return;
    const u32x2 z = *(const u32x2*)p;
    u32x2 o; o.x = cvtpk(v[0] * bflo(z.x), v[1] * bfhi(z.x)); o.y = cvtpk(v[2] * bflo(z.y), v[3] * bfhi(z.y));
    *(u32x2*)p = o;
}

struct Params { const float* in[16]; float* out; unsigned char* ws; };

__device__ __forceinline__ void phase0(const Params& p, LAS unsigned char* lds, int tid, int bid, int G) {
    LAS float* sc = (LAS float*)lds;
    LAS float* red = (LAS float*)(lds + 20480);
    for (int i = tid; i < 5120; i += 512) { const float v = i < 4096 ? p.in[1][i] : p.in[3][i - 4096]; sc[i] = v / (1.f + expf(-v)); }
    __syncthreads();
    float* mod = (float*)(p.ws + WS_MOD);
    for (int item = bid; item < 192; item += G) {
        const int l = item / 48, cgp = item % 48, col = tid & 63, kg = tid >> 6, n = cgp * 64 + col;
        const float* w = p.in[4] + ((size_t)l * 1024 + kg * 128) * 3072 + n;
        float a0 = 0.f, a1 = 0.f, a2 = 0.f, a3 = 0.f, a4 = 0.f;
#pragma unroll 8
        for (int k = 0; k < 128; ++k) { const float wv = w[(size_t)k * 3072]; const int kk = kg * 128 + k;
            a0 += sc[kk] * wv; a1 += sc[1024 + kk] * wv; a2 += sc[2048 + kk] * wv; a3 += sc[3072 + kk] * wv; a4 += sc[4096 + kk] * wv; }
        red[(kg * 5 + 0) * 64 + col] = a0; red[(kg * 5 + 1) * 64 + col] = a1; red[(kg * 5 + 2) * 64 + col] = a2; red[(kg * 5 + 3) * 64 + col] = a3; red[(kg * 5 + 4) * 64 + col] = a4;
        __syncthreads();
        if (tid < 320) { const int bi = tid >> 6, c2 = tid & 63; float s = 0.f;
#pragma unroll
            for (int k2 = 0; k2 < 8; ++k2) s += red[(k2 * 5 + bi) * 64 + c2];
            mod[(l * 5 + bi) * 3072 + cgp * 64 + c2] = s + p.in[5][l * 3072 + cgp * 64 + c2]; }
        __syncthreads();
    }
    const int gt = bid * 512 + tid, NT = G * 512;
    float* rope = (float*)(p.ws + WS_ROPE);
    for (int i = gt; i < 5 * 3072; i += NT) ((float*)(p.ws + WS_ROPE + 65536))[i] = 0.f;
    for (int i = gt; i < 2048; i += NT) { const int pos = i >> 4, fi = i & 15; const float inv = exp2f(-(float)fi * (13.287712379549449f / 16.f)); const float ang = (float)pos * inv;
        const double rev = (double)ang * 0.15915494309189535; const double frc = rev - floor(rev); float s, c; sincospif((float)(2.0 * frc), &s, &c); rope[2 * i] = c; rope[2 * i + 1] = s; }
    if (gt < DEPTH * 64) {
        const int l = gt >> 6, d = gt & 63; float mq = fabsf(p.in[9][l * 64 + d]), mk = fabsf(p.in[10][l * 64 + d]);
#pragma unroll
        for (int o = 1; o < 64; o <<= 1) { mq = fmaxf(mq, __shfl_xor(mq, o)); mk = fmaxf(mk, __shfl_xor(mk, o)); }
        if (d == 0) ((float*)(p.ws + WS_ROPE + 131072))[l] = 8.f * LOG2E * mq * mk * 1.02f; }
    bf16_t* t128 = (bf16_t*)(p.ws + WS_T128);
    for (int i = gt; i < 65536; i += NT) { const int m = i >> 8, k = i & 255, part = m >> 7, k1 = m & 127, pp = k >> 7, l1 = k & 127; const int j = (l1 * k1) & 127; float s, c; sincospif((float)j / 64.f, &s, &c);
        const float v = (part == pp) ? c : (part == 0 ? s : -s); t128[i] = (bf16_t)(cvtpk(v, 0.f) & 0xffffu); }
    bf16_t* tc = (bf16_t*)(p.ws + WS_TC);
    for (int i = gt; i < 256 * 512; i += NT) { const int kk = i >> 9, k = i & 511, part = k >> 8, ll = k & 255; const int j = (kk * ll) & 255; float s, c; sincospif((float)j / 128.f, &s, &c);
        const float v = (part ? s : c) * 0.0625f; tc[i] = (bf16_t)(cvtpk(v, 0.f) & 0xffffu); }
    bf16_t* t3 = (bf16_t*)(p.ws + WS_T3);
    for (int i = gt; i < 128 * 64 * 128; i += NT) { const int k1 = i >> 13, k2 = (i >> 7) & 63, kp = i & 127, l2 = kp >> 1, part = kp & 1; const int j = (l2 * (k1 + 128 * k2)) & 8191; float s, c; sincospif((float)j / 4096.f, &s, &c);
        const float v = (part ? s : c) * 0.011048543456039806f; t3[i] = (bf16_t)(cvtpk(v, 0.f) & 0xffffu); }
}

__device__ __forceinline__ void transpose_blk(const float* Wsrc, int ldw, int K, bf16_t* WTdst, int kb, int perm, LAS float* scr, int lane) {
    const int k0 = 64 * kb;
#pragma unroll 8
    for (int i = 0; i < 32; ++i) { const int kk = 2 * i + (lane >> 5); scr[kk * 33 + (lane & 31)] = Wsrc[(size_t)(k0 + kk) * ldw + (lane & 31)]; }
    asm volatile("s_waitcnt lgkmcnt(0)" ::: "memory");
    const int c = lane & 7;
#pragma unroll
    for (int j = 0; j < 4; ++j) { const int n = (lane >> 3) + 8 * j; const int sc = perm ? (16 * ((n >> 2) & 1) + 4 * (n >> 3) + (n & 3)) : n; const LAS float* s = scr + (8 * c) * 33 + sc;
        u32x4 o; o.x = cvtpk(s[0 * 33], s[1 * 33]); o.y = cvtpk(s[2 * 33], s[3 * 33]); o.z = cvtpk(s[4 * 33], s[5 * 33]); o.w = cvtpk(s[6 * 33], s[7 * 33]);
        *(u32x4*)(WTdst + (size_t)n * K + k0 + 8 * c) = o; }
    asm volatile("s_waitcnt lgkmcnt(0)" ::: "memory");
}
__device__ __forceinline__ void conv_weights(const Params& p, LAS unsigned char* lds, int l, int tid, int lane, int wave, int bid, int G) {
    unsigned char* wsW = p.ws + ((l & 1) ? WS_W1 : WS_W);
    bf16_t* WinT = (bf16_t*)(wsW + W_IN_OFF);
    LAS float* scr = (LAS float*)(lds + wave * 8448);
    LAS float* ctab = (LAS float*)(lds + 8 * 8448);
    if (tid < 64) { float s, c; sincospif((float)tid / 32.f, &s, &c); ctab[tid] = c * 0.125f; ctab[64 + tid] = s * 0.125f; }
    __syncthreads();
    const int gw = bid * 8 + wave, NGW = G * 8;
    const float* win = p.in[6] + (size_t)l * 1024 * INW;
    constexpr int I_IN = 16 * 168, I_PA = 4 * 32, I_PC = 8 * 32, I_OUT = 16 * 32;
    for (int it = gw; it < I_IN + 2 * I_PA + I_PC + I_OUT; it += NGW) {
        int r = it;
        if (r < I_IN) { const int rb = 16 + r % 168, kb = r / 168, n = rb * 32; int c0, perm = 0;
            if (n < 1536 || n >= 2304) c0 = n - 256;
            else if (n < 2048) { const int t = n - 1536, tile = t >> 8, tt = t & 255, bj = tt >> 7, wc = (tt >> 5) & 3; c0 = 1280 + (tile * 4 + wc) * 64 + 32 * bj; perm = 1; }
            else { const int tt = n - 2048, bj = tt >> 7, wc = (tt >> 5) & 3; if (wc < 2) { c0 = 1792 + wc * 64 + 32 * bj; perm = 1; } else c0 = 1920 + (wc - 2) * 64 + 32 * bj; }
            transpose_blk(win + c0, INW, 1024, WinT + (size_t)n * 1024, kb, perm, scr, lane); continue; } r -= I_IN;
        if (r < I_PA) { transpose_blk(p.in[12] + (size_t)l * 256 * 1024 + 32 * (r & 31), 1024, 256, (bf16_t*)(wsW + W_PA_OFF) + (size_t)32 * (r & 31) * 256, r >> 5, 0, scr, lane); continue; } r -= I_PA;
        if (r < I_PA) { transpose_blk(p.in[13] + (size_t)l * 256 * 1024 + 32 * (r & 31), 1024, 256, (bf16_t*)(wsW + W_PB_OFF) + (size_t)32 * (r & 31) * 256, r >> 5, 0, scr, lane); continue; } r -= I_PA;
        if (r < I_PC) { transpose_blk(p.in[14] + (size_t)l * 512 * 1024 + 32 * (r & 31), 1024, 512, (bf16_t*)(wsW + W_PC_OFF) + (size_t)32 * (r & 31) * 512, r >> 5, 0, scr, lane); continue; } r -= I_PC;
        transpose_blk(p.in[15] + (size_t)l * 1024 * 1024 + 32 * (r & 31), 1024, 1024, (bf16_t*)(wsW + W_OUT_OFF) + (size_t)32 * (r & 31) * 1024, r >> 5, 0, scr, lane);
    }
    const int gtid = (G - 1 - bid) * 512 + tid, NT = G * 512;
    for (int id = gtid; id < 65536; id += NT) {
        const int n = id >> 7, ko = id & 127, part = n >> 8, grp = (n >> 6) & 3, m = n & 63;
        const LAS float* tb = ctab + part * 64;
        const float* wrow = win + (size_t)(ko * 8) * INW + grp * 64;
        float a[8];
#pragma unroll
        for (int j = 0; j < 8; ++j) a[j] = 0.f;
#pragma unroll 4
        for (int c4 = 0; c4 < 16; ++c4) {
            const float t0 = tb[(m * (4 * c4)) & 63], t1 = tb[(m * (4 * c4 + 1)) & 63], t2 = tb[(m * (4 * c4 + 2)) & 63], t3 = tb[(m * (4 * c4 + 3)) & 63];
#pragma unroll
            for (int j = 0; j < 8; ++j) { const f32x4 wv = *(const f32x4*)(wrow + (size_t)j * INW + c4 * 4); a[j] += wv[0] * t0 + wv[1] * t1 + wv[2] * t2 + wv[3] * t3; }
        }
        const float sg = part ? -1.f : 1.f;
        u32x4 o; o.x = cvtpk(sg * a[0], sg * a[1]); o.y = cvtpk(sg * a[2], sg * a[3]); o.z = cvtpk(sg * a[4], sg * a[5]); o.w = cvtpk(sg * a[6], sg * a[7]);
        *(u32x4*)(WinT + (size_t)n * 1024 + ko * 8) = o;
    }
    { const float* sw = p.in[7] + (size_t)l * 65536; bf16_t* dw = (bf16_t*)(p.ws + WS_SGUW);
      for (int id = gtid; id < 8192; id += NT) { const f32x4 v0 = *(const f32x4*)(sw + id * 8), v1 = *(const f32x4*)(sw + id * 8 + 4);
          u32x4 o; o.x = cvtpk(v0[0], v0[1]); o.y = cvtpk(v0[2], v0[3]); o.z = cvtpk(v1[0], v1[1]); o.w = cvtpk(v1[2], v1[3]); *(u32x4*)(dw + id * 8) = o; } }
}
__device__ __forceinline__ void h_rows(const Params& p, int l, int lane, int wave, int bid, int G) {
    const int gw = bid * 8 + wave, NGW = G * 8;
    const float* xs = l == 0 ? p.in[0] : p.out;
    const float* cs = l == 0 ? p.in[2] : (const float*)(p.ws + WS_XC);
    const float* mod = (const float*)(p.ws + WS_MOD) + (size_t)l * 5 * 3072;
    bf16_t* H = (bf16_t*)(p.ws + WS_H);
    for (int row = gw; row < MT; row += NGW) {
        const float* src = row < ML ? xs + (size_t)row * DM : cs + (size_t)(row - ML) * DM;
        const int bi = row < ML ? (row >> 13) : 4;
        const float* md = mod + bi * 3072;
        f32x4 v[4]; float ss = 0.f;
#pragma unroll
        for (int j = 0; j < 4; ++j) { v[j] = *(const f32x4*)(src + 4 * lane + 256 * j); ss += (v[j][0] * v[j][0] + v[j][1] * v[j][1]) + (v[j][2] * v[j][2] + v[j][3] * v[j][3]); }
#pragma unroll
        for (int o = 1; o < 64; o <<= 1) ss += __shfl_xor(ss, o);
        const float rinv = rsqrtf(ss * (1.f / 1024.f) + EPSV);
#pragma unroll
        for (int j = 0; j < 4; ++j) { const int idx = 4 * lane + 256 * j; const f32x4 sh = *(const f32x4*)(md + idx), scl = *(const f32x4*)(md + 1024 + idx);
            const f32x4 o = v[j] * rinv * (scl + 1.f) + sh; u32x2 w; w.x = cvtpk(o[0], o[1]); w.y = cvtpk(o[2], o[3]); *(u32x2*)(H + (size_t)row * DM + idx) = w; }
    }
}

__device__ __forceinline__ void attn_item(LAS unsigned char* lds, const bf16_t* QKV, bf16_t* Z, const float* sinkl, const float m0,
                                          int b, int blk, int kvh, int hp, bool isctx, int tid, int lane, int wave, bool dry = false) {
    constexpr int RS = 144;
    LAS unsigned char* Qs = lds; LAS unsigned char* Ks = lds + 256 * RS; LAS unsigned char* Vs = Ks + 128 * RS;
    const int qrow0 = isctx ? (ML + b * 256 + blk * 128) : (b * SEQ + blk * 128);
    __syncthreads();
#pragma unroll
    for (int it = 0; it < 4; ++it) { const int id = it * 512 + tid, r = id >> 3, c16 = id & 7, hl = r >> 7, tq = r & 127;
        *(LAS u32x4*)(Qs + r * RS + c16 * 16) = *(const u32x4*)(QKV + (size_t)(qrow0 + tq) * 768 + (kvh * 4 + hp * 2 + hl) * 64 + c16 * 8); }
    const int hl = wave >> 2, qq = wave & 3, gq = hp * 2 + hl, g = lane >> 4, c = lane & 15;
    const LAS unsigned char* qbase = Qs + (hl * 128 + qq * 32 + c) * RS + 16 * g;
    f32x4 O[4][2]; float l_run[2];
    const float sinkv = sinkl[kvh * 4 + gq] * LOG2E;
    const float mshift = fmaxf(m0, sinkv), nm = -mshift;
    const f32x4 negm = {nm, nm, nm, nm};
#pragma unroll
    for (int qi = 0; qi < 2; ++qi) { l_run[qi] = (g == 0) ? __builtin_amdgcn_exp2f(sinkv - mshift) : 0.f;
#pragma unroll
        for (int df = 0; df < 4; ++df) O[df][qi] = (f32x4){0.f, 0.f, 0.f, 0.f}; }
    const LAS unsigned char* vbase = Vs + (4 * g + (c >> 2)) * RS + (4 * (c & 3)) * 2;
    const int kvoff = 512 + kvh * 64 + (tid & 7) * 8, kr0 = tid >> 3;
    int ti = isctx ? 3 : (blk == 0 ? 1 : 0);
    u32x4 kreg[2], vreg[2];
#define ATT_KROW(t) ((t) >= 3 ? ML + b * 256 + ((t) - 3) * 128 : qrow0 + ((t) - 1) * 128)
#define ATT_PRELOAD(t) do { const bf16_t* src_ = QKV + (size_t)(ATT_KROW(t) + kr0) * 768 + kvoff; \
        kreg[0] = *(const u32x4*)src_; vreg[0] = *(const u32x4*)(src_ + 128); kreg[1] = *(const u32x4*)(src_ + (size_t)64 * 768); vreg[1] = *(const u32x4*)(src_ + (size_t)64 * 768 + 128); } while (0)
    ATT_PRELOAD(ti);
#pragma unroll 1
    while (ti < 5) {
        int tn = ti + 1; if (tn == 2 && blk == 63) tn = 3;
        __syncthreads();
#pragma unroll
        for (int it = 0; it < 2; ++it) { *(LAS u32x4*)(Ks + (kr0 + 64 * it) * RS + (tid & 7) * 16) = kreg[it]; *(LAS u32x4*)(Vs + (kr0 + 64 * it) * RS + (tid & 7) * 16) = vreg[it]; }
        if (tn < 5) ATT_PRELOAD(tn);
        __syncthreads();
#pragma unroll
        for (int qi = 0; qi < 2; ++qi) {
            asm volatile("" ::: "memory"); __builtin_amdgcn_sched_barrier(0);
            f32x4 s[8];
            const bf16x8 qf0 = *(const LAS bf16x8*)(qbase + (16 * qi) * RS), qf1 = *(const LAS bf16x8*)(qbase + (16 * qi) * RS + 64);
#pragma unroll
            for (int kf = 0; kf < 8; ++kf) { const LAS unsigned char* kp = Ks + (16 * kf + c) * RS + 16 * g;
                const bf16x8 k0 = *(const LAS bf16x8*)kp, k1 = *(const LAS bf16x8*)(kp + 64);
                s[kf] = __builtin_amdgcn_mfma_f32_16x16x32_bf16(k0, qf0, negm, 0, 0, 0);
                s[kf] = __builtin_amdgcn_mfma_f32_16x16x32_bf16(k1, qf1, s[kf], 0, 0, 0); }
            if (ti == 0 || ti == 2) { int qidx = qq * 32 + 16 * qi + c; asm volatile("" : "+v"(qidx));
#pragma unroll
                for (int kf = 0; kf < 8; ++kf)
#pragma unroll
                    for (int r = 0; r < 4; ++r) { const int key = 16 * kf + 4 * g + r; const bool valid = (ti == 0) ? (key >= qidx) : (key <= qidx); if (!valid) s[kf][r] = -1e30f; } }
            float psum = 0.f;
#pragma unroll
            for (int kf = 0; kf < 8; ++kf)
#pragma unroll
                for (int r = 0; r < 4; ++r) { const float pv = __builtin_amdgcn_exp2f(s[kf][r]); s[kf][r] = pv; psum += pv; }
            l_run[qi] += psum;
#pragma unroll
            for (int ks = 0; ks < 4; ++ks) {
                u32x4 pw; pw.x = cvtpk(s[2 * ks][0], s[2 * ks][1]); pw.y = cvtpk(s[2 * ks][2], s[2 * ks][3]); pw.z = cvtpk(s[2 * ks + 1][0], s[2 * ks + 1][1]); pw.w = cvtpk(s[2 * ks + 1][2], s[2 * ks + 1][3]);
                const bf16x8 pf = __builtin_bit_cast(bf16x8, pw);
#pragma unroll
                for (int df = 0; df < 4; ++df) { const LAS unsigned char* vp = vbase + (ks * 32) * RS + df * 32;
                    const bf16x8 vf = cat8(lds_tr(vp), lds_tr(vp + 16 * RS));
                    O[df][qi] = __builtin_amdgcn_mfma_f32_16x16x32_bf16(vf, pf, O[df][qi], 0, 0, 0); }
            }
        }
        ti = tn;
    }
#undef ATT_KROW
#undef ATT_PRELOAD
#pragma unroll
    for (int qi = 0; qi < 2; ++qi) { float lt = l_run[qi]; lt += __shfl_xor(lt, 16); lt += __shfl_xor(lt, 32); const float inv = 1.f / lt;
        const size_t row = (size_t)(qrow0 + qq * 32 + 16 * qi + c);
#pragma unroll
        for (int df = 0; df < 4; ++df) mul_store4(Z + row * 1024 + 512 + (kvh * 4 + gq) * 64 + 16 * df + 4 * g, O[df][qi] * inv, dry); }
}

__device__ __forceinline__ void f1_item(LAS unsigned char* lds, const bf16_t* Gb, bf16_t* Afft, const bf16_t* t128, int b, int l2, int tid, int lane, int wave) {
    constexpr int RS = 528;
    const int g = lane >> 4, c = lane & 15;
    __syncthreads();
#pragma unroll
    for (int it = 0; it < 16; ++it) { const int id = it * 512 + tid, row = id >> 5, c16 = id & 31, pp = row >> 7, l1 = row & 127;
        *(LAS u32x4*)(lds + row * RS + c16 * 16) = *(const u32x4*)(Gb + (size_t)(b * SEQ + 64 * l1 + l2) * 512 + pp * 256 + c16 * 8); }
    bf16x8 tb[8][2];
    { const bf16_t* tp = t128 + (size_t)(32 * wave + c) * 256 + 8 * g;
#pragma unroll
      for (int ks = 0; ks < 8; ++ks)
#pragma unroll
          for (int j = 0; j < 2; ++j) tb[ks][j] = *(const bf16x8*)(tp + (size_t)j * 16 * 256 + ks * 32); }
    __syncthreads();
    const LAS unsigned char* abase = lds + (8 * g + (c >> 2)) * RS + (4 * (c & 3)) * 2;
    const int part = wave >> 2;
#pragma unroll 1
    for (int cq = 0; cq < 4; ++cq) {
        f32x4 acc[4][2]; zero_acc<4, 2>(acc);
#pragma unroll
        for (int ks = 0; ks < 8; ++ks) {
            bf16x8 a[4];
#pragma unroll
            for (int i = 0; i < 4; ++i) { const LAS unsigned char* ap = abase + ks * 32 * RS + (cq * 64 + 16 * i) * 2; a[i] = cat8(lds_tr(ap), lds_tr(ap + 4 * RS)); }
#pragma unroll
            for (int i = 0; i < 4; ++i)
#pragma unroll
                for (int j = 0; j < 2; ++j) acc[i][j] = __builtin_amdgcn_mfma_f32_16x16x32_bf16(a[i], tb[ks][j], acc[i][j], 0, 0, 0);
        }
#pragma unroll
        for (int j = 0; j < 2; ++j) { const int k1 = (wave & 3) * 32 + 16 * j + c; const size_t arow = ((size_t)(b * 128 + k1) * 64 + l2) * 2 + part;
#pragma unroll
            for (int i = 0; i < 4; ++i) { u32x2 o; o.x = cvtpk(acc[i][j][0], acc[i][j][1]); o.y = cvtpk(acc[i][j][2], acc[i][j][3]); *(u32x2*)(Afft + arow * 256 + cq * 64 + 16 * i + 4 * g) = o; } }
    }
}
__device__ __forceinline__ void sgu_item(LAS unsigned char* lds, const bf16_t* Ub, bf16_t* Z, const bf16_t* sguw, const float* sgub, int ci, int tid, int lane, int wave, bool dry = false) {
    constexpr int RS = 528;
    const int row0 = ci * 128;
    __syncthreads();
    { const int t = tid >> 2, qd = tid & 3; const bf16_t* vp = Ub + (size_t)(row0 + t) * 512 + 256 + qd * 64;
      u32x4 w[8]; float ss = 0.f;
#pragma unroll
      for (int i = 0; i < 8; ++i) { w[i] = *(const u32x4*)(vp + 8 * i);
          const float a0 = bflo(w[i].x), a1 = bfhi(w[i].x), a2 = bflo(w[i].y), a3 = bfhi(w[i].y), a4 = bflo(w[i].z), a5 = bfhi(w[i].z), a6 = bflo(w[i].w), a7 = bfhi(w[i].w);
          ss += (a0 * a0 + a1 * a1) + (a2 * a2 + a3 * a3) + (a4 * a4 + a5 * a5) + (a6 * a6 + a7 * a7); }
      ss += __shfl_xor(ss, 1); ss += __shfl_xor(ss, 2);
      const float rinv = rsqrtf(ss * (1.f / 256.f) + EPSV);
#pragma unroll
      for (int i = 0; i < 8; ++i) { u32x4 o; o.x = cvtpk(bflo(w[i].x) * rinv, bfhi(w[i].x) * rinv); o.y = cvtpk(bflo(w[i].y) * rinv, bfhi(w[i].y) * rinv); o.z = cvtpk(bflo(w[i].z) * rinv, bfhi(w[i].z) * rinv); o.w = cvtpk(bflo(w[i].w) * rinv, bfhi(w[i].w) * rinv);
          *(LAS u32x4*)(lds + t * RS + qd * 128 + i * 16) = o; } }
    __syncthreads();
    const int grp = wave >> 1, sh = wave & 1, g = lane >> 4, c = lane & 15;
    f32x4 acc[4][4]; zero_acc<4, 4>(acc);
    act_gemm<4, 4, 4, 4>(acc, lds, RS, grp * 64, sguw + (size_t)grp * 16384 + (size_t)(sh * 64) * 128, 128, lane);
#pragma unroll
    for (int j = 0; j < 4; ++j) { const int s = sh * 64 + 16 * j + c; const float bias = sgub[grp * 128 + s]; const size_t row = (size_t)(row0 + s);
#pragma unroll
        for (int i = 0; i < 4; ++i) { const int col = grp * 64 + 16 * i + 4 * g; const u32x2 uw = *(const u32x2*)(Ub + row * 512 + col);
            f32x4 v = acc[i][j]; v[0] = (v[0] + bias) * bflo(uw.x); v[1] = (v[1] + bias) * bfhi(uw.x); v[2] = (v[2] + bias) * bflo(uw.y); v[3] = (v[3] + bias) * bfhi(uw.y);
            mul_store4(Z + row * 1024 + 256 + col, v, dry); } }
}
__device__ __forceinline__ void f3_wave_item(LAS unsigned char* ldsw, const bf16_t* Afft, bf16_t* Z, const bf16_t* t3, int wi, int lane, bool dry) {
    constexpr int RS = 80;
    const int b = wi >> 10, k1 = (wi >> 3) & 127, ch0 = (wi & 7) * 32;
    const bf16_t* src = Afft + (size_t)(b * 128 + k1) * 128 * 256 + ch0;
    u32x4 v[8];
#pragma unroll
    for (int it = 0; it < 8; ++it) { const int id = it * 64 + lane; v[it] = *(const u32x4*)(src + (size_t)(id >> 2) * 256 + (id & 3) * 8); }
#pragma unroll
    for (int it = 0; it < 8; ++it) { const int id = it * 64 + lane; *(LAS u32x4*)(ldsw + (id >> 2) * RS + (id & 3) * 16) = v[it]; }
    asm volatile("s_waitcnt lgkmcnt(0)" ::: "memory");
    const int g = lane >> 4, c = lane & 15;
    f32x4 acc[2][4]; zero_acc<2, 4>(acc);
    act_gemm<2, 4, 4, 4>(acc, ldsw, RS, 0, t3 + (size_t)k1 * 64 * 128, 128, lane);
#pragma unroll
    for (int j = 0; j < 4; ++j) { const int k2 = 16 * j + c; const size_t row = (size_t)b * SEQ + k1 + 128 * k2;
#pragma unroll
        for (int i = 0; i < 2; ++i) mul_store4(Z + row * 1024 + ch0 + 16 * i + 4 * g, acc[i][j], dry); }
    asm volatile("" ::: "memory");
}
__device__ __forceinline__ void fc_item(LAS unsigned char* lds, const bf16_t* Gb, bf16_t* Z, const bf16_t* tc, int b, int hh, int tid, int lane, int wave, bool dry = false) {
    constexpr int RS = 272;
    __syncthreads();
#pragma unroll 4
    for (int it = 0; it < 16; ++it) { const int id = it * 512 + tid, row = id >> 4, c16 = id & 15, part = row >> 8, ll = row & 255;
        *(LAS u32x4*)(lds + row * RS + c16 * 16) = *(const u32x4*)(Gb + (size_t)(ML + b * 256 + ll) * 512 + part * 256 + hh * 128 + c16 * 8); }
    __syncthreads();
    const int g = lane >> 4, c = lane & 15;
#pragma unroll 1
    for (int jh = 0; jh < 2; ++jh) {
        f32x4 acc[1][8]; zero_acc<1, 8>(acc);
        act_gemm<1, 8, 16, 1>(acc, lds, RS, 16 * wave, tc + (size_t)(jh * 128) * 512, 512, lane);
#pragma unroll
        for (int j = 0; j < 8; ++j) { const size_t row = (size_t)(ML + b * 256 + jh * 128 + 16 * j + c); mul_store4(Z + row * 1024 + hh * 128 + 16 * wave + 4 * g, acc[0][j], dry); }
    }
}

__device__ __forceinline__ void ctx_merge_tile(const bf16_t* Y, const bf16_t* GT, bf16_t* MG, const unsigned char* wsW, int tile, int lane, int wave) {
    const int m = ML + 64 * (tile >> 4) + 16 * (wave >> 1) + (lane & 15), nb = 64 * (tile & 15) + 32 * (wave & 1), g = lane >> 4, c = lane & 15;
    f32x4 mg[2] = {(f32x4){0.f, 0.f, 0.f, 0.f}, (f32x4){0.f, 0.f, 0.f, 0.f}};
#pragma unroll
    for (int seg = 0; seg < 3; ++seg) {
        const int Kseg = seg == 2 ? 512 : 256;
        const bf16_t* Wt = (const bf16_t*)(wsW + (seg == 0 ? W_PA_OFF : (seg == 1 ? W_PB_OFF : W_PC_OFF)));
        const bf16_t* yp = Y + (size_t)m * 1024 + seg * 256 + 8 * g;
        const bf16_t* wp = Wt + (size_t)(nb + c) * Kseg + 8 * g;
        f32x4 acc[2] = {(f32x4){0.f, 0.f, 0.f, 0.f}, (f32x4){0.f, 0.f, 0.f, 0.f}};
#pragma unroll 8
        for (int ks = 0; ks < Kseg / 32; ++ks) {
            const bf16x8 yf = *(const bf16x8*)(yp + ks * 32);
#pragma unroll
            for (int j = 0; j < 2; ++j) { const bf16x8 wf = *(const bf16x8*)(wp + (size_t)j * 16 * Kseg + ks * 32); acc[j] = __builtin_amdgcn_mfma_f32_16x16x32_bf16(wf, yf, acc[j], 0, 0, 0); }
        }
#pragma unroll
        for (int j = 0; j < 2; ++j) { const u32x2 gw = *(const u32x2*)(GT + (size_t)m * 3072 + seg * 1024 + nb + 16 * j + 4 * g);
            mg[j][0] += acc[j][0] * bflo(gw.x); mg[j][1] += acc[j][1] * bfhi(gw.x); mg[j][2] += acc[j][2] * bflo(gw.y); mg[j][3] += acc[j][3] * bfhi(gw.y); }
    }
#pragma unroll
    for (int j = 0; j < 2; ++j) { u32x2 o; o.x = cvtpk(mg[j][0], mg[j][1]); o.y = cvtpk(mg[j][2], mg[j][3]); *(u32x2*)(MG + (size_t)m * 1024 + nb + 16 * j + 4 * g) = o; }
}
__device__ __forceinline__ void ctx_out_tile(const bf16_t* MG, const bf16_t* WoT, const float* csrc, float* cdst, const float* gate_c, int tile, int lane, int wave) {
    const int mr = 64 * (tile >> 4) + 16 * (wave >> 1) + (lane & 15), nb = 64 * (tile & 15) + 32 * (wave & 1), g = lane >> 4, c = lane & 15;
    const bf16_t* ap = MG + (size_t)(ML + mr) * 1024 + 8 * g;
    const bf16_t* wp = WoT + (size_t)(nb + c) * 1024 + 8 * g;
    f32x4 acc[2] = {(f32x4){0.f, 0.f, 0.f, 0.f}, (f32x4){0.f, 0.f, 0.f, 0.f}};
#pragma unroll 8
    for (int ks = 0; ks < 32; ++ks) {
        const bf16x8 yf = *(const bf16x8*)(ap + ks * 32);
#pragma unroll
        for (int j = 0; j < 2; ++j) { const bf16x8 wf = *(const bf16x8*)(wp + (size_t)j * 16 * 1024 + ks * 32); acc[j] = __builtin_amdgcn_mfma_f32_16x16x32_bf16(wf, yf, acc[j], 0, 0, 0); }
    }
#pragma unroll
    for (int j = 0; j < 2; ++j) { const int n = nb + 16 * j + 4 * g; const f32x4 gt = *(const f32x4*)(gate_c + n); const f32x4 xs = *(const f32x4*)(csrc + (size_t)mr * DM + n);
        *(f32x4*)(cdst + (size_t)mr * DM + n) = xs + gt * acc[j]; }
}

#define XB_TMO      128
#define XB_XCNT(j)  (256  + 64 * (j))
#define XB_XSUB(j)  (1280 + 64 * (j))
#define XB_XGEN(j)  (2304 + 64 * (j))
#define XB_TOP      3328
#define XB_TOPGEN   3392
#define XCD_BAR_WORDS 3456
#define XB_SPIN_CAP (1u << 18)
__device__ __forceinline__ unsigned xb_ld(unsigned* p)              { return __hip_atomic_load(p, __ATOMIC_RELAXED, __HIP_MEMORY_SCOPE_AGENT); }
__device__ __forceinline__ unsigned xb_add(unsigned* p, unsigned v) { return __hip_atomic_fetch_add(p, v, __ATOMIC_RELAXED, __HIP_MEMORY_SCOPE_AGENT); }
__device__ __forceinline__ unsigned xb_xcc_id() { return (unsigned)__builtin_amdgcn_s_getreg((3 << 11) | 20) & 0xFu; }
#define XB_SPIN(cond, bar) do { unsigned _sp = 0; while (cond) { __builtin_amdgcn_s_sleep(1); \
    if ((++_sp & 255u) == 0u) { if (xb_ld(&(bar)[XB_TMO])) break; if (_sp > XB_SPIN_CAP) { atomicAdd(&(bar)[XB_TMO], 1u); break; } } } } while (0)
struct XcdBarrier { unsigned* bar; unsigned x; volatile LAS unsigned* st; };
__device__ __forceinline__ XcdBarrier xcd_barrier_post(unsigned* bar, volatile LAS unsigned* st) {
    XcdBarrier b; b.bar = bar; b.x = xb_xcc_id(); b.st = st;
    if (threadIdx.x == 0) (void)xb_add(&bar[XB_XCNT(b.x)], 1u);
    return b;
}
__device__ __forceinline__ void xcd_barrier_complete(unsigned* bar, unsigned x, unsigned& nloc, unsigned& nx) {
    const unsigned G = gridDim.x * gridDim.y * gridDim.z;
    unsigned sum, cnt, mine, sp = 0u;
    for (;;) {
        sum = 0u; cnt = 0u; mine = 0u;
#pragma unroll
        for (unsigned j = 0; j < 16; ++j) { const unsigned c = xb_ld(&bar[XB_XCNT(j)]); sum += c; cnt += (c > 0u) ? 1u : 0u; mine = (j == x) ? c : mine; }
        if (sum == G) break;
        __builtin_amdgcn_s_sleep(1);
        if ((++sp & 255u) == 0u) { if (xb_ld(&bar[XB_TMO])) break; if (sp > XB_SPIN_CAP) { atomicAdd(&bar[XB_TMO], 1u); break; } }
    }
    nloc = mine > 0u ? mine : 1u; nx = cnt > 0u ? cnt : 1u;
}
__device__ __forceinline__ void xcd_barrier(const XcdBarrier& b) {
    asm volatile("s_waitcnt vmcnt(0)" ::: "memory");
    __syncthreads();
    if (threadIdx.x == 0) {
        unsigned bz_ = 0u, bx = b.x;
        asm volatile("" : "+s"(bz_), "+s"(bx)); unsigned* bar = b.bar + bz_;
        __builtin_amdgcn_s_waitcnt(0);
        unsigned nloc = b.st[0], nx = b.st[1];
        if (nloc == 0u) { xcd_barrier_complete(bar, bx, nloc, nx); b.st[0] = nloc; b.st[1] = nx; }
        const unsigned old = xb_add(&bar[XB_XSUB(bx)], 1u);
        const unsigned gen = old / nloc;
        if (old + 1u == (gen + 1u) * nloc) {
            __builtin_amdgcn_fence(__ATOMIC_RELEASE, "agent");
            asm volatile("s_waitcnt vmcnt(0)" ::: "memory");
            const unsigned og = xb_add(&bar[XB_TOP], 1u);
            const unsigned tg = og / nx;
            if (og + 1u == (tg + 1u) * nx) xb_add(&bar[XB_TOPGEN], 1u);
            else XB_SPIN(xb_ld(&bar[XB_TOPGEN]) == tg, bar);
            __builtin_amdgcn_fence(__ATOMIC_ACQUIRE, "agent");
            xb_add(&bar[XB_XGEN(bx)], 1u);
            asm volatile("s_waitcnt vmcnt(0)" ::: "memory");
        } else {
            XB_SPIN(xb_ld(&bar[XB_XGEN(bx)]) == gen, bar);
            __builtin_amdgcn_fence(__ATOMIC_ACQUIRE, "agent");
            asm volatile("s_waitcnt vmcnt(0)" ::: "memory");
        }
    }
    __syncthreads();
}

#define PHASE_IDS() int t__ = threadIdx.x, b__ = blockIdx.x, g__ = gridDim.x; asm volatile("" : "+v"(t__)); asm volatile("" : "+s"(b__), "+s"(g__)); \
    size_t wz_ = 0; asm volatile("" : "+s"(wz_)); unsigned char* ws = p.ws + wz_;     \
    const int tid = t__, lane = tid & 63, wave = __builtin_amdgcn_readfirstlane(tid >> 6), bid = b__, G = g__; (void)lane; (void)wave; (void)bid; (void)G
__global__ void __launch_bounds__(512, 2) fwd_megakernel(Params p) {
    extern __shared__ __attribute__((aligned(16))) unsigned char lds_raw[];
    LAS unsigned char* lds = (LAS unsigned char*)lds_raw;
    cg::grid_group grid = cg::this_grid();
    volatile LAS unsigned* bst = (volatile LAS unsigned*)(lds + LDS_BYTES - 16);
    if (threadIdx.x < 4) bst[threadIdx.x] = 0u;
    __syncthreads();
    const XcdBarrier xbar = xcd_barrier_post((unsigned*)(p.ws + WS_BAR), bst);
#define GSYNC() do { xcd_barrier(xbar); if (PROBE_DUP == 7) xcd_barrier(xbar); } while (0)
#ifndef SKIP_P0
    { PHASE_IDS(); phase0(p, lds, tid, bid, G); }
#endif
    grid.sync();
#pragma unroll 1
    for (int l = 0; l < DEPTH; ++l) {
        const bool last = (l == DEPTH - 1);
#ifndef SKIP_P1
        for (int rep = (PROBE_DUP == 1 ? 0 : 1); rep < 2; ++rep) { PHASE_IDS(); if (l == 0) { conv_weights(p, lds, 0, tid, lane, wave, bid, G); } h_rows(p, l, lane, wave, bid, G); }
#endif
        GSYNC();
#ifndef SKIP_P2
#pragma unroll 1
        for (int rep = (PROBE_DUP == 2 ? 0 : 1); rep < 2; ++rep) { PHASE_IDS();
          pg8::Gemm g{(const bf16_t*)(ws + WS_H), (const bf16_t*)(ws + ((l & 1) ? WS_W1 : WS_W) + W_IN_OFF), MT, NIN, 1024, 1024}; pg8::StaticOrder S; S.init(MT, NIN, G, bid);
          pg8::EpiProj E{(bf16_t*)(ws + WS_G), (bf16_t*)(ws + WS_Z), (bf16_t*)(ws + WS_U), (bf16_t*)(ws + WS_QKV), (bf16_t*)(ws + WS_GT), (const float*)(ws + WS_ROPE), p.in[9] + l * 64, p.in[10] + l * 64};
          pg8::gemm_phase<pg8::EpiProj>(lds, g, S, E, tid); }
#endif
        GSYNC();
#ifndef SKIP_P3
#pragma unroll 1
        for (int rep = ((PROBE_DUP == 3 || PROBE_DUP == 8) ? 0 : 1); rep < 2; ++rep) { PHASE_IDS(); const bool dry = rep == 0;
          bf16_t* Zb = (bf16_t*)(ws + WS_Z); const bf16_t* QKVb = (const bf16_t*)(ws + WS_QKV);
          const int n_attn = last ? 1024 : 1056, n_f1 = 256, n_sgu = last ? 256 : 264, total = n_attn + n_f1 + n_sgu;
          const float* sinkl = p.in[11] + l * 8; const float* sgub = p.in[8] + l * 512; const float m0 = ((const float*)(ws + WS_ROPE + 131072))[l];
          for (int item = bid + (PROBE_DUP == 8 && rep == 0 ? n_attn : 0); item < total; item += G) {
              int tid = t__; asm volatile("" : "+v"(tid)); const int lane = tid & 63;
#ifndef NO_ATTN
              if (item < n_attn) { const bool ic = item >= 1024; const int i2 = item - 1024;
                                   attn_item(lds, QKVb, Zb, sinkl, m0, ic ? (i2 >> 3) : (item >> 8), ic ? ((i2 >> 2) & 1) : ((item >> 2) & 63), (item >> 1) & 1, item & 1, ic, tid, lane, wave, dry); }
              else
#endif
#ifndef NO_F1
              if (item < n_attn + n_f1) { const int i2 = item - n_attn; f1_item(lds, (const bf16_t*)(ws + WS_G), (bf16_t*)(ws + WS_H), (const bf16_t*)(ws + WS_T128), i2 >> 6, i2 & 63, tid, lane, wave); }
              else
#endif
#ifndef NO_SGU
              { sgu_item(lds, (const bf16_t*)(ws + WS_U), Zb, (const bf16_t*)(ws + WS_SGUW), sgub, item - n_attn - n_f1, tid, lane, wave, dry); }
#else
              {}
#endif
          } }
#endif
        GSYNC();
#ifndef SKIP_P4
#pragma unroll 1
        for (int rep = (PROBE_DUP == 4 ? 0 : 1); rep < 2; ++rep) { PHASE_IDS(); const bool dry = rep == 0;
          bf16_t* Zb = (bf16_t*)(ws + WS_Z);
          for (int wi = bid * 8 + wave; wi < 4096; wi += G * 8) f3_wave_item(lds + wave * 10240, (const bf16_t*)(ws + WS_H), Zb, (const bf16_t*)(ws + WS_T3), wi, lane, dry);
          if (!last) { for (int item = bid; item < 8; item += G) fc_item(lds, (const bf16_t*)(ws + WS_G), Zb, (const bf16_t*)(ws + WS_TC), item >> 1, item & 1, tid, lane, wave, dry); }
          if (!last && rep == 1) { __syncthreads(); conv_weights(p, lds, l + 1, tid, lane, wave, bid, G); } }
#endif
        GSYNC();
#ifndef SKIP_P5
        if (!last) { PHASE_IDS();
          for (int t = bid; t < 256; t += G) ctx_merge_tile((const bf16_t*)(ws + WS_Z), (const bf16_t*)(ws + WS_GT), (bf16_t*)(ws + WS_H), ws + ((l & 1) ? WS_W1 : WS_W), t, lane, wave); }
#pragma unroll 1
        for (int seg = (PROBE_DUP == 5 ? -3 : 0); seg < 3; ++seg) { PHASE_IDS(); const int sg_ = seg < 0 ? seg + 3 : seg;
          const int Mrows = ML; pg8::StaticOrder S; S.init(Mrows, 1024, G, bid);
          const bf16_t* Zb = (const bf16_t*)(ws + WS_Z);
          const size_t woff = sg_ == 0 ? W_PA_OFF : (sg_ == 1 ? W_PB_OFF : W_PC_OFF);
          pg8::Gemm g{Zb + sg_ * 256, (const bf16_t*)(ws + ((l & 1) ? WS_W1 : WS_W) + woff), Mrows, 1024, sg_ == 2 ? 512 : 256, 1024};
          pg8::EpiMerge E{(const bf16_t*)(ws + WS_GT), (bf16_t*)(ws + WS_H), sg_};
          pg8::gemm_phase<pg8::EpiMerge>(lds, g, S, E, tid); }
#endif
        GSYNC();
#ifndef SKIP_P6
#pragma unroll 1
        for (int rep = (PROBE_DUP == 6 ? 0 : 1); rep < 2; ++rep) { PHASE_IDS();
          const int Mrows = ML; pg8::StaticOrder S; S.init(Mrows, 1024, G, bid);
          pg8::Gemm g{(const bf16_t*)(ws + WS_H), (const bf16_t*)(ws + ((l & 1) ? WS_W1 : WS_W) + W_OUT_OFF), Mrows, 1024, 1024, 1024};
          float* XC = (float*)(ws + WS_XC);
          if (!last && rep == 1) { for (int t = bid; t < 256; t += G) ctx_out_tile((const bf16_t*)(ws + WS_H), (const bf16_t*)(ws + ((l & 1) ? WS_W1 : WS_W) + W_OUT_OFF), l == 0 ? p.in[2] : XC, XC, (const float*)(ws + WS_MOD) + (size_t)(l * 5 + 4) * 3072 + 2048, t, lane, wave); }
          pg8::EpiRes E{l == 0 ? p.in[0] : p.out, p.out, l == 0 ? p.in[2] : XC, XC, rep == 0 ? (const float*)(ws + WS_ROPE + 65536) : (const float*)(ws + WS_MOD) + (size_t)l * 5 * 3072};
          pg8::gemm_phase<pg8::EpiRes>(lds, g, S, E, tid); }
#endif
        if (!last) GSYNC();
    }
}

extern "C" void kernel_launch(void* const* d_in, const int* in_sizes, int n_in, void* d_out, int out_size, void* d_ws, size_t ws_size, hipStream_t stream) {
    static int grid = 0;
    if (grid == 0) {
        if (n_in != 16 || ws_size < WS_END) { fprintf(stderr, "kernel_launch: unexpected inputs (n_in %d, ws %zu)\n", n_in, ws_size); grid = -1; return; }
        int dev = 0, cus = 0, per_cu = 0;
        hipGetDevice(&dev);
        hipDeviceGetAttribute(&cus, hipDeviceAttributeMultiprocessorCount, dev);
        hipFuncSetAttribute((const void*)fwd_megakernel, hipFuncAttributeMaxDynamicSharedMemorySize, LDS_BYTES);
        hipOccupancyMaxActiveBlocksPerMultiprocessor(&per_cu, (const void*)fwd_megakernel, 512, LDS_BYTES);
        if (per_cu < 1 || cus < 1) { fprintf(stderr, "kernel_launch: occupancy query gave %d blocks/CU on %d CUs\n", per_cu, cus); grid = -1; return; }
        grid = cus;
    }
    if (grid < 0) return;
    if (hipMemsetAsync((char*)d_ws + WS_BAR, 0, XCD_BAR_WORDS * 4, stream) != hipSuccess) { fprintf(stderr, "kernel_launch: memset of barrier words failed\n"); return; }
    Params p{};
    for (int i = 0; i < 16; ++i) p.in[i] = (const float*)d_in[i];
    p.out = (float*)d_out; p.ws = (unsigned char*)d_ws;
    void* args[] = {&p};
    hipError_t e = hipLaunchCooperativeKernel((const void*)fwd_megakernel, dim3(grid), dim3(512), args, LDS_BYTES, stream);
    if (e != hipSuccess) fprintf(stderr, "cooperative launch failed: %s (grid %d)\n", hipGetErrorString(e), grid);
}
```

```cpp
#include <hip/hip_runtime.h>
#include <hip/hip_cooperative_groups.h>
#include <cstdio>
#include <cstdint>
namespace cg = cooperative_groups;

#define LAS __attribute__((address_space(3)))
typedef unsigned short bf16_t;
typedef short bf16x8 __attribute__((ext_vector_type(8)));
typedef short s16x4 __attribute__((ext_vector_type(4)));
typedef float f32x4 __attribute__((ext_vector_type(4)));
typedef unsigned u32x4 __attribute__((ext_vector_type(4)));
typedef unsigned u32x2 __attribute__((ext_vector_type(2)));
typedef float f32x2_t __attribute__((ext_vector_type(2)));
typedef __bf16 bf16x2_t __attribute__((ext_vector_type(2)));

constexpr int DM = 1024, NB = 4, SEQ = 8192, DEPTH = 4, CTXL = 256;
constexpr int ML = NB * SEQ;
constexpr int MC = NB * CTXL;
constexpr int MT = ML + MC;
constexpr int INW = 5632;
constexpr int NIN = 5888;
constexpr float EPSV = 1e-6f;
constexpr float LOG2E = 1.4426950408889634f;

constexpr size_t MiB = 1u << 20;
constexpr size_t WS_MOD = 0;
constexpr size_t WS_ROPE = 256 * 1024;
constexpr size_t WS_T128 = 512 * 1024;
constexpr size_t WS_TC = 1 * MiB;
constexpr size_t WS_T3 = 2 * MiB;
constexpr size_t WS_SGUW = 4 * MiB;
constexpr size_t WS_BAR = 6 * MiB;
constexpr size_t WS_XC = 8 * MiB;
constexpr size_t WS_W = 16 * MiB;
constexpr size_t W_IN_OFF = 0, W_PA_OFF = (size_t)NIN * 1024 * 2, W_PB_OFF = W_PA_OFF + 1024 * 256 * 2, W_PC_OFF = W_PB_OFF + 1024 * 256 * 2, W_OUT_OFF = W_PC_OFF + 1024 * 512 * 2;
constexpr size_t WS_H = 32 * MiB;
constexpr size_t WS_G = 98 * MiB;
constexpr size_t WS_Z = 131 * MiB;
constexpr size_t WS_U = 197 * MiB;
constexpr size_t WS_QKV = 230 * MiB;
constexpr size_t WS_GT = 280 * MiB;
constexpr size_t WS_W1 = 478 * MiB;
constexpr size_t WS_END = 494 * MiB;
static_assert(W_OUT_OFF + 1024 * 1024 * 2 <= 16 * MiB, "weights fit");

constexpr int LDS_BYTES = 147456;
#ifndef PROBE_TS
#define PROBE_TS 0
#endif
#ifndef PROBE_SCALE
#define PROBE_SCALE 1000.f
#endif
#ifndef PROBE_DUP
#define PROBE_DUP 0
#endif

__device__ __forceinline__ unsigned cvtpk(float lo, float hi) { f32x2_t v = {lo, hi}; bf16x2_t b = __builtin_convertvector(v, bf16x2_t); return __builtin_bit_cast(unsigned, b); }
__device__ __forceinline__ float bflo(unsigned w) { return __uint_as_float(w << 16); }
__device__ __forceinline__ float bfhi(unsigned w) { return __uint_as_float(w & 0xffff0000u); }
__device__ __forceinline__ float silu_f(float v) { return v * __builtin_amdgcn_rcpf(1.f + __expf(-v)); }
__device__ __forceinline__ float sigm_f(float v) { return __builtin_amdgcn_rcpf(1.f + __expf(-v)); }
__device__ __forceinline__ unsigned pack4q(f32x4 v) {
    unsigned w = 0u;
    w = __builtin_amdgcn_cvt_pk_u8_f32(fmaxf(v[0] * 255.f, 1.f), 0u, w); w = __builtin_amdgcn_cvt_pk_u8_f32(fmaxf(v[1] * 255.f, 1.f), 1u, w);
    w = __builtin_amdgcn_cvt_pk_u8_f32(fmaxf(v[2] * 255.f, 1.f), 2u, w); w = __builtin_amdgcn_cvt_pk_u8_f32(fmaxf(v[3] * 255.f, 1.f), 3u, w); return w; }
__device__ __forceinline__ float ub0(unsigned w) { return (float)(w & 0xffu); }
__device__ __forceinline__ float ub1(unsigned w) { return (float)((w >> 8) & 0xffu); }
__device__ __forceinline__ float ub2(unsigned w) { return (float)((w >> 16) & 0xffu); }
__device__ __forceinline__ float ub3(unsigned w) { return (float)(w >> 24); }
typedef short v4i16_t __attribute__((ext_vector_type(4)));
__device__ __forceinline__ s16x4 lds_tr(const LAS unsigned char* p) { return __builtin_bit_cast(s16x4, __builtin_amdgcn_ds_read_tr16_b64_v4i16((LAS v4i16_t*)p)); }
__device__ __forceinline__ bf16x8 cat8(s16x4 a, s16x4 b) { return (bf16x8){a[0], a[1], a[2], a[3], b[0], b[1], b[2], b[3]}; }

namespace pg8 {
constexpr int BM = 256, BK = 64, HALF = 128, HTB = HALF * BK * 2, STAGE_BYTES = 8 * HTB, NXCD = 8, WGM = 8;
__host__ __device__ __forceinline__ int lds_byte(int r, int c) { const int st = (r >> 4) * 2 + (c >> 5), rr = r & 15, cc = c & 31, ob = rr * 64 + cc * 2; return st * 1024 + (ob ^ (((ob >> 9) & 1) << 5)); }
__host__ __device__ __forceinline__ void stage_rc(int b, int& R, int& C) { const int st = b / 1024, sb = b % 1024, swz = sb ^ (((sb >> 9) & 1) << 5); R = (st >> 1) * 16 + swz / 64; C = (st & 1) * 32 + (swz % 64) / 2; }
__host__ __device__ __forceinline__ int perm32(int rho) { const int n = rho >> 4, i = rho & 15; return 8 * (i >> 2) + 4 * n + (i & 3); }
struct Unit { int pm, pn; };
struct Gemm { const bf16_t* A; const bf16_t* Bt; int M, N, K, lda; };
struct StaticOrder {
    int nM, nN, nwg, G, c;
    __host__ __device__ void init(int M, int N, int G_, int c_) { nM = M / BM; nN = N / BM; nwg = nM * nN; G = G_; c = c_; }
    __host__ __device__ bool next(int i, Unit& u) const {
        const long L = (long)i * G + c; if (L >= nwg) return false;
        int wgid = (int)L; { const int q = nwg / NXCD, r = nwg % NXCD, xcd = wgid % NXCD, off = wgid / NXCD; wgid = (xcd < r ? xcd * (q + 1) : r * (q + 1) + (xcd - r) * q) + off; }
        const int nig = WGM * nN, gid = wgid / nig, fm = gid * WGM, gsz = (nM - fm) < WGM ? (nM - fm) : WGM;
        u.pm = fm + ((wgid % nig) % gsz); u.pn = (wgid % nig) / gsz; return true;
    }
};
template <class Epi, bool HOOK = false>
__device__ __forceinline__ void gemm_phase(LAS unsigned char* lds, const Gemm g, const StaticOrder& S, const Epi& E, const int tid) {
    const int wid = __builtin_amdgcn_readfirstlane(tid >> 6), lane = tid & 63, wr = wid >> 2, wc = wid & 3, fr = lane & 15, fq = lane >> 4;
    const int K = g.K, nt = K / BK, lda = g.lda;
    unsigned voffA[2], voffB[2];
#pragma unroll
    for (int i = 0; i < 2; ++i) { int R, C; stage_rc(tid * 16 + i * 8192, R, C); const int Rb = Epi::PERM ? ((R & ~31) + perm32(R & 31)) : R;
        voffA[i] = (unsigned)(R * lda + C) * 2u; voffB[i] = (unsigned)(Rb * K + C) * 2u; }
    const size_t kstep = (size_t)(BK * 2);
    const size_t hstepA = (size_t)HALF * lda * 2, hstepB = (size_t)HALF * K * 2;
    const size_t tstepA = 2 * hstepA, tstepB = 2 * hstepB;
    const unsigned ldsw = (unsigned)wid * 1024u;
    const int aoff = lds_byte(wr * 64 + fr, fq * 8), boff = lds_byte(wc * 32 + fr, fq * 8);
#define PG8_SA(b, h) (((b) * 2 + (h)) * HTB)
#define PG8_SB(b, h) ((4 + (b) * 2 + (h)) * HTB)
#define PG8_STAGE(bufoff, gbase, voff) do { _Pragma("unroll") for (int _i = 0; _i < 2; ++_i) \
        __builtin_amdgcn_global_load_lds((const unsigned*)((const char*)(gbase) + (voff)[_i]), (LAS unsigned*)(lds + (bufoff) + ldsw + _i * 8192), 16, 0, 0); } while (0)
#define PG8_LDA(dst, b, h) do { _Pragma("unroll") for (int m = 0; m < 4; ++m) _Pragma("unroll") for (int k = 0; k < 2; ++k) dst[m][k] = *(const LAS bf16x8*)(lds + PG8_SA(b, h) + aoff + m * 2048 + k * 1024); } while (0)
#define PG8_LDB(dst, b, h) do { _Pragma("unroll") for (int n = 0; n < 2; ++n) _Pragma("unroll") for (int k = 0; k < 2; ++k) dst[n][k] = *(const LAS bf16x8*)(lds + PG8_SB(b, h) + boff + n * 2048 + k * 1024); } while (0)
#define PG8_MMA(ai, bj, At, Bt) do { __builtin_amdgcn_s_setprio(1); _Pragma("unroll") for (int m = 0; m < 4; ++m) _Pragma("unroll") for (int n = 0; n < 2; ++n) _Pragma("unroll") for (int k = 0; k < 2; ++k) \
        acc[ai][bj][m][n] = __builtin_amdgcn_mfma_f32_16x16x32_bf16(Bt[n][k], At[m][k], acc[ai][bj][m][n], 0, 0, 0); __builtin_amdgcn_s_setprio(0); } while (0)
#define PG8_WAIT_V(n) asm volatile("s_waitcnt vmcnt(" #n ")" ::: "memory")
#define PG8_WAIT_L(n) asm volatile("s_waitcnt lgkmcnt(" #n ")" ::: "memory")
#define PG8_BAR __builtin_amdgcn_s_barrier()
#define PG8_SCHED __builtin_amdgcn_sched_barrier(0)
    Unit cur, nxt; int ui = 0;
    if (!S.next(0, cur)) return;
    f32x4 acc[2][2][4][2];
#pragma unroll
    for (int a = 0; a < 2; ++a)
#pragma unroll
        for (int b = 0; b < 2; ++b)
#pragma unroll
            for (int m = 0; m < 4; ++m)
#pragma unroll
                for (int n = 0; n < 2; ++n) acc[a][b][m][n] = (f32x4){0.f, 0.f, 0.f, 0.f};
    bf16x8 At[4][2], B0[2][2], B1[2][2];
    const char* cA = (const char*)g.A + (size_t)cur.pm * tstepA; const char* cB = (const char*)g.Bt + (size_t)cur.pn * tstepB;
    PG8_STAGE(PG8_SB(0, 0), cB, voffB); PG8_STAGE(PG8_SB(0, 1), cB + hstepB, voffB); PG8_STAGE(PG8_SA(0, 0), cA, voffA); PG8_STAGE(PG8_SA(0, 1), cA + hstepA, voffA);
    if (wr == 1) PG8_BAR;
    PG8_WAIT_V(2); PG8_BAR;
    PG8_STAGE(PG8_SB(1, 0), cB + kstep, voffB); PG8_STAGE(PG8_SA(1, 0), cA + kstep, voffA); PG8_STAGE(PG8_SB(1, 1), cB + hstepB + kstep, voffB);
    PG8_WAIT_V(6); PG8_BAR;
    for (;;) {
        const bool has_next = S.next(ui + 1, nxt);
        const char* nA = has_next ? (const char*)g.A + (size_t)nxt.pm * tstepA : cA; const char* nB = has_next ? (const char*)g.Bt + (size_t)nxt.pn * tstepB : cB;
        for (int t = 0; t < nt; t += 2) {
            if constexpr (HOOK) { if (t == 4 || t == 8) E.mid(acc, cur, t == 8, wr, wc, fr, fq); }
            const bool last = (t == nt - 2);
            const char* a1 = cA + (size_t)(t + 1) * kstep;
            const char* a2 = last ? nA : cA + (size_t)(t + 2) * kstep; const char* b2 = last ? nB : cB + (size_t)(t + 2) * kstep;
            const char* a3 = a2 + kstep; const char* b3 = b2 + kstep;
            PG8_LDB(B0, 0, 0); PG8_LDB(B1, 0, 1); PG8_SCHED; PG8_LDA(At, 0, 0); PG8_STAGE(PG8_SA(1, 1), a1 + hstepA, voffA);
            PG8_WAIT_V(8); PG8_WAIT_L(0); PG8_BAR; PG8_MMA(0, 0, At, B0); PG8_MMA(0, 1, At, B1); PG8_BAR; PG8_SCHED;
            PG8_LDA(At, 0, 1); PG8_STAGE(PG8_SB(0, 0), b2, voffB); PG8_STAGE(PG8_SB(0, 1), b2 + hstepB, voffB); PG8_STAGE(PG8_SA(0, 0), a2, voffA);
            PG8_WAIT_V(8); PG8_WAIT_L(0); PG8_BAR; PG8_MMA(1, 0, At, B0); PG8_MMA(1, 1, At, B1); PG8_BAR; PG8_SCHED;
            PG8_LDB(B0, 1, 0); PG8_LDB(B1, 1, 1); PG8_SCHED; PG8_LDA(At, 1, 0); PG8_STAGE(PG8_SA(0, 1), a2 + hstepA, voffA);
            PG8_WAIT_V(8); PG8_WAIT_L(0); PG8_BAR; PG8_MMA(0, 0, At, B0); PG8_MMA(0, 1, At, B1); PG8_BAR; PG8_SCHED;
            PG8_LDA(At, 1, 1); PG8_STAGE(PG8_SB(1, 0), b3, voffB); PG8_STAGE(PG8_SB(1, 1), b3 + hstepB, voffB); PG8_STAGE(PG8_SA(1, 0), a3, voffA);
            PG8_WAIT_V(8); PG8_WAIT_L(0); PG8_BAR; PG8_MMA(1, 0, At, B0); PG8_MMA(1, 1, At, B1); PG8_BAR; PG8_SCHED;
        }
        if (wr == 0) PG8_BAR;
        { Unit ue = cur; asm volatile("" : "+s"(ue.pm), "+s"(ue.pn));
          E(acc, ue, wr, wc, fr, fq); }
        if (!has_next) break;
#pragma unroll
        for (int a = 0; a < 2; ++a)
#pragma unroll
            for (int b = 0; b < 2; ++b)
#pragma unroll
                for (int m = 0; m < 4; ++m)
#pragma unroll
                    for (int n = 0; n < 2; ++n) acc[a][b][m][n] = (f32x4){0.f, 0.f, 0.f, 0.f};
        cur = nxt; cA = nA; cB = nB; ++ui;
        if (wr == 1) PG8_BAR;
    }
    PG8_WAIT_V(0);
    PG8_BAR;
#undef PG8_SA
#undef PG8_SB
#undef PG8_STAGE
#undef PG8_LDA
#undef PG8_LDB
#undef PG8_MMA
#undef PG8_WAIT_V
#undef PG8_WAIT_L
#undef PG8_BAR
#undef PG8_SCHED
}

struct EpiProj {
    static constexpr bool PERM = true;
    bf16_t *Gb, *Zb, *Ub, *QKVb, *GTb; const float *rope, *qg, *kg;
    __device__ __forceinline__ void operator()(const f32x4 (&acc)[2][2][4][2], const Unit& u, int wr, int wc, int fr, int fq) const {
        const int pn = u.pn;
        const int row0 = u.pm * BM + wr * 64 + fr;
        if (pn >= 6 && pn <= 8) {
            const bool isq = pn < 8;
            if (!isq && wc >= 2) {
#pragma unroll
                for (int ai = 0; ai < 2; ++ai)
#pragma unroll
                    for (int m = 0; m < 4; ++m) { bf16_t* rowp = QKVb + (size_t)(row0 + ai * HALF + m * 16) * 768 + 640 + (wc - 2) * 64 + 8 * fq;
#pragma unroll
                        for (int bj = 0; bj < 2; ++bj) { const f32x4 v0 = acc[ai][bj][m][0], v1 = acc[ai][bj][m][1];
                            u32x4 w; w.x = cvtpk(v0[0], v0[1]); w.y = cvtpk(v0[2], v0[3]); w.z = cvtpk(v1[0], v1[1]); w.w = cvtpk(v1[2], v1[3]);
                            *(u32x4*)(rowp + bj * 32) = w; } }
            } else {
                const int head = isq ? (pn - 6) * 4 + wc : wc;
                const float* gain = isq ? qg : kg;
                const int cbase = (isq ? 0 : 512) + head * 64 + 4 * fq;
                const float scale = isq ? 0.125f * LOG2E : 1.f;
                const bool dorope = u.pm < (ML / BM);
                const f32x4 g1a = *(const f32x4*)(gain + 4 * fq), g2a = *(const f32x4*)(gain + 16 + 4 * fq), g1b = *(const f32x4*)(gain + 32 + 4 * fq), g2b = *(const f32x4*)(gain + 48 + 4 * fq);
#pragma unroll
                for (int ai = 0; ai < 2; ++ai)
#pragma unroll
                    for (int m = 0; m < 4; ++m) { const int row = row0 + ai * HALF + m * 16;
                        f32x4 x1a = acc[ai][0][m][0], x2a = acc[ai][0][m][1], x1b = acc[ai][1][m][0], x2b = acc[ai][1][m][1];
                        float ss = 0.f;
#pragma unroll
                        for (int e = 0; e < 4; ++e) ss += (x1a[e] * x1a[e] + x2a[e] * x2a[e]) + (x1b[e] * x1b[e] + x2b[e] * x2b[e]);
                        ss += __shfl_xor(ss, 16); ss += __shfl_xor(ss, 32);
                        const float rinv = rsqrtf(ss * (1.f / 64.f) + EPSV);
                        x1a = x1a * rinv * g1a; x2a = x2a * rinv * g2a; x1b = x1b * rinv * g1b; x2b = x2b * rinv * g2b;
                        if (dorope) { const int t = row & (SEQ - 1);
                            const float* ra = rope + ((t >> 6) * 16 + 4 * fq) * 2; const f32x4 a0 = *(const f32x4*)ra, a1 = *(const f32x4*)(ra + 4);
                            const float* rb = rope + ((t & 63) * 16 + 4 * fq) * 2; const f32x4 b0 = *(const f32x4*)rb, b1 = *(const f32x4*)(rb + 4);
                            const f32x4 ca = {a0[0], a0[2], a1[0], a1[2]}, sa = {a0[1], a0[3], a1[1], a1[3]}, cb = {b0[0], b0[2], b1[0], b1[2]}, sb = {b0[1], b0[3], b1[1], b1[3]};
                            const f32x4 y1a = x1a * ca - x2a * sa, y2a = x2a * ca + x1a * sa, y1b = x1b * cb - x2b * sb, y2b = x2b * cb + x1b * sb;
                            x1a = y1a; x2a = y2a; x1b = y1b; x2b = y2b; }
                        x1a = x1a * scale; x2a = x2a * scale; x1b = x1b * scale; x2b = x2b * scale;
                        bf16_t* dp = QKVb + (size_t)row * 768 + cbase;
                        u32x2 w;
                        w.x = cvtpk(x1a[0], x1a[1]); w.y = cvtpk(x1a[2], x1a[3]); *(u32x2*)dp = w;
                        w.x = cvtpk(x2a[0], x2a[1]); w.y = cvtpk(x2a[2], x2a[3]); *(u32x2*)(dp + 16) = w;
                        w.x = cvtpk(x1b[0], x1b[1]); w.y = cvtpk(x1b[2], x1b[3]); *(u32x2*)(dp + 32) = w;
                        w.x = cvtpk(x2b[0], x2b[1]); w.y = cvtpk(x2b[2], x2b[3]); *(u32x2*)(dp + 48) = w; }
            }
            return;
        }
        bf16_t* base; int ld, c0, act;
        if (pn < 2) { base = Gb; ld = 512; c0 = pn * 256; act = 0; }
        else if (pn == 2) { base = Zb; ld = 1024; c0 = 0; act = 1; }
        else if (pn == 3) { base = Ub; ld = 512; c0 = 0; act = 0; }
        else if (pn == 4) { base = Ub; ld = 512; c0 = 256; act = 0; }
        else if (pn == 5) { base = Zb; ld = 1024; c0 = 256; act = 1; }
        else if (pn < 11) { base = Zb; ld = 1024; c0 = 512 + (pn - 9) * 256; act = 1; }
        else {
            unsigned char* gb8 = (unsigned char*)GTb + (size_t)row0 * 3072 + (pn - 11) * 256 + wc * 32 + 8 * fq;
#pragma unroll
            for (int ai = 0; ai < 2; ++ai)
#pragma unroll
                for (int m = 0; m < 4; ++m)
#pragma unroll
                    for (int bj = 0; bj < 2; ++bj) { f32x4 v0 = acc[ai][bj][m][0], v1 = acc[ai][bj][m][1];
#pragma unroll
                        for (int e = 0; e < 4; ++e) { v0[e] = sigm_f(v0[e]); v1[e] = sigm_f(v1[e]); }
                        u32x2 w; w.x = pack4q(v0); w.y = pack4q(v1);
                        *(u32x2*)(gb8 + (size_t)(ai * HALF + m * 16) * 3072 + bj * HALF) = w; }
            return; }
        const int col0 = c0 + wc * 32 + 8 * fq;
#pragma unroll
        for (int ai = 0; ai < 2; ++ai)
#pragma unroll
            for (int m = 0; m < 4; ++m) { bf16_t* rowp = base + (size_t)(row0 + ai * HALF + m * 16) * ld + col0;
#pragma unroll
                for (int bj = 0; bj < 2; ++bj) { f32x4 v0 = acc[ai][bj][m][0], v1 = acc[ai][bj][m][1];
                    if (act == 1) {
#pragma unroll
                        for (int e = 0; e < 4; ++e) { v0[e] = silu_f(v0[e]); v1[e] = silu_f(v1[e]); } }
                    else if (act == 2) {
#pragma unroll
                        for (int e = 0; e < 4; ++e) { v0[e] = sigm_f(v0[e]); v1[e] = sigm_f(v1[e]); } }
                    u32x4 w; w.x = cvtpk(v0[0], v0[1]); w.y = cvtpk(v0[2], v0[3]); w.z = cvtpk(v1[0], v1[1]); w.w = cvtpk(v1[2], v1[3]);
                    *(u32x4*)(rowp + bj * HALF) = w; } }
    }
};
struct EpiMerge {
    static constexpr bool PERM = true;
    const unsigned char* GT8; bf16_t* MG;
    __device__ __forceinline__ void mid(f32x4 (&acc)[2][2][4][2], const Unit& u, bool second, int wr, int wc, int fr, int fq) const {
        const int row0 = u.pm * BM + wr * 64 + fr, col0 = u.pn * BM + wc * 32 + 8 * fq + (second ? 1024 : 0);
#pragma unroll
        for (int ai = 0; ai < 2; ++ai)
#pragma unroll
            for (int m = 0; m < 4; ++m) { const unsigned char* gp = GT8 + (size_t)(row0 + ai * HALF + m * 16) * 3072 + col0;
#pragma unroll
                for (int bj = 0; bj < 2; ++bj) { const u32x2 nu = *(const u32x2*)(gp + bj * HALF), de = *(const u32x2*)(gp + 1024 + bj * HALF);
                    f32x4& v0 = acc[ai][bj][m][0]; f32x4& v1 = acc[ai][bj][m][1];
                    v0[0] *= ub0(nu.x) * __builtin_amdgcn_rcpf(ub0(de.x)); v0[1] *= ub1(nu.x) * __builtin_amdgcn_rcpf(ub1(de.x));
                    v0[2] *= ub2(nu.x) * __builtin_amdgcn_rcpf(ub2(de.x)); v0[3] *= ub3(nu.x) * __builtin_amdgcn_rcpf(ub3(de.x));
                    v1[0] *= ub0(nu.y) * __builtin_amdgcn_rcpf(ub0(de.y)); v1[1] *= ub1(nu.y) * __builtin_amdgcn_rcpf(ub1(de.y));
                    v1[2] *= ub2(nu.y) * __builtin_amdgcn_rcpf(ub2(de.y)); v1[3] *= ub3(nu.y) * __builtin_amdgcn_rcpf(ub3(de.y)); } }
        asm volatile("s_waitcnt vmcnt(0)" ::: "memory");
    }
    __device__ __forceinline__ void operator()(const f32x4 (&acc)[2][2][4][2], const Unit& u, int wr, int wc, int fr, int fq) const {
        const int row0 = u.pm * BM + wr * 64 + fr, col0 = u.pn * BM + wc * 32 + 8 * fq;
        constexpr float Q = 1.f / 255.f;
#pragma unroll
        for (int ai = 0; ai < 2; ++ai)
#pragma unroll
            for (int m = 0; m < 4; ++m) { const size_t row = (size_t)(row0 + ai * HALF + m * 16);
#pragma unroll
                for (int bj = 0; bj < 2; ++bj) { const int col = col0 + bj * HALF;
                    const u32x2 gw = *(const u32x2*)(GT8 + row * 3072 + 2048 + col);
                    f32x4 v0 = acc[ai][bj][m][0], v1 = acc[ai][bj][m][1];
                    v0[0] *= ub0(gw.x) * Q; v0[1] *= ub1(gw.x) * Q; v0[2] *= ub2(gw.x) * Q; v0[3] *= ub3(gw.x) * Q;
                    v1[0] *= ub0(gw.y) * Q; v1[1] *= ub1(gw.y) * Q; v1[2] *= ub2(gw.y) * Q; v1[3] *= ub3(gw.y) * Q;
                    u32x4 w; w.x = cvtpk(v0[0], v0[1]); w.y = cvtpk(v0[2], v0[3]); w.z = cvtpk(v1[0], v1[1]); w.w = cvtpk(v1[2], v1[3]);
                    *(u32x4*)(MG + row * 1024 + col) = w; } }
    }
};
struct EpiRes {
    static constexpr bool PERM = false;
    const float* xsrc; float* xdst; const float* csrc; float* cdst; const float* modl;
    __device__ __forceinline__ void operator()(const f32x4 (&acc)[2][2][4][2], const Unit& u, int wr, int wc, int fr, int fq) const {
        const bool isctx = u.pm >= (ML / BM);
        const int rbase = u.pm * BM + wr * 64 + fr;
        const int bi = isctx ? 4 : (rbase >> 13);
        const float* src = isctx ? csrc + (size_t)(rbase - ML) * DM : xsrc + (size_t)rbase * DM;
        float* dst = isctx ? cdst + (size_t)(rbase - ML) * DM : xdst + (size_t)rbase * DM;
        const int col0 = u.pn * BM + wc * 32 + 4 * fq;
#pragma unroll
        for (int bj = 0; bj < 2; ++bj)
#pragma unroll
            for (int n = 0; n < 2; ++n) { const int col = col0 + bj * HALF + n * 16;
                const f32x4 gt = *(const f32x4*)(modl + bi * 3072 + 2048 + col);
#pragma unroll
                for (int ai = 0; ai < 2; ++ai)
#pragma unroll
                    for (int m = 0; m < 4; ++m) { const size_t off = (size_t)(ai * HALF + m * 16) * DM + col;
                        const f32x4 xs = *(const f32x4*)(src + off);
                        *(f32x4*)(dst + off) = xs + gt * acc[ai][bj][m][n]; } }
    }
};
}

template <int NJ, int KC>
__device__ __forceinline__ void ag_load(bf16x8 (&bb)[KC][NJ], const bf16_t* tbase, int ldt, int ch) {
#pragma unroll
    for (int kk = 0; kk < KC; ++kk)
#pragma unroll
        for (int j = 0; j < NJ; ++j) bb[kk][j] = *(const bf16x8*)(tbase + (size_t)j * 16 * ldt + (ch * KC + kk) * 32);
}
template <int NI, int NJ, int KC>
__device__ __forceinline__ void ag_mma(f32x4 (&acc)[NI][NJ], const bf16x8 (&bb)[KC][NJ], const LAS unsigned char* abase, int RS, int ch) {
#pragma unroll
    for (int kk = 0; kk < KC; ++kk) { const LAS unsigned char* ap = abase + (ch * KC + kk) * 32 * RS;
        bf16x8 a[NI];
#pragma unroll
        for (int i = 0; i < NI; ++i) { const s16x4 lo = lds_tr(ap + i * 32), hi = lds_tr(ap + 4 * RS + i * 32); a[i] = cat8(lo, hi); }
#pragma unroll
        for (int i = 0; i < NI; ++i)
#pragma unroll
            for (int j = 0; j < NJ; ++j) acc[i][j] = __builtin_amdgcn_mfma_f32_16x16x32_bf16(a[i], bb[kk][j], acc[i][j], 0, 0, 0);
    }
}
template <int NI, int NJ, int KS, int KC>
__device__ __forceinline__ void act_gemm(f32x4 (&acc)[NI][NJ], const LAS unsigned char* act, int RS, int n0, const bf16_t* tab, int ldt, int lane) {
    constexpr int NC = KS / KC;
    static_assert(NC == 1 || NC % 2 == 0, "chunk count");
    const int g = lane >> 4, c = lane & 15;
    const LAS unsigned char* abase = act + (8 * g + (c >> 2)) * RS + (n0 + 4 * (c & 3)) * 2;
    const bf16_t* tbase = tab + (size_t)c * ldt + 8 * g;
    bf16x8 b0[KC][NJ];
    ag_load<NJ, KC>(b0, tbase, ldt, 0);
    if constexpr (NC == 1) { ag_mma<NI, NJ, KC>(acc, b0, abase, RS, 0); }
    else {
        bf16x8 b1[KC][NJ];
#pragma unroll 1
        for (int ch = 0; ch < NC; ch += 2) {
            ag_load<NJ, KC>(b1, tbase, ldt, ch + 1);
            ag_mma<NI, NJ, KC>(acc, b0, abase, RS, ch);
            if (ch + 2 < NC) ag_load<NJ, KC>(b0, tbase, ldt, ch + 2);
            ag_mma<NI, NJ, KC>(acc, b1, abase, RS, ch + 1);
        }
    }
}
template <int NI, int NJ> __device__ __forceinline__ void zero_acc(f32x4 (&acc)[NI][NJ]) {
#pragma unroll
    for (int i = 0; i < NI; ++i)
#pragma unroll
        for (int j = 0; j < NJ; ++j) acc[i][j] = (f32x4){0.f, 0.f, 0.f, 0.f};
}
__device__ __forceinline__ void mul_store4z(bf16_t* p, f32x4 v, u32x2 z, bool dry = false) {
    if (dry && v[0] != 1.2345e30f) return;
    u32x2 o; o.x = cvtpk(v[0] * bflo(z.x), v[1] * bfhi(z.x)); o.y = cvtpk(v[2] * bflo(z.y), v[3] * bfhi(z.y));
    *(u32x2*)p = o;
}
__device__ __forceinline__ void mul_store4(bf16_t* p, f32x4 v, bool dry = false) {
    if (dry && v[0] != 1.2345e30f) return;
    const u32x2 z = *(const u32x2*)p;
    u32x2 o; o.x = cvtpk(v[0] * bflo(z.x), v[1] * bfhi(z.x)); o.y = cvtpk(v[2] * bflo(z.y), v[3] * bfhi(z.y));
    *(u32x2*)p = o;
}

struct Params { const float* in[16]; float* out; unsigned char* ws; };

__device__ __forceinline__ void phase0(const Params& p, LAS unsigned char* lds, int tid, int bid, int G) {
    LAS float* sc = (LAS float*)lds;
    LAS float* red = (LAS float*)(lds + 20480);
    for (int i = tid; i < 5120; i += 512) { const float v = i < 4096 ? p.in[1][i] : p.in[3][i - 4096]; sc[i] = v / (1.f + expf(-v)); }
    __syncthreads();
    float* mod = (float*)(p.ws + WS_MOD);
    for (int item = bid; item < 192; item += G) {
        const int l = item / 48, cgp = item % 48, col = tid & 63, kg = tid >> 6, n = cgp * 64 + col;
        const float* w = p.in[4] + ((size_t)l * 1024 + kg * 128) * 3072 + n;
        float a0 = 0.f, a1 = 0.f, a2 = 0.f, a3 = 0.f, a4 = 0.f;
#pragma unroll 8
        for (int k = 0; k < 128; ++k) { const float wv = w[(size_t)k * 3072]; const int kk = kg * 128 + k;
            a0 += sc[kk] * wv; a1 += sc[1024 + kk] * wv; a2 += sc[2048 + kk] * wv; a3 += sc[3072 + kk] * wv; a4 += sc[4096 + kk] * wv; }
        red[(kg * 5 + 0) * 64 + col] = a0; red[(kg * 5 + 1) * 64 + col] = a1; red[(kg * 5 + 2) * 64 + col] = a2; red[(kg * 5 + 3) * 64 + col] = a3; red[(kg * 5 + 4) * 64 + col] = a4;
        __syncthreads();
        if (tid < 320) { const int bi = tid >> 6, c2 = tid & 63; float s = 0.f;
#pragma unroll
            for (int k2 = 0; k2 < 8; ++k2) s += red[(k2 * 5 + bi) * 64 + c2];
            mod[(l * 5 + bi) * 3072 + cgp * 64 + c2] = s + p.in[5][l * 3072 + cgp * 64 + c2]; }
        __syncthreads();
    }
    const int gt = bid * 512 + tid, NT = G * 512;
    float* rope = (float*)(p.ws + WS_ROPE);
    for (int i = gt; i < 5 * 3072; i += NT) ((float*)(p.ws + WS_ROPE + 65536))[i] = 0.f;
    for (int i = gt; i < 2048; i += NT) { const int pos = i >> 4, fi = i & 15; const float inv = exp2f(-(float)fi * (13.287712379549449f / 16.f)); const float ang = (float)pos * inv;
        const double rev = (double)ang * 0.15915494309189535; const double frc = rev - floor(rev); float s, c; sincospif((float)(2.0 * frc), &s, &c); rope[2 * i] = c; rope[2 * i + 1] = s; }
    if (gt < DEPTH * 64) {
        const int l = gt >> 6, d = gt & 63; float mq = fabsf(p.in[9][l * 64 + d]), mk = fabsf(p.in[10][l * 64 + d]);
#pragma unroll
        for (int o = 1; o < 64; o <<= 1) { mq = fmaxf(mq, __shfl_xor(mq, o)); mk = fmaxf(mk, __shfl_xor(mk, o)); }
        if (d == 0) ((float*)(p.ws + WS_ROPE + 131072))[l] = 8.f * LOG2E * mq * mk * 1.02f; }
    bf16_t* t128 = (bf16_t*)(p.ws + WS_T128);
    for (int i = gt; i < 65536; i += NT) { const int m = i >> 8, k = i & 255, part = m >> 7, k1 = m & 127, pp = k >> 7, l1 = k & 127; const int j = (l1 * k1) & 127; float s, c; sincospif((float)j / 64.f, &s, &c);
        const float v = (part == pp) ? c : (part == 0 ? s : -s); t128[i] = (bf16_t)(cvtpk(v, 0.f) & 0xffffu); }
    bf16_t* tc = (bf16_t*)(p.ws + WS_TC);
    for (int i = gt; i < 256 * 512; i += NT) { const int kk = i >> 9, k = i & 511, part = k >> 8, ll = k & 255; const int j = (kk * ll) & 255; float s, c; sincospif((float)j / 128.f, &s, &c);
        const float v = (part ? s : c) * 0.0625f; tc[i] = (bf16_t)(cvtpk(v, 0.f) & 0xffffu); }
    bf16_t* t3 = (bf16_t*)(p.ws + WS_T3);
    for (int i = gt; i < 128 * 64 * 128; i += NT) { const int k1 = i >> 13, k2 = (i >> 7) & 63, kp = i & 127, l2 = kp >> 1, part = kp & 1; const int j = (l2 * (k1 + 128 * k2)) & 8191; float s, c; sincospif((float)j / 4096.f, &s, &c);
        const float v = (part ? s : c) * 0.011048543456039806f; t3[i] = (bf16_t)(cvtpk(v, 0.f) & 0xffffu); }
}

__device__ __forceinline__ void transpose_blk(const float* Wsrc, int ldw, int K, bf16_t* WTdst, int kb, int perm, LAS float* scr, int lane) {
    const int k0 = 64 * kb;
    f32x4 wv[8];
#pragma unroll
    for (int i = 0; i < 8; ++i) wv[i] = *(const f32x4*)(Wsrc + (size_t)(k0 + 8 * i + (lane >> 3)) * ldw + 4 * (lane & 7));
#pragma unroll
    for (int i = 0; i < 8; ++i) { LAS float* d = scr + (8 * i + (lane >> 3)) * 33 + 4 * (lane & 7); d[0] = wv[i][0]; d[1] = wv[i][1]; d[2] = wv[i][2]; d[3] = wv[i][3]; }
    asm volatile("s_waitcnt lgkmcnt(0)" ::: "memory");
    const int c = lane & 7;
#pragma unroll
    for (int j = 0; j < 4; ++j) { const int n = (lane >> 3) + 8 * j; const int sc = perm ? (16 * ((n >> 2) & 1) + 4 * (n >> 3) + (n & 3)) : n; const LAS float* s = scr + (8 * c) * 33 + sc;
        u32x4 o; o.x = cvtpk(s[0 * 33], s[1 * 33]); o.y = cvtpk(s[2 * 33], s[3 * 33]); o.z = cvtpk(s[4 * 33], s[5 * 33]); o.w = cvtpk(s[6 * 33], s[7 * 33]);
        *(u32x4*)(WTdst + (size_t)n * K + k0 + 8 * c) = o; }
    asm volatile("s_waitcnt lgkmcnt(0)" ::: "memory");
}
__device__ __forceinline__ void conv_weights(const Params& p, LAS unsigned char* lds, int l, int tid, int lane, int wave, int bid, int G) {
    unsigned char* wsW = p.ws + ((l & 1) ? WS_W1 : WS_W);
    bf16_t* WinT = (bf16_t*)(wsW + W_IN_OFF);
    LAS float* scr = (LAS float*)(lds + wave * 8448);
    LAS float* ctab = (LAS float*)(lds + 8 * 8448);
    if (tid < 64) { float s, c; sincospif((float)tid / 32.f, &s, &c); ctab[tid] = c * 0.125f; ctab[64 + tid] = s * 0.125f; }
    __syncthreads();
    const int gw = bid * 8 + wave, NGW = G * 8;
    const float* win = p.in[6] + (size_t)l * 1024 * INW;
    constexpr int I_IN = 16 * 168, I_PA = 4 * 32, I_PC = 8 * 32, I_OUT = 16 * 32;
    for (int it = gw; it < I_IN + 2 * I_PA + I_PC + I_OUT; it += NGW) {
        int r = it;
        if (r < I_IN) { const int rb = 16 + r % 168, kb = r / 168, n = rb * 32; int c0, perm = 0;
            if (n < 1536 || n >= 2304) c0 = n - 256;
            else if (n < 2048) { const int t = n - 1536, tile = t >> 8, tt = t & 255, bj = tt >> 7, wc = (tt >> 5) & 3; c0 = 1280 + (tile * 4 + wc) * 64 + 32 * bj; perm = 1; }
            else { const int tt = n - 2048, bj = tt >> 7, wc = (tt >> 5) & 3; if (wc < 2) { c0 = 1792 + wc * 64 + 32 * bj; perm = 1; } else c0 = 1920 + (wc - 2) * 64 + 32 * bj; }
            transpose_blk(win + c0, INW, 1024, WinT + (size_t)n * 1024, kb, perm, scr, lane); continue; } r -= I_IN;
        if (r < I_PA) { transpose_blk(p.in[12] + (size_t)l * 256 * 1024 + 32 * (r & 31), 1024, 1024, (bf16_t*)(wsW + W_PA_OFF) + (size_t)32 * (r & 31) * 1024, r >> 5, 0, scr, lane); continue; } r -= I_PA;
        if (r < I_PA) { transpose_blk(p.in[13] + (size_t)l * 256 * 1024 + 32 * (r & 31), 1024, 1024, (bf16_t*)(wsW + W_PA_OFF) + (size_t)32 * (r & 31) * 1024 + 256, r >> 5, 0, scr, lane); continue; } r -= I_PA;
        if (r < I_PC) { transpose_blk(p.in[14] + (size_t)l * 512 * 1024 + 32 * (r & 31), 1024, 1024, (bf16_t*)(wsW + W_PA_OFF) + (size_t)32 * (r & 31) * 1024 + 512, r >> 5, 0, scr, lane); continue; } r -= I_PC;
        transpose_blk(p.in[15] + (size_t)l * 1024 * 1024 + 32 * (r & 31), 1024, 1024, (bf16_t*)(wsW + W_OUT_OFF) + (size_t)32 * (r & 31) * 1024, r >> 5, 0, scr, lane);
    }
    const int gtid = (G - 1 - bid) * 512 + tid, NT = G * 512;
    for (int id = gtid; id < 65536; id += NT) {
        const int n = id >> 7, ko = id & 127, part = n >> 8, grp = (n >> 6) & 3, m = n & 63;
        const LAS float* tb = ctab + part * 64;
        const float* wrow = win + (size_t)(ko * 8) * INW + grp * 64;
        float a[8];
#pragma unroll
        for (int j = 0; j < 8; ++j) a[j] = 0.f;
#pragma unroll 4
        for (int c4 = 0; c4 < 16; ++c4) {
            const float t0 = tb[(m * (4 * c4)) & 63], t1 = tb[(m * (4 * c4 + 1)) & 63], t2 = tb[(m * (4 * c4 + 2)) & 63], t3 = tb[(m * (4 * c4 + 3)) & 63];
#pragma unroll
            for (int j = 0; j < 8; ++j) { const f32x4 wv = *(const f32x4*)(wrow + (size_t)j * INW + c4 * 4); a[j] += wv[0] * t0 + wv[1] * t1 + wv[2] * t2 + wv[3] * t3; }
        }
        const float sg = part ? -1.f : 1.f;
        u32x4 o; o.x = cvtpk(sg * a[0], sg * a[1]); o.y = cvtpk(sg * a[2], sg * a[3]); o.z = cvtpk(sg * a[4], sg * a[5]); o.w = cvtpk(sg * a[6], sg * a[7]);
        *(u32x4*)(WinT + (size_t)n * 1024 + ko * 8) = o;
    }
    { const float* sw = p.in[7] + (size_t)l * 65536; bf16_t* dw = (bf16_t*)(p.ws + WS_SGUW);
      for (int id = gtid; id < 8192; id += NT) { const f32x4 v0 = *(const f32x4*)(sw + id * 8), v1 = *(const f32x4*)(sw + id * 8 + 4);
          u32x4 o; o.x = cvtpk(v0[0], v0[1]); o.y = cvtpk(v0[2], v0[3]); o.z = cvtpk(v1[0], v1[1]); o.w = cvtpk(v1[2], v1[3]); *(u32x4*)(dw + id * 8) = o; } }
}
__device__ __forceinline__ void h_rows(const Params& p, int l, int lane, int wave, int bid, int G) {
    const int gw = bid * 8 + wave, NGW = G * 8;
    const float* xs = l == 0 ? p.in[0] : p.out;
    const float* cs = l == 0 ? p.in[2] : (const float*)(p.ws + WS_XC);
    const float* mod = (const float*)(p.ws + WS_MOD) + (size_t)l * 5 * 3072;
    bf16_t* H = (bf16_t*)(p.ws + WS_H);
    for (int row0 = gw * 4; row0 < MT; row0 += NGW * 4) {
        const float* src = row0 < ML ? xs + (size_t)row0 * DM : cs + (size_t)(row0 - ML) * DM;
        const int bi = row0 < ML ? (row0 >> 13) : 4;
        const float* md = mod + bi * 3072;
        f32x4 v[4][4]; float ss[4];
#pragma unroll
        for (int r = 0; r < 4; ++r)
#pragma unroll
            for (int j = 0; j < 4; ++j) v[r][j] = *(const f32x4*)(src + (size_t)r * DM + 4 * lane + 256 * j);
#pragma unroll
        for (int r = 0; r < 4; ++r) { ss[r] = 0.f;
#pragma unroll
            for (int j = 0; j < 4; ++j) ss[r] += (v[r][j][0] * v[r][j][0] + v[r][j][1] * v[r][j][1]) + (v[r][j][2] * v[r][j][2] + v[r][j][3] * v[r][j][3]); }
#pragma unroll
        for (int o = 1; o < 64; o <<= 1) {
#pragma unroll
            for (int r = 0; r < 4; ++r) ss[r] += __shfl_xor(ss[r], o); }
#pragma unroll
        for (int j = 0; j < 4; ++j) { const int idx = 4 * lane + 256 * j; const f32x4 sh = *(const f32x4*)(md + idx), scl = *(const f32x4*)(md + 1024 + idx) + 1.f;
#pragma unroll
            for (int r = 0; r < 4; ++r) { const float rinv = rsqrtf(ss[r] * (1.f / 1024.f) + EPSV);
                const f32x4 o = v[r][j] * rinv * scl + sh; u32x2 w; w.x = cvtpk(o[0], o[1]); w.y = cvtpk(o[2], o[3]); *(u32x2*)(H + (size_t)(row0 + r) * DM + idx) = w; } }
    }
}

__device__ __forceinline__ void attn_item(LAS unsigned char* lds, const bf16_t* QKV, bf16_t* Z, const float* sinkl, const float m0,
                                          int b, int blk, int kvh, int hp, bool isctx, int tid, int lane, int wave, bool dry = false) {
    constexpr int RS = 144;
    LAS unsigned char* Qs = lds; LAS unsigned char* Ks = lds + 256 * RS; LAS unsigned char* Vs = Ks + 128 * RS;
    const int qrow0 = isctx ? (ML + b * 256 + blk * 128) : (b * SEQ + blk * 128);
    const int hl = wave >> 2, qq = wave & 3, gq = hp * 2 + hl, g = lane >> 4, c = lane & 15;
    u32x4 qreg[4];
#pragma unroll
    for (int it = 0; it < 4; ++it) { const int id = it * 512 + tid, r = id >> 3, c16 = id & 7;
        qreg[it] = *(const u32x4*)(QKV + (size_t)(qrow0 + (r & 127)) * 768 + (kvh * 4 + hp * 2 + (r >> 7)) * 64 + c16 * 8); }
    u32x2 zreg[2][4];
#pragma unroll
    for (int qi = 0; qi < 2; ++qi)
#pragma unroll
        for (int df = 0; df < 4; ++df) zreg[qi][df] = *(const u32x2*)(Z + (size_t)(qrow0 + qq * 32 + 16 * qi + c) * 1024 + 512 + (kvh * 4 + gq) * 64 + 16 * df + 4 * g);
    const LAS unsigned char* qbase = Qs + (hl * 128 + qq * 32 + c) * RS + 16 * g;
    f32x4 O[4][2]; float l_run[2];
    const float sinkv = sinkl[kvh * 4 + gq] * LOG2E;
    const float mshift = fmaxf(m0, sinkv), nm = -mshift;
    const f32x4 negm = {nm, nm, nm, nm};
#pragma unroll
    for (int qi = 0; qi < 2; ++qi) { l_run[qi] = (g == 0) ? __builtin_amdgcn_exp2f(sinkv - mshift) : 0.f;
#pragma unroll
        for (int df = 0; df < 4; ++df) O[df][qi] = (f32x4){0.f, 0.f, 0.f, 0.f}; }
    const LAS unsigned char* vbase = Vs + (4 * g + (c >> 2)) * RS + (4 * (c & 3)) * 2;
    const int kvoff = 512 + kvh * 64 + (tid & 7) * 8, kr0 = tid >> 3;
    int ti = isctx ? 3 : (blk == 0 ? 1 : 0);
    u32x4 kreg[2], vreg[2];
#define ATT_KROW(t) ((t) >= 3 ? ML + b * 256 + ((t) - 3) * 128 : qrow0 + ((t) - 1) * 128)
#define ATT_PRELOAD(t) do { const bf16_t* src_ = QKV + (size_t)(ATT_KROW(t) + kr0) * 768 + kvoff; \
        kreg[0] = *(const u32x4*)src_; vreg[0] = *(const u32x4*)(src_ + 128); kreg[1] = *(const u32x4*)(src_ + (size_t)64 * 768); vreg[1] = *(const u32x4*)(src_ + (size_t)64 * 768 + 128); } while (0)
    ATT_PRELOAD(ti);
    __syncthreads();
#pragma unroll
    for (int it = 0; it < 4; ++it) { const int id = it * 512 + tid; *(LAS u32x4*)(Qs + (id >> 3) * RS + (id & 7) * 16) = qreg[it]; }
#pragma unroll 1
    while (ti < 5) {
        int tn = ti + 1; if (tn == 2 && blk == 63) tn = 3;
        __syncthreads();
#pragma unroll
        for (int it = 0; it < 2; ++it) { *(LAS u32x4*)(Ks + (kr0 + 64 * it) * RS + (tid & 7) * 16) = kreg[it]; *(LAS u32x4*)(Vs + (kr0 + 64 * it) * RS + (tid & 7) * 16) = vreg[it]; }
        if (tn < 5) ATT_PRELOAD(tn);
        __syncthreads();
        const int ks_lo = (ti == 0) ? qq : 0, ks_hi = (ti == 2) ? qq + 1 : 4;
        const int sg = (ti == 0) ? 1 : -1;
        bf16x8 qf[2][2];
#pragma unroll
        for (int qi = 0; qi < 2; ++qi) { qf[qi][0] = *(const LAS bf16x8*)(qbase + (16 * qi) * RS); qf[qi][1] = *(const LAS bf16x8*)(qbase + (16 * qi) * RS + 64); }
        int base0 = sg * (4 * g - (qq * 32 + c)); asm volatile("" : "+v"(base0));
        float psum[2] = {0.f, 0.f};
        if (ti == 0 || ti == 2) {
#pragma unroll
        for (int ks = 0; ks < 4; ++ks) {
            if (ks >= ks_lo && ks < ks_hi) {
                asm volatile("" ::: "memory");
                const LAS unsigned char* kp = Ks + (32 * ks + c) * RS + 16 * g;
                const bf16x8 ka0 = *(const LAS bf16x8*)kp, ka1 = *(const LAS bf16x8*)(kp + 64), kb0 = *(const LAS bf16x8*)(kp + 16 * RS), kb1 = *(const LAS bf16x8*)(kp + 16 * RS + 64);
                bf16x8 pf[2];
#pragma unroll
                for (int qi = 0; qi < 2; ++qi) {
                    f32x4 s0 = __builtin_amdgcn_mfma_f32_16x16x32_bf16(ka0, qf[qi][0], negm, 0, 0, 0);
                    s0 = __builtin_amdgcn_mfma_f32_16x16x32_bf16(ka1, qf[qi][1], s0, 0, 0, 0);
                    f32x4 s1 = __builtin_amdgcn_mfma_f32_16x16x32_bf16(kb0, qf[qi][0], negm, 0, 0, 0);
                    s1 = __builtin_amdgcn_mfma_f32_16x16x32_bf16(kb1, qf[qi][1], s1, 0, 0, 0);
                    if (ti == 0 || ti == 2) {
                        const int base = base0 - sg * 16 * qi;
#pragma unroll
                        for (int r = 0; r < 4; ++r) { const int l0 = -sg * (32 * ks + r), l1 = -sg * (32 * ks + 16 + r); s0[r] = (base < l0) ? -1e30f : s0[r]; s1[r] = (base < l1) ? -1e30f : s1[r]; } }
#pragma unroll
                    for (int r = 0; r < 4; ++r) { s0[r] = __builtin_amdgcn_exp2f(s0[r]); s1[r] = __builtin_amdgcn_exp2f(s1[r]); psum[qi] += s0[r] + s1[r]; }
                    u32x4 pw; pw.x = cvtpk(s0[0], s0[1]); pw.y = cvtpk(s0[2], s0[3]); pw.z = cvtpk(s1[0], s1[1]); pw.w = cvtpk(s1[2], s1[3]);
                    pf[qi] = __builtin_bit_cast(bf16x8, pw);
                }
#pragma unroll
                for (int df = 0; df < 4; ++df) { const LAS unsigned char* vp = vbase + (ks * 32) * RS + df * 32;
                    const bf16x8 vf = cat8(lds_tr(vp), lds_tr(vp + 16 * RS));
                    O[df][0] = __builtin_amdgcn_mfma_f32_16x16x32_bf16(vf, pf[0], O[df][0], 0, 0, 0);
                    O[df][1] = __builtin_amdgcn_mfma_f32_16x16x32_bf16(vf, pf[1], O[df][1], 0, 0, 0); }
            }
        }
        } else {
#pragma unroll
        for (int ks = 0; ks < 4; ++ks) {
            {
                const LAS unsigned char* kp = Ks + (32 * ks + c) * RS + 16 * g;
                const bf16x8 ka0 = *(const LAS bf16x8*)kp, ka1 = *(const LAS bf16x8*)(kp + 64), kb0 = *(const LAS bf16x8*)(kp + 16 * RS), kb1 = *(const LAS bf16x8*)(kp + 16 * RS + 64);
                bf16x8 pf[2];
#pragma unroll
                for (int qi = 0; qi < 2; ++qi) {
                    f32x4 s0 = __builtin_amdgcn_mfma_f32_16x16x32_bf16(ka0, qf[qi][0], negm, 0, 0, 0);
                    s0 = __builtin_amdgcn_mfma_f32_16x16x32_bf16(ka1, qf[qi][1], s0, 0, 0, 0);
                    f32x4 s1 = __builtin_amdgcn_mfma_f32_16x16x32_bf16(kb0, qf[qi][0], negm, 0, 0, 0);
                    s1 = __builtin_amdgcn_mfma_f32_16x16x32_bf16(kb1, qf[qi][1], s1, 0, 0, 0);
#pragma unroll
                    for (int r = 0; r < 4; ++r) { s0[r] = __builtin_amdgcn_exp2f(s0[r]); s1[r] = __builtin_amdgcn_exp2f(s1[r]); psum[qi] += s0[r] + s1[r]; }
                    u32x4 pw; pw.x = cvtpk(s0[0], s0[1]); pw.y = cvtpk(s0[2], s0[3]); pw.z = cvtpk(s1[0], s1[1]); pw.w = cvtpk(s1[2], s1[3]);
                    pf[qi] = __builtin_bit_cast(bf16x8, pw);
                }
#pragma unroll
                for (int df = 0; df < 4; ++df) { const LAS unsigned char* vp = vbase + (ks * 32) * RS + df * 32;
                    const bf16x8 vf = cat8(lds_tr(vp), lds_tr(vp + 16 * RS));
                    O[df][0] = __builtin_amdgcn_mfma_f32_16x16x32_bf16(vf, pf[0], O[df][0], 0, 0, 0);
                    O[df][1] = __builtin_amdgcn_mfma_f32_16x16x32_bf16(vf, pf[1], O[df][1], 0, 0, 0); }
            }
        }
        }
        l_run[0] += psum[0]; l_run[1] += psum[1];
        ti = tn;
    }
#undef ATT_KROW
#undef ATT_PRELOAD
#pragma unroll
    for (int qi = 0; qi < 2; ++qi) { float lt = l_run[qi]; lt += __shfl_xor(lt, 16); lt += __shfl_xor(lt, 32); const float inv = 1.f / lt;
        const size_t row = (size_t)(qrow0 + qq * 32 + 16 * qi + c);
#pragma unroll
        for (int df = 0; df < 4; ++df) mul_store4z(Z + row * 1024 + 512 + (kvh * 4 + gq) * 64 + 16 * df + 4 * g, O[df][qi] * inv, zreg[qi][df], dry); }
}

__device__ __forceinline__ void f1_item(LAS unsigned char* lds, const bf16_t* Gb, bf16_t* Afft, const bf16_t* t128, int b, int l2, int tid, int lane, int wave) {
    constexpr int RS = 528;
    const int g = lane >> 4, c = lane & 15;
    __syncthreads();
#pragma unroll
    for (int it = 0; it < 16; ++it) { const int id = it * 512 + tid, row = id >> 5, c16 = id & 31, pp = row >> 7, l1 = row & 127;
        *(LAS u32x4*)(lds + row * RS + c16 * 16) = *(const u32x4*)(Gb + (size_t)(b * SEQ + 64 * l1 + l2) * 512 + pp * 256 + c16 * 8); }
    bf16x8 tb[8][2];
    { const bf16_t* tp = t128 + (size_t)(32 * wave + c) * 256 + 8 * g;
#pragma unroll
      for (int ks = 0; ks < 8; ++ks)
#pragma unroll
          for (int j = 0; j < 2; ++j) tb[ks][j] = *(const bf16x8*)(tp + (size_t)j * 16 * 256 + ks * 32); }
    __syncthreads();
    const LAS unsigned char* abase = lds + (8 * g + (c >> 2)) * RS + (4 * (c & 3)) * 2;
    const int part = wave >> 2;
#pragma unroll 1
    for (int cq = 0; cq < 4; ++cq) {
        f32x4 acc[4][2]; zero_acc<4, 2>(acc);
#pragma unroll
        for (int ks = 0; ks < 8; ++ks) {
            bf16x8 a[4];
#pragma unroll
            for (int i = 0; i < 4; ++i) { const LAS unsigned char* ap = abase + ks * 32 * RS + (cq * 64 + 16 * i) * 2; a[i] = cat8(lds_tr(ap), lds_tr(ap + 4 * RS)); }
#pragma unroll
            for (int i = 0; i < 4; ++i)
#pragma unroll
                for (int j = 0; j < 2; ++j) acc[i][j] = __builtin_amdgcn_mfma_f32_16x16x32_bf16(a[i], tb[ks][j], acc[i][j], 0, 0, 0);
        }
#pragma unroll
        for (int j = 0; j < 2; ++j) { const int k1 = (wave & 3) * 32 + 16 * j + c; const size_t arow = ((size_t)(b * 128 + k1) * 64 + l2) * 2 + part;
#pragma unroll
            for (int i = 0; i < 4; ++i) { const unsigned long long o = (unsigned long long)cvtpk(acc[i][j][0], acc[i][j][1]) | ((unsigned long long)cvtpk(acc[i][j][2], acc[i][j][3]) << 32);
                __hip_atomic_store((unsigned long long*)(Afft + arow * 256 + cq * 64 + 16 * i + 4 * g), o, __ATOMIC_RELAXED, __HIP_MEMORY_SCOPE_AGENT); } }
    }
}
__device__ __forceinline__ void sgu_item(LAS unsigned char* lds, const bf16_t* Ub, bf16_t* Z, const bf16_t* sguw, const float* sgub, int ci, int tid, int lane, int wave, bool dry = false) {
    constexpr int RS = 528;
    const int row0 = ci * 128;
    const int grp = wave >> 1, sh = wave & 1, g = lane >> 4, c = lane & 15;
    const int t = tid >> 2, qd = tid & 3; const bf16_t* vp = Ub + (size_t)(row0 + t) * 512 + 256 + qd * 64;
    u32x4 w[8];
#pragma unroll
    for (int i = 0; i < 8; ++i) w[i] = *(const u32x4*)(vp + 8 * i);
    bf16x8 b0[4][4];
    ag_load<4, 4>(b0, sguw + (size_t)grp * 16384 + (size_t)(sh * 64 + c) * 128 + 8 * g, 128, 0);
    u32x2 uw[4][4], zw[4][4];
#pragma unroll
    for (int j = 0; j < 4; ++j) { const size_t row = (size_t)(row0 + sh * 64 + 16 * j + c);
#pragma unroll
        for (int i = 0; i < 4; ++i) { const int col = grp * 64 + 16 * i + 4 * g; uw[i][j] = *(const u32x2*)(Ub + row * 512 + col); zw[i][j] = *(const u32x2*)(Z + row * 1024 + 256 + col); } }
    __syncthreads();
    { float ss = 0.f;
#pragma unroll
      for (int i = 0; i < 8; ++i) {
          const float a0 = bflo(w[i].x), a1 = bfhi(w[i].x), a2 = bflo(w[i].y), a3 = bfhi(w[i].y), a4 = bflo(w[i].z), a5 = bfhi(w[i].z), a6 = bflo(w[i].w), a7 = bfhi(w[i].w);
          ss += (a0 * a0 + a1 * a1) + (a2 * a2 + a3 * a3) + (a4 * a4 + a5 * a5) + (a6 * a6 + a7 * a7); }
      ss += __shfl_xor(ss, 1); ss += __shfl_xor(ss, 2);
      const float rinv = rsqrtf(ss * (1.f / 256.f) + EPSV);
#pragma unroll
      for (int i = 0; i < 8; ++i) { u32x4 o; o.x = cvtpk(bflo(w[i].x) * rinv, bfhi(w[i].x) * rinv); o.y = cvtpk(bflo(w[i].y) * rinv, bfhi(w[i].y) * rinv); o.z = cvtpk(bflo(w[i].z) * rinv, bfhi(w[i].z) * rinv); o.w = cvtpk(bflo(w[i].w) * rinv, bfhi(w[i].w) * rinv);
          *(LAS u32x4*)(lds + t * RS + qd * 128 + i * 16) = o; } }
    __syncthreads();
    f32x4 acc[4][4]; zero_acc<4, 4>(acc);
    ag_mma<4, 4, 4>(acc, b0, lds + (8 * g + (c >> 2)) * RS + (grp * 64 + 4 * (c & 3)) * 2, RS, 0);
#pragma unroll
    for (int j = 0; j < 4; ++j) { const int s_ = sh * 64 + 16 * j + c; const float bias = sgub[grp * 128 + s_]; const size_t row = (size_t)(row0 + s_);
#pragma unroll
        for (int i = 0; i < 4; ++i) { const int col = grp * 64 + 16 * i + 4 * g; const u32x2 u2 = uw[i][j];
            f32x4 v = acc[i][j]; v[0] = (v[0] + bias) * bflo(u2.x); v[1] = (v[1] + bias) * bfhi(u2.x); v[2] = (v[2] + bias) * bflo(u2.y); v[3] = (v[3] + bias) * bfhi(u2.y);
            mul_store4z(Z + row * 1024 + 256 + col, v, zw[i][j], dry); } }
}
__device__ __forceinline__ void f3_wave_item(LAS unsigned char* ldsw, const bf16_t* Afft, bf16_t* Z, const bf16_t* t3, int wi, int lane, bool dry) {
    constexpr int RS = 80;
    const int b = wi >> 10, k1 = (wi >> 3) & 127, ch0 = (wi & 7) * 32;
    const bf16_t* src = Afft + (size_t)(b * 128 + k1) * 128 * 256 + ch0;
    u32x4 v[8];
#pragma unroll
    for (int it = 0; it < 8; ++it) { const int id = it * 64 + lane; v[it] = *(const u32x4*)(src + (size_t)(id >> 2) * 256 + (id & 3) * 8); }
#pragma unroll
    for (int it = 0; it < 8; ++it) { const int id = it * 64 + lane; *(LAS u32x4*)(ldsw + (id >> 2) * RS + (id & 3) * 16) = v[it]; }
    asm volatile("s_waitcnt lgkmcnt(0)" ::: "memory");
    const int g = lane >> 4, c = lane & 15;
    f32x4 acc[2][4]; zero_acc<2, 4>(acc);
    act_gemm<2, 4, 4, 4>(acc, ldsw, RS, 0, t3 + (size_t)k1 * 64 * 128, 128, lane);
#pragma unroll
    for (int j = 0; j < 4; ++j) { const int k2 = 16 * j + c; const size_t row = (size_t)b * SEQ + k1 + 128 * k2;
#pragma unroll
        for (int i = 0; i < 2; ++i) mul_store4(Z + row * 1024 + ch0 + 16 * i + 4 * g, acc[i][j], dry); }
    asm volatile("" ::: "memory");
}
__device__ __forceinline__ void fc_item(LAS unsigned char* lds, const bf16_t* Gb, bf16_t* Z, const bf16_t* tc, int item, int tid, int lane, int wave, bool dry = false) {
    constexpr int RS = 144;
    const int b = item >> 3, chq = (item >> 1) & 3, kh = item & 1;
    u32x4 v[8];
#pragma unroll
    for (int it = 0; it < 8; ++it) { const int id = it * 512 + tid, row = id >> 3, c16 = id & 7, part = row >> 8, ll = row & 255;
        v[it] = *(const u32x4*)(Gb + (size_t)(ML + b * 256 + ll) * 512 + part * 256 + chq * 64 + c16 * 8); }
    __syncthreads();
#pragma unroll
    for (int it = 0; it < 8; ++it) { const int id = it * 512 + tid; *(LAS u32x4*)(lds + (id >> 3) * RS + (id & 7) * 16) = v[it]; }
    __syncthreads();
    const int g = lane >> 4, c = lane & 15, kk0 = kh * 128 + (wave >> 2) * 64;
    f32x4 acc[1][4]; zero_acc<1, 4>(acc);
    act_gemm<1, 4, 16, 4>(acc, lds, RS, 16 * (wave & 3), tc + (size_t)kk0 * 512, 512, lane);
#pragma unroll
    for (int j = 0; j < 4; ++j) { const size_t row = (size_t)(ML + b * 256 + kk0 + 16 * j + c); mul_store4(Z + row * 1024 + chq * 64 + 16 * (wave & 3) + 4 * g, acc[0][j], dry); }
}

__device__ __forceinline__ void ctx_merge_tile(const bf16_t* Y, const unsigned char* GT, bf16_t* MG, const unsigned char* wsW, int tile, int lane, int wave) {
    const int m = ML + 64 * (tile >> 4) + 16 * (wave >> 1) + (lane & 15), nb = 64 * (tile & 15) + 32 * (wave & 1), g = lane >> 4, c = lane & 15;
    f32x4 mg[2] = {(f32x4){0.f, 0.f, 0.f, 0.f}, (f32x4){0.f, 0.f, 0.f, 0.f}};
#pragma unroll
    for (int seg = 0; seg < 3; ++seg) {
        const int Kseg = seg == 2 ? 512 : 256;
        const bf16_t* Wt = (const bf16_t*)(wsW + W_PA_OFF) + seg * 256;
        const bf16_t* yp = Y + (size_t)m * 1024 + seg * 256 + 8 * g;
        const bf16_t* wp = Wt + (size_t)(nb + c) * 1024 + 8 * g;
        f32x4 acc[2] = {(f32x4){0.f, 0.f, 0.f, 0.f}, (f32x4){0.f, 0.f, 0.f, 0.f}};
#pragma unroll 8
        for (int ks = 0; ks < Kseg / 32; ++ks) {
            const bf16x8 yf = *(const bf16x8*)(yp + ks * 32);
#pragma unroll
            for (int j = 0; j < 2; ++j) { const bf16x8 wf = *(const bf16x8*)(wp + (size_t)j * 16 * 1024 + ks * 32); acc[j] = __builtin_amdgcn_mfma_f32_16x16x32_bf16(wf, yf, acc[j], 0, 0, 0); }
        }
#pragma unroll
        for (int j = 0; j < 2; ++j) { const unsigned gw = *(const unsigned*)(GT + (size_t)m * 3072 + seg * 1024 + nb + 16 * j + 4 * g);
            mg[j][0] += acc[j][0] * ub0(gw) * (1.f / 255.f); mg[j][1] += acc[j][1] * ub1(gw) * (1.f / 255.f); mg[j][2] += acc[j][2] * ub2(gw) * (1.f / 255.f); mg[j][3] += acc[j][3] * ub3(gw) * (1.f / 255.f); }
    }
#pragma unroll
    for (int j = 0; j < 2; ++j) { u32x2 o; o.x = cvtpk(mg[j][0], mg[j][1]); o.y = cvtpk(mg[j][2], mg[j][3]); *(u32x2*)(MG + (size_t)m * 1024 + nb + 16 * j + 4 * g) = o; }
}
__device__ __forceinline__ void ctx_out_tile(const bf16_t* MG, const bf16_t* WoT, const float* csrc, float* cdst, const float* gate_c, int tile, int lane, int wave) {
    const int mr = 64 * (tile >> 4) + 16 * (wave >> 1) + (lane & 15), nb = 64 * (tile & 15) + 32 * (wave & 1), g = lane >> 4, c = lane & 15;
    const bf16_t* ap = MG + (size_t)(ML + mr) * 1024 + 8 * g;
    const bf16_t* wp = WoT + (size_t)(nb + c) * 1024 + 8 * g;
    f32x4 acc[2] = {(f32x4){0.f, 0.f, 0.f, 0.f}, (f32x4){0.f, 0.f, 0.f, 0.f}};
#pragma unroll 8
    for (int ks = 0; ks < 32; ++ks) {
        const bf16x8 yf = *(const bf16x8*)(ap + ks * 32);
#pragma unroll
        for (int j = 0; j < 2; ++j) { const bf16x8 wf = *(const bf16x8*)(wp + (size_t)j * 16 * 1024 + ks * 32); acc[j] = __builtin_amdgcn_mfma_f32_16x16x32_bf16(wf, yf, acc[j], 0, 0, 0); }
    }
#pragma unroll
    for (int j = 0; j < 2; ++j) { const int n = nb + 16 * j + 4 * g; const f32x4 gt = *(const f32x4*)(gate_c + n); const f32x4 xs = *(const f32x4*)(csrc + (size_t)mr * DM + n);
        *(f32x4*)(cdst + (size_t)mr * DM + n) = xs + gt * acc[j]; }
}

#define XB_TMO      128
#define XB_XCNT(j)  (256  + 64 * (j))
#define XB_XSUB(j)  (1280 + 64 * (j))
#define XB_XGEN(j)  (2304 + 64 * (j))
#define XB_TOP      3328
#define XB_TOPGEN   3392
#define XCD_BAR_WORDS 3456
#define XB_SPIN_CAP (1u << 18)
__device__ __forceinline__ unsigned xb_ld(unsigned* p)              { return __hip_atomic_load(p, __ATOMIC_RELAXED, __HIP_MEMORY_SCOPE_AGENT); }
__device__ __forceinline__ unsigned xb_add(unsigned* p, unsigned v) { return __hip_atomic_fetch_add(p, v, __ATOMIC_RELAXED, __HIP_MEMORY_SCOPE_AGENT); }
__device__ __forceinline__ unsigned xb_xcc_id() { return (unsigned)__builtin_amdgcn_s_getreg((3 << 11) | 20) & 0xFu; }
#define XB_SPIN(cond, bar) do { unsigned _sp = 0; while (cond) { __builtin_amdgcn_s_sleep(1); \
    if ((++_sp & 255u) == 0u) { if (xb_ld(&(bar)[XB_TMO])) break; if (_sp > XB_SPIN_CAP) { atomicAdd(&(bar)[XB_TMO], 1u); break; } } } } while (0)
struct XcdBarrier { unsigned* bar; unsigned x; volatile LAS unsigned* st; };
__device__ __forceinline__ XcdBarrier xcd_barrier_post(unsigned* bar, volatile LAS unsigned* st) {
    XcdBarrier b; b.bar = bar; b.x = xb_xcc_id(); b.st = st;
    if (threadIdx.x == 0) (void)xb_add(&bar[XB_XCNT(b.x)], 1u);
    return b;
}
__device__ __forceinline__ void xcd_barrier_complete(unsigned* bar, unsigned x, unsigned& nloc, unsigned& nx) {
    const unsigned G = gridDim.x * gridDim.y * gridDim.z;
    unsigned sum, cnt, mine, sp = 0u;
    for (;;) {
        sum = 0u; cnt = 0u; mine = 0u;
#pragma unroll
        for (unsigned j = 0; j < 16; ++j) { const unsigned c = xb_ld(&bar[XB_XCNT(j)]); sum += c; cnt += (c > 0u) ? 1u : 0u; mine = (j == x) ? c : mine; }
        if (sum == G) break;
        __builtin_amdgcn_s_sleep(1);
        if ((++sp & 255u) == 0u) { if (xb_ld(&bar[XB_TMO])) break; if (sp > XB_SPIN_CAP) { atomicAdd(&bar[XB_TMO], 1u); break; } }
    }
    nloc = mine > 0u ? mine : 1u; nx = cnt > 0u ? cnt : 1u;
}
__device__ __forceinline__ void xcd_barrier(const XcdBarrier& b) {
    asm volatile("s_waitcnt vmcnt(0)" ::: "memory");
    __syncthreads();
    if (threadIdx.x == 0) {
        unsigned bz_ = 0u, bx = b.x;
        asm volatile("" : "+s"(bz_), "+s"(bx)); unsigned* bar = b.bar + bz_;
        __builtin_amdgcn_s_waitcnt(0);
        unsigned nloc = b.st[0], nx = b.st[1];
        if (nloc == 0u) { xcd_barrier_complete(bar, bx, nloc, nx); b.st[0] = nloc; b.st[1] = nx; }
        const unsigned old = xb_add(&bar[XB_XSUB(bx)], 1u);
        const unsigned gen = old / nloc;
        if (old + 1u == (gen + 1u) * nloc) {
            __builtin_amdgcn_fence(__ATOMIC_RELEASE, "agent");
            asm volatile("s_waitcnt vmcnt(0)" ::: "memory");
            const unsigned og = xb_add(&bar[XB_TOP], 1u);
            const unsigned tg = og / nx;
            if (og + 1u == (tg + 1u) * nx) xb_add(&bar[XB_TOPGEN], 1u);
            else XB_SPIN(xb_ld(&bar[XB_TOPGEN]) == tg, bar);
            __builtin_amdgcn_fence(__ATOMIC_ACQUIRE, "agent");
            xb_add(&bar[XB_XGEN(bx)], 1u);
            asm volatile("s_waitcnt vmcnt(0)" ::: "memory");
        } else {
            XB_SPIN(xb_ld(&bar[XB_XGEN(bx)]) == gen, bar);
            __builtin_amdgcn_fence(__ATOMIC_ACQUIRE, "agent");
            asm volatile("s_waitcnt vmcnt(0)" ::: "memory");
        }
    }
    __syncthreads();
}

#define PHASE_IDS() int t__ = threadIdx.x, b__ = blockIdx.x, g__ = gridDim.x; asm volatile("" : "+v"(t__)); asm volatile("" : "+s"(b__), "+s"(g__)); \
    size_t wz_ = 0; asm volatile("" : "+s"(wz_)); unsigned char* ws = p.ws + wz_;     \
    const int tid = t__, lane = tid & 63, wave = __builtin_amdgcn_readfirstlane(tid >> 6), bid = b__, G = g__; (void)lane; (void)wave; (void)bid; (void)G
__global__ void __launch_bounds__(512, 2) fwd_megakernel(Params p) {
    extern __shared__ __attribute__((aligned(16))) unsigned char lds_raw[];
    LAS unsigned char* lds = (LAS unsigned char*)lds_raw;
    cg::grid_group grid = cg::this_grid();
    volatile LAS unsigned* bst = (volatile LAS unsigned*)(lds + LDS_BYTES - 16);
    if (threadIdx.x < 4) bst[threadIdx.x] = 0u;
    __syncthreads();
    const XcdBarrier xbar = xcd_barrier_post((unsigned*)(p.ws + WS_BAR), bst);
    unsigned long long tacc_ = 0ull, t0_ = 0ull; (void)t0_; (void)tacc_;
#define TS_BEGIN(k) do { if (PROBE_TS == (k)) t0_ = __builtin_amdgcn_s_memrealtime(); } while (0)
#define TS_END(k) do { if (PROBE_TS == (k)) tacc_ += __builtin_amdgcn_s_memrealtime() - t0_; } while (0)
#define GSYNC() do { TS_BEGIN(7); xcd_barrier(xbar); if (PROBE_DUP == 7) xcd_barrier(xbar); TS_END(7); } while (0)
    const unsigned long long tstart_ = (PROBE_TS == 8) ? __builtin_amdgcn_s_memrealtime() : 0ull; (void)tstart_;
    TS_BEGIN(9);
#ifndef SKIP_P0
    { PHASE_IDS(); phase0(p, lds, tid, bid, G); __syncthreads(); conv_weights(p, lds, 0, tid, lane, wave, bid, G); }
#endif
    TS_END(9);
    grid.sync();
#pragma unroll 1
    for (int l = 0; l < DEPTH; ++l) {
        const bool last = (l == DEPTH - 1);
        TS_BEGIN(1);
#ifndef SKIP_P1
        for (int rep = (PROBE_DUP == 1 ? 0 : 1); rep < 2; ++rep) { PHASE_IDS(); h_rows(p, l, lane, wave, bid, G); }
#endif
        TS_END(1);
        GSYNC();
        TS_BEGIN(2);
#ifndef SKIP_P2
#pragma unroll 1
        for (int rep = (PROBE_DUP == 2 ? 0 : 1); rep < 2; ++rep) { PHASE_IDS();
          pg8::Gemm g{(const bf16_t*)(ws + WS_H), (const bf16_t*)(ws + ((l & 1) ? WS_W1 : WS_W) + W_IN_OFF), MT, NIN, 1024, 1024}; pg8::StaticOrder S; S.init(MT, NIN, G, bid);
          pg8::EpiProj E{(bf16_t*)(ws + WS_G), (bf16_t*)(ws + WS_Z), (bf16_t*)(ws + WS_U), (bf16_t*)(ws + WS_QKV), (bf16_t*)(ws + WS_GT), (const float*)(ws + WS_ROPE), p.in[9] + l * 64, p.in[10] + l * 64};
          pg8::gemm_phase<pg8::EpiProj>(lds, g, S, E, tid); }
#endif
        TS_END(2);
        GSYNC();
        TS_BEGIN(3);
#ifndef SKIP_P3
#pragma unroll 1
        for (int rep = 1; rep < 2; ++rep) { PHASE_IDS(); const bool dry = false;
          bf16_t* Zb = (bf16_t*)(ws + WS_Z); const bf16_t* QKVb = (const bf16_t*)(ws + WS_QKV);
          const int n_attn = last ? 1024 : 1056, n_f1 = 256, n_sgu = last ? 256 : 264, total = n_attn + n_f1 + n_sgu;
          const float* sinkl = p.in[11] + l * 8; const float* sgub = p.in[8] + l * 512; const float m0 = ((const float*)(ws + WS_ROPE + 131072))[l];
          unsigned* f1cnt = (unsigned*)(ws + WS_BAR) + 3584 + 64 * (l * 4);
          for (int item = bid; item < total; item += G) {
              int tid = t__; asm volatile("" : "+v"(tid)); const int lane = tid & 63;
              if (item < n_f1) { f1_item(lds, (const bf16_t*)(ws + WS_G), (bf16_t*)(ws + WS_H), (const bf16_t*)(ws + WS_T128), item >> 6, item & 63, tid, lane, wave);
                                 asm volatile("s_waitcnt vmcnt(0)" ::: "memory"); __syncthreads();
                                 if (tid == 0) __hip_atomic_fetch_add(f1cnt + 64 * (item >> 6), 1u, __ATOMIC_RELAXED, __HIP_MEMORY_SCOPE_AGENT); }
              else if (item < n_f1 + n_attn) { const int ia = item - n_f1; const bool ic = ia >= 1024; const int i2 = ia - 1024;
                                   attn_item(lds, QKVb, Zb, sinkl, m0, ic ? (i2 >> 3) : (ia >> 8), ic ? ((i2 >> 2) & 1) : ((ia >> 2) & 63), (ia >> 1) & 1, ia & 1, ic, tid, lane, wave, dry); }
              else { sgu_item(lds, (const bf16_t*)(ws + WS_U), Zb, (const bf16_t*)(ws + WS_SGUW), sgub, item - n_attn - n_f1, tid, lane, wave, dry); }
          }
          if (rep == 1) {
              __syncthreads();
              if (tid == 0) { unsigned sp = 0;
                  while (__hip_atomic_load(f1cnt, __ATOMIC_RELAXED, __HIP_MEMORY_SCOPE_AGENT) < 64u || __hip_atomic_load(f1cnt + 64, __ATOMIC_RELAXED, __HIP_MEMORY_SCOPE_AGENT) < 64u ||
                         __hip_atomic_load(f1cnt + 128, __ATOMIC_RELAXED, __HIP_MEMORY_SCOPE_AGENT) < 64u || __hip_atomic_load(f1cnt + 192, __ATOMIC_RELAXED, __HIP_MEMORY_SCOPE_AGENT) < 64u) {
                      __builtin_amdgcn_s_sleep(2); if (++sp > (1u << 20)) break; } }
              __syncthreads();
              __builtin_amdgcn_fence(__ATOMIC_ACQUIRE, "agent");
              asm volatile("s_waitcnt vmcnt(0)" ::: "memory");
              for (int wi = bid * 8 + wave; wi < 4096; wi += G * 8) f3_wave_item(lds + wave * 10240, (const bf16_t*)(ws + WS_H), Zb, (const bf16_t*)(ws + WS_T3), wi, lane, false);
              if (!last) { for (int item = (bid + G - 64 % G) % G; item < 32; item += G) fc_item(lds, (const bf16_t*)(ws + WS_G), Zb, (const bf16_t*)(ws + WS_TC), item, tid, lane, wave, false); }
              if (!last) { __syncthreads(); conv_weights(p, lds, l + 1, tid, lane, wave, bid, G); }
          }
        }
#endif
        TS_END(3);
        GSYNC();
        TS_BEGIN(5);
#ifndef SKIP_P5
        if (!last) { PHASE_IDS(); if (((bid >> 3) & 1) == 0) {
          for (int t = bid; t < 256; t += G) ctx_merge_tile((const bf16_t*)(ws + WS_Z), (const unsigned char*)(ws + WS_GT), (bf16_t*)(ws + WS_H), ws + ((l & 1) ? WS_W1 : WS_W), t, lane, wave); } }
#pragma unroll 1
        for (int rep = (PROBE_DUP == 5 ? 0 : 1); rep < 2; ++rep) { PHASE_IDS();
          pg8::StaticOrder S; S.init(ML, 1024, G, bid);
          pg8::Gemm g{(const bf16_t*)(ws + WS_Z), (const bf16_t*)(ws + ((l & 1) ? WS_W1 : WS_W) + W_PA_OFF), ML, 1024, 1024, 1024};
          pg8::EpiMerge E{(const unsigned char*)(ws + WS_GT), (bf16_t*)(ws + WS_H)};
          pg8::gemm_phase<pg8::EpiMerge, true>(lds, g, S, E, tid); }
        if (!last) { PHASE_IDS(); if (((bid >> 3) & 1) != 0) {
          for (int t = bid; t < 256; t += G) ctx_merge_tile((const bf16_t*)(ws + WS_Z), (const unsigned char*)(ws + WS_GT), (bf16_t*)(ws + WS_H), ws + ((l & 1) ? WS_W1 : WS_W), t, lane, wave); } }
#endif
        TS_END(5);
        GSYNC();
        TS_BEGIN(6);
#ifndef SKIP_P6
#pragma unroll 1
        for (int rep = (PROBE_DUP == 6 ? 0 : 1); rep < 2; ++rep) { PHASE_IDS();
          const int Mrows = ML; pg8::StaticOrder S; S.init(Mrows, 1024, G, bid);
          pg8::Gemm g{(const bf16_t*)(ws + WS_H), (const bf16_t*)(ws + ((l & 1) ? WS_W1 : WS_W) + W_OUT_OFF), Mrows, 1024, 1024, 1024};
          float* XC = (float*)(ws + WS_XC);
          if (!last && rep == 1 && ((bid >> 3) & 1) == 0) { for (int t = bid; t < 256; t += G) ctx_out_tile((const bf16_t*)(ws + WS_H), (const bf16_t*)(ws + ((l & 1) ? WS_W1 : WS_W) + W_OUT_OFF), l == 0 ? p.in[2] : XC, XC, (const float*)(ws + WS_MOD) + (size_t)(l * 5 + 4) * 3072 + 2048, t, lane, wave); }
          pg8::EpiRes E{l == 0 ? p.in[0] : p.out, p.out, l == 0 ? p.in[2] : XC, XC, rep == 0 ? (const float*)(ws + WS_ROPE + 65536) : (const float*)(ws + WS_MOD) + (size_t)l * 5 * 3072};
          pg8::gemm_phase<pg8::EpiRes>(lds, g, S, E, tid);
          if (!last && rep == 1 && ((bid >> 3) & 1) != 0) { for (int t = bid; t < 256; t += G) ctx_out_tile((const bf16_t*)(ws + WS_H), (const bf16_t*)(ws + ((l & 1) ? WS_W1 : WS_W) + W_OUT_OFF), l == 0 ? p.in[2] : XC, XC, (const float*)(ws + WS_MOD) + (size_t)(l * 5 + 4) * 3072 + 2048, t, lane, wave); } }
#endif
        TS_END(6);
        if (!last) GSYNC();
    }
    if (PROBE_TS != 0) {
        if (PROBE_TS == 8) tacc_ = __builtin_amdgcn_s_memrealtime() - tstart_;
        xcd_barrier(xbar);
        if (blockIdx.x == 0 && threadIdx.x == 0) p.out[0] += 0.3f + (float)tacc_ * (0.01f / PROBE_SCALE);
    }
}

extern "C" void kernel_launch(void* const* d_in, const int* in_sizes, int n_in, void* d_out, int out_size, void* d_ws, size_t ws_size, hipStream_t stream) {
    static int grid = 0;
    if (grid == 0) {
        if (n_in != 16 || ws_size < WS_END) { fprintf(stderr, "kernel_launch: unexpected inputs (n_in %d, ws %zu)\n", n_in, ws_size); grid = -1; return; }
        int dev = 0, cus = 0, per_cu = 0;
        hipGetDevice(&dev);
        hipDeviceGetAttribute(&cus, hipDeviceAttributeMultiprocessorCount, dev);
        hipFuncSetAttribute((const void*)fwd_megakernel, hipFuncAttributeMaxDynamicSharedMemorySize, LDS_BYTES);
        hipOccupancyMaxActiveBlocksPerMultiprocessor(&per_cu, (const void*)fwd_megakernel, 512, LDS_BYTES);
        if (per_cu < 1 || cus < 1) { fprintf(stderr, "kernel_launch: occupancy query gave %d blocks/CU on %d CUs\n", per_cu, cus); grid = -1; return; }
        grid = cus;
    }
    if (grid < 0) return;
    if (hipMemsetAsync((char*)d_ws + WS_BAR, 0, 20480, stream) != hipSuccess) { fprintf(stderr, "kernel_launch: memset of barrier words failed\n"); return; }
    Params p{};
    for (int i = 0; i < 16; ++i) p.in[i] = (const float*)d_in[i];
    p.out = (float*)d_out; p.ws = (unsigned char*)d_ws;
    void* args[] = {&p};
    hipError_t e = hipLaunchCooperativeKernel((const void*)fwd_megakernel, dim3(grid), dim3(512), args, LDS_BYTES, stream);
    if (e != hipSuccess) fprintf(stderr, "cooperative launch failed: %s (grid %d)\n", hipGetErrorString(e), grid);
}
```

```cpp
#include <hip/hip_runtime.h>
#include <hip/hip_cooperative_groups.h>
#include <cstdio>
#include <cstdint>
namespace cg = cooperative_groups;

#define LAS __attribute__((address_space(3)))
typedef unsigned short bf16_t;
typedef short bf16x8 __attribute__((ext_vector_type(8)));
typedef short s16x4 __attribute__((ext_vector_type(4)));
typedef float f32x4 __attribute__((ext_vector_type(4)));
typedef unsigned u32x4 __attribute__((ext_vector_type(4)));
typedef unsigned u32x2 __attribute__((ext_vector_type(2)));
typedef float f32x2_t __attribute__((ext_vector_type(2)));
typedef __bf16 bf16x2_t __attribute__((ext_vector_type(2)));

constexpr int DM = 1024, NB = 4, SEQ = 8192, DEPTH = 4, CTXL = 256;
constexpr int ML = NB * SEQ;
constexpr int MC = NB * CTXL;
constexpr int MT = ML + MC;
constexpr int INW = 5632;
constexpr int NIN = 5888;
constexpr float EPSV = 1e-6f;
constexpr float LOG2E = 1.4426950408889634f;

constexpr size_t MiB = 1u << 20;
constexpr size_t WS_MOD = 0;
constexpr size_t WS_ROPE = 256 * 1024;
constexpr size_t WS_T128 = 512 * 1024;
constexpr size_t WS_TC = 1 * MiB;
constexpr size_t WS_T3 = 2 * MiB;
constexpr size_t WS_SGUW = 4 * MiB;
constexpr size_t WS_BAR = 6 * MiB;
constexpr size_t WS_XC = 8 * MiB;
constexpr size_t WS_W = 16 * MiB;
constexpr size_t W_IN_OFF = 0, W_PA_OFF = (size_t)NIN * 1024 * 2, W_PB_OFF = W_PA_OFF + 1024 * 256 * 2, W_PC_OFF = W_PB_OFF + 1024 * 256 * 2, W_OUT_OFF = W_PC_OFF + 1024 * 512 * 2;
constexpr size_t WS_H = 32 * MiB;
constexpr size_t WS_G = 98 * MiB;
constexpr size_t WS_Z = 131 * MiB;
constexpr size_t WS_U = 197 * MiB;
constexpr size_t WS_QKV = 230 * MiB;
constexpr size_t WS_GT = 280 * MiB;
constexpr size_t WS_W1 = 478 * MiB;
constexpr size_t WS_END = 494 * MiB;
static_assert(W_OUT_OFF + 1024 * 1024 * 2 <= 16 * MiB, "weights fit");

constexpr int LDS_BYTES = 147456;
#ifndef PROBE_TS
#define PROBE_TS 0
#endif
#ifndef PROBE_SCALE
#define PROBE_SCALE 1000.f
#endif
#ifndef PROBE_DUP
#define PROBE_DUP 0
#endif

__device__ __forceinline__ unsigned cvtpk(float lo, float hi) { f32x2_t v = {lo, hi}; bf16x2_t b = __builtin_convertvector(v, bf16x2_t); return __builtin_bit_cast(unsigned, b); }
__device__ __forceinline__ float bflo(unsigned w) { return __uint_as_float(w << 16); }
__device__ __forceinline__ float bfhi(unsigned w) { return __uint_as_float(w & 0xffff0000u); }
__device__ __forceinline__ float silu_f(float v) { return v * __builtin_amdgcn_rcpf(1.f + __expf(-v)); }
__device__ __forceinline__ float sigm_f(float v) { return __builtin_amdgcn_rcpf(1.f + __expf(-v)); }
__device__ __forceinline__ unsigned pack4q(f32x4 v) {
    unsigned w = 0u;
    w = __builtin_amdgcn_cvt_pk_u8_f32(fmaxf(v[0] * 255.f, 1.f), 0u, w); w = __builtin_amdgcn_cvt_pk_u8_f32(fmaxf(v[1] * 255.f, 1.f), 1u, w);
    w = __builtin_amdgcn_cvt_pk_u8_f32(fmaxf(v[2] * 255.f, 1.f), 2u, w); w = __builtin_amdgcn_cvt_pk_u8_f32(fmaxf(v[3] * 255.f, 1.f), 3u, w); return w; }
__device__ __forceinline__ float ub0(unsigned w) { return (float)(w & 0xffu); }
__device__ __forceinline__ float ub1(unsigned w) { return (float)((w >> 8) & 0xffu); }
__device__ __forceinline__ float ub2(unsigned w) { return (float)((w >> 16) & 0xffu); }
__device__ __forceinline__ float ub3(unsigned w) { return (float)(w >> 24); }
typedef short v4i16_t __attribute__((ext_vector_type(4)));
__device__ __forceinline__ s16x4 lds_tr(const LAS unsigned char* p) { return __builtin_bit_cast(s16x4, __builtin_amdgcn_ds_read_tr16_b64_v4i16((LAS v4i16_t*)p)); }
__device__ __forceinline__ bf16x8 cat8(s16x4 a, s16x4 b) { return (bf16x8){a[0], a[1], a[2], a[3], b[0], b[1], b[2], b[3]}; }

namespace pg8 {
constexpr int BM = 256, BK = 64, HALF = 128, HTB = HALF * BK * 2, STAGE_BYTES = 8 * HTB, NXCD = 8, WGM = 8;
__host__ __device__ __forceinline__ int lds_byte(int r, int c) { const int st = (r >> 4) * 2 + (c >> 5), rr = r & 15, cc = c & 31, ob = rr * 64 + cc * 2; return st * 1024 + (ob ^ (((ob >> 9) & 1) << 5)); }
__host__ __device__ __forceinline__ void stage_rc(int b, int& R, int& C) { const int st = b / 1024, sb = b % 1024, swz = sb ^ (((sb >> 9) & 1) << 5); R = (st >> 1) * 16 + swz / 64; C = (st & 1) * 32 + (swz % 64) / 2; }
__host__ __device__ __forceinline__ int perm32(int rho) { const int n = rho >> 4, i = rho & 15; return 8 * (i >> 2) + 4 * n + (i & 3); }
struct Unit { int pm, pn; };
struct Gemm { const bf16_t* A; const bf16_t* Bt; int M, N, K, lda; };
struct StaticOrder {
    int nM, nN, nwg, G, c;
    __host__ __device__ void init(int M, int N, int G_, int c_) { nM = M / BM; nN = N / BM; nwg = nM * nN; G = G_; c = c_; }
    __host__ __device__ bool next(int i, Unit& u) const {
        const long L = (long)i * G + c; if (L >= nwg) return false;
        int wgid = (int)L; { const int q = nwg / NXCD, r = nwg % NXCD, xcd = wgid % NXCD, off = wgid / NXCD; wgid = (xcd < r ? xcd * (q + 1) : r * (q + 1) + (xcd - r) * q) + off; }
        const int nig = WGM * nN, gid = wgid / nig, fm = gid * WGM, gsz = (nM - fm) < WGM ? (nM - fm) : WGM;
        u.pm = fm + ((wgid % nig) % gsz); u.pn = (wgid % nig) / gsz; return true;
    }
};
template <class Epi, bool HOOK = false>
__device__ __forceinline__ void gemm_phase(LAS unsigned char* lds, const Gemm g, const StaticOrder& S, const Epi& E, const int tid) {
    const int wid = __builtin_amdgcn_readfirstlane(tid >> 6), lane = tid & 63, wr = wid >> 2, wc = wid & 3, fr = lane & 15, fq = lane >> 4;
    const int K = g.K, nt = K / BK, lda = g.lda;
    unsigned voffA[2], voffB[2];
#pragma unroll
    for (int i = 0; i < 2; ++i) { int R, C; stage_rc(tid * 16 + i * 8192, R, C); const int Rb = Epi::PERM ? ((R & ~31) + perm32(R & 31)) : R;
        voffA[i] = (unsigned)(R * lda + C) * 2u; voffB[i] = (unsigned)(Rb * K + C) * 2u; }
    const size_t kstep = (size_t)(BK * 2);
    const size_t hstepA = (size_t)HALF * lda * 2, hstepB = (size_t)HALF * K * 2;
    const size_t tstepA = 2 * hstepA, tstepB = 2 * hstepB;
    const unsigned ldsw = (unsigned)wid * 1024u;
    const int aoff = lds_byte(wr * 64 + fr, fq * 8), boff = lds_byte(wc * 32 + fr, fq * 8);
#define PG8_SA(b, h) (((b) * 2 + (h)) * HTB)
#define PG8_SB(b, h) ((4 + (b) * 2 + (h)) * HTB)
#define PG8_STAGE(bufoff, gbase, voff) do { _Pragma("unroll") for (int _i = 0; _i < 2; ++_i) \
        __builtin_amdgcn_global_load_lds((const unsigned*)((const char*)(gbase) + (voff)[_i]), (LAS unsigned*)(lds + (bufoff) + ldsw + _i * 8192), 16, 0, 0); } while (0)
#define PG8_LDA(dst, b, h) do { _Pragma("unroll") for (int m = 0; m < 4; ++m) _Pragma("unroll") for (int k = 0; k < 2; ++k) dst[m][k] = *(const LAS bf16x8*)(lds + PG8_SA(b, h) + aoff + m * 2048 + k * 1024); } while (0)
#define PG8_LDB(dst, b, h) do { _Pragma("unroll") for (int n = 0; n < 2; ++n) _Pragma("unroll") for (int k = 0; k < 2; ++k) dst[n][k] = *(const LAS bf16x8*)(lds + PG8_SB(b, h) + boff + n * 2048 + k * 1024); } while (0)
#define PG8_MMA(ai, bj, At, Bt) do { __builtin_amdgcn_s_setprio(1); _Pragma("unroll") for (int m = 0; m < 4; ++m) _Pragma("unroll") for (int n = 0; n < 2; ++n) _Pragma("unroll") for (int k = 0; k < 2; ++k) \
        acc[ai][bj][m][n] = __builtin_amdgcn_mfma_f32_16x16x32_bf16(Bt[n][k], At[m][k], acc[ai][bj][m][n], 0, 0, 0); __builtin_amdgcn_s_setprio(0); } while (0)
#define PG8_WAIT_V(n) asm volatile("s_waitcnt vmcnt(" #n ")" ::: "memory")
#define PG8_WAIT_L(n) asm volatile("s_waitcnt lgkmcnt(" #n ")" ::: "memory")
#define PG8_BAR __builtin_amdgcn_s_barrier()
#define PG8_SCHED __builtin_amdgcn_sched_barrier(0)
    Unit cur, nxt; int ui = 0;
    if (!S.next(0, cur)) return;
    f32x4 acc[2][2][4][2];
#pragma unroll
    for (int a = 0; a < 2; ++a)
#pragma unroll
        for (int b = 0; b < 2; ++b)
#pragma unroll
            for (int m = 0; m < 4; ++m)
#pragma unroll
                for (int n = 0; n < 2; ++n) acc[a][b][m][n] = (f32x4){0.f, 0.f, 0.f, 0.f};
    bf16x8 At[4][2], B0[2][2], B1[2][2];
    const char* cA = (const char*)g.A + (size_t)cur.pm * tstepA; const char* cB = (const char*)g.Bt + (size_t)cur.pn * tstepB;
    PG8_STAGE(PG8_SB(0, 0), cB, voffB); PG8_STAGE(PG8_SB(0, 1), cB + hstepB, voffB); PG8_STAGE(PG8_SA(0, 0), cA, voffA); PG8_STAGE(PG8_SA(0, 1), cA + hstepA, voffA);
    if (wr == 1) PG8_BAR;
    PG8_WAIT_V(2); PG8_BAR;
    PG8_STAGE(PG8_SB(1, 0), cB + kstep, voffB); PG8_STAGE(PG8_SA(1, 0), cA + kstep, voffA); PG8_STAGE(PG8_SB(1, 1), cB + hstepB + kstep, voffB);
    PG8_WAIT_V(6); PG8_BAR;
    for (;;) {
        const bool has_next = S.next(ui + 1, nxt);
        const char* nA = has_next ? (const char*)g.A + (size_t)nxt.pm * tstepA : cA; const char* nB = has_next ? (const char*)g.Bt + (size_t)nxt.pn * tstepB : cB;
        for (int t = 0; t < nt; t += 2) {
            if constexpr (HOOK) { if (t == 4 || t == 8) E.mid(acc, cur, t == 8, wr, wc, fr, fq); }
            const bool last = (t == nt - 2);
            const char* a1 = cA + (size_t)(t + 1) * kstep;
            const char* a2 = last ? nA : cA + (size_t)(t + 2) * kstep; const char* b2 = last ? nB : cB + (size_t)(t + 2) * kstep;
            const char* a3 = a2 + kstep; const char* b3 = b2 + kstep;
            PG8_LDB(B0, 0, 0); PG8_LDB(B1, 0, 1); PG8_SCHED; PG8_LDA(At, 0, 0); PG8_STAGE(PG8_SA(1, 1), a1 + hstepA, voffA);
            PG8_WAIT_V(8); PG8_WAIT_L(0); PG8_BAR; PG8_MMA(0, 0, At, B0); PG8_MMA(0, 1, At, B1); PG8_BAR; PG8_SCHED;
            PG8_LDA(At, 0, 1); PG8_STAGE(PG8_SB(0, 0), b2, voffB); PG8_STAGE(PG8_SB(0, 1), b2 + hstepB, voffB); PG8_STAGE(PG8_SA(0, 0), a2, voffA);
            PG8_WAIT_V(8); PG8_WAIT_L(0); PG8_BAR; PG8_MMA(1, 0, At, B0); PG8_MMA(1, 1, At, B1); PG8_BAR; PG8_SCHED;
            PG8_LDB(B0, 1, 0); PG8_LDB(B1, 1, 1); PG8_SCHED; PG8_LDA(At, 1, 0); PG8_STAGE(PG8_SA(0, 1), a2 + hstepA, voffA);
            PG8_WAIT_V(8); PG8_WAIT_L(0); PG8_BAR; PG8_MMA(0, 0, At, B0); PG8_MMA(0, 1, At, B1); PG8_BAR; PG8_SCHED;
            PG8_LDA(At, 1, 1); PG8_STAGE(PG8_SB(1, 0), b3, voffB); PG8_STAGE(PG8_SB(1, 1), b3 + hstepB, voffB); PG8_STAGE(PG8_SA(1, 0), a3, voffA);
            PG8_WAIT_V(8); PG8_WAIT_L(0); PG8_BAR; PG8_MMA(1, 0, At, B0); PG8_MMA(1, 1, At, B1); PG8_BAR; PG8_SCHED;
        }
        if (wr == 0) PG8_BAR;
        { Unit ue = cur; asm volatile("" : "+s"(ue.pm), "+s"(ue.pn));
          E(acc, ue, wr, wc, fr, fq); }
        if (!has_next) break;
#pragma unroll
        for (int a = 0; a < 2; ++a)
#pragma unroll
            for (int b = 0; b < 2; ++b)
#pragma unroll
                for (int m = 0; m < 4; ++m)
#pragma unroll
                    for (int n = 0; n < 2; ++n) acc[a][b][m][n] = (f32x4){0.f, 0.f, 0.f, 0.f};
        cur = nxt; cA = nA; cB = nB; ++ui;
        if (wr == 1) PG8_BAR;
    }
    PG8_WAIT_V(0);
    PG8_BAR;
#undef PG8_SA
#undef PG8_SB
#undef PG8_STAGE
#undef PG8_LDA
#undef PG8_LDB
#undef PG8_MMA
#undef PG8_WAIT_V
#undef PG8_WAIT_L
#undef PG8_BAR
#undef PG8_SCHED
}

struct EpiProj {
    static constexpr bool PERM = true;
    bf16_t *Gb, *Zb, *Ub, *QKVb, *GTb; const float *rope, *qg, *kg;
    __device__ __forceinline__ void operator()(const f32x4 (&acc)[2][2][4][2], const Unit& u, int wr, int wc, int fr, int fq) const {
        const int pn = u.pn;
        const int row0 = u.pm * BM + wr * 64 + fr;
        if (pn >= 6 && pn <= 8) {
            const bool isq = pn < 8;
            if (!isq && wc >= 2) {
#pragma unroll
                for (int ai = 0; ai < 2; ++ai)
#pragma unroll
                    for (int m = 0; m < 4; ++m) { bf16_t* rowp = QKVb + (size_t)(row0 + ai * HALF + m * 16) * 768 + 640 + (wc - 2) * 64 + 8 * fq;
#pragma unroll
                        for (int bj = 0; bj < 2; ++bj) { const f32x4 v0 = acc[ai][bj][m][0], v1 = acc[ai][bj][m][1];
                            u32x4 w; w.x = cvtpk(v0[0], v0[1]); w.y = cvtpk(v0[2], v0[3]); w.z = cvtpk(v1[0], v1[1]); w.w = cvtpk(v1[2], v1[3]);
                            *(u32x4*)(rowp + bj * 32) = w; } }
            } else {
                const int head = isq ? (pn - 6) * 4 + wc : wc;
                const float* gain = isq ? qg : kg;
                const int cbase = (isq ? 0 : 512) + head * 64 + 4 * fq;
                const float scale = isq ? 0.125f * LOG2E : 1.f;
                const bool dorope = u.pm < (ML / BM);
                const f32x4 g1a = *(const f32x4*)(gain + 4 * fq), g2a = *(const f32x4*)(gain + 16 + 4 * fq), g1b = *(const f32x4*)(gain + 32 + 4 * fq), g2b = *(const f32x4*)(gain + 48 + 4 * fq);
#pragma unroll
                for (int ai = 0; ai < 2; ++ai)
#pragma unroll
                    for (int m = 0; m < 4; ++m) { const int row = row0 + ai * HALF + m * 16;
                        f32x4 x1a = acc[ai][0][m][0], x2a = acc[ai][0][m][1], x1b = acc[ai][1][m][0], x2b = acc[ai][1][m][1];
                        float ss = 0.f;
#pragma unroll
                        for (int e = 0; e < 4; ++e) ss += (x1a[e] * x1a[e] + x2a[e] * x2a[e]) + (x1b[e] * x1b[e] + x2b[e] * x2b[e]);
                        ss += __shfl_xor(ss, 16); ss += __shfl_xor(ss, 32);
                        const float rinv = rsqrtf(ss * (1.f / 64.f) + EPSV);
                        x1a = x1a * rinv * g1a; x2a = x2a * rinv * g2a; x1b = x1b * rinv * g1b; x2b = x2b * rinv * g2b;
                        if (dorope) { const int t = row & (SEQ - 1);
                            const float* ra = rope + ((t >> 6) * 16 + 4 * fq) * 2; const f32x4 a0 = *(const f32x4*)ra, a1 = *(const f32x4*)(ra + 4);
                            const float* rb = rope + ((t & 63) * 16 + 4 * fq) * 2; const f32x4 b0 = *(const f32x4*)rb, b1 = *(const f32x4*)(rb + 4);
                            const f32x4 ca = {a0[0], a0[2], a1[0], a1[2]}, sa = {a0[1], a0[3], a1[1], a1[3]}, cb = {b0[0], b0[2], b1[0], b1[2]}, sb = {b0[1], b0[3], b1[1], b1[3]};
                            const f32x4 y1a = x1a * ca - x2a * sa, y2a = x2a * ca + x1a * sa, y1b = x1b * cb - x2b * sb, y2b = x2b * cb + x1b * sb;
                            x1a = y1a; x2a = y2a; x1b = y1b; x2b = y2b; }
                        x1a = x1a * scale; x2a = x2a * scale; x1b = x1b * scale; x2b = x2b * scale;
                        bf16_t* dp = QKVb + (size_t)row * 768 + cbase;
                        u32x2 w;
                        w.x = cvtpk(x1a[0], x1a[1]); w.y = cvtpk(x1a[2], x1a[3]); *(u32x2*)dp = w;
                        w.x = cvtpk(x2a[0], x2a[1]); w.y = cvtpk(x2a[2], x2a[3]); *(u32x2*)(dp + 16) = w;
                        w.x = cvtpk(x1b[0], x1b[1]); w.y = cvtpk(x1b[2], x1b[3]); *(u32x2*)(dp + 32) = w;
                        w.x = cvtpk(x2b[0], x2b[1]); w.y = cvtpk(x2b[2], x2b[3]); *(u32x2*)(dp + 48) = w; }
            }
            return;
        }
        bf16_t* base; int ld, c0, act;
        if (pn < 2) { base = Gb; ld = 512; c0 = pn * 256; act = 0; }
        else if (pn == 2) { base = Zb; ld = 1024; c0 = 0; act = 1; }
        else if (pn == 3) { base = Ub; ld = 512; c0 = 0; act = 0; }
        else if (pn == 4) { base = Ub; ld = 512; c0 = 256; act = 0; }
        else if (pn == 5) { base = Zb; ld = 1024; c0 = 256; act = 1; }
        else if (pn < 11) { base = Zb; ld = 1024; c0 = 512 + (pn - 9) * 256; act = 1; }
        else {
            unsigned char* gb8 = (unsigned char*)GTb + (size_t)row0 * 3072 + (pn - 11) * 256 + wc * 32 + 8 * fq;
#pragma unroll
            for (int ai = 0; ai < 2; ++ai)
#pragma unroll
                for (int m = 0; m < 4; ++m)
#pragma unroll
                    for (int bj = 0; bj < 2; ++bj) { f32x4 v0 = acc[ai][bj][m][0], v1 = acc[ai][bj][m][1];
#pragma unroll
                        for (int e = 0; e < 4; ++e) { v0[e] = sigm_f(v0[e]); v1[e] = sigm_f(v1[e]); }
                        u32x2 w; w.x = pack4q(v0); w.y = pack4q(v1);
                        *(u32x2*)(gb8 + (size_t)(ai * HALF + m * 16) * 3072 + bj * HALF) = w; }
            return; }
        const int col0 = c0 + wc * 32 + 8 * fq;
#pragma unroll
        for (int ai = 0; ai < 2; ++ai)
#pragma unroll
            for (int m = 0; m < 4; ++m) { bf16_t* rowp = base + (size_t)(row0 + ai * HALF + m * 16) * ld + col0;
#pragma unroll
                for (int bj = 0; bj < 2; ++bj) { f32x4 v0 = acc[ai][bj][m][0], v1 = acc[ai][bj][m][1];
                    if (act == 1) {
#pragma unroll
                        for (int e = 0; e < 4; ++e) { v0[e] = silu_f(v0[e]); v1[e] = silu_f(v1[e]); } }
                    else if (act == 2) {
#pragma unroll
                        for (int e = 0; e < 4; ++e) { v0[e] = sigm_f(v0[e]); v1[e] = sigm_f(v1[e]); } }
                    u32x4 w; w.x = cvtpk(v0[0], v0[1]); w.y = cvtpk(v0[2], v0[3]); w.z = cvtpk(v1[0], v1[1]); w.w = cvtpk(v1[2], v1[3]);
                    *(u32x4*)(rowp + bj * HALF) = w; } }
    }
};
struct EpiMerge {
    static constexpr bool PERM = true;
    const unsigned char* GT8; bf16_t* MG;
    __device__ __forceinline__ void mid(f32x4 (&acc)[2][2][4][2], const Unit& u, bool second, int wr, int wc, int fr, int fq) const {
        const int row0 = u.pm * BM + wr * 64 + fr, col0 = u.pn * BM + wc * 32 + 8 * fq + (second ? 1024 : 0);
#pragma unroll
        for (int ai = 0; ai < 2; ++ai)
#pragma unroll
            for (int m = 0; m < 4; ++m) { const unsigned char* gp = GT8 + (size_t)(row0 + ai * HALF + m * 16) * 3072 + col0;
#pragma unroll
                for (int bj = 0; bj < 2; ++bj) { const u32x2 nu = *(const u32x2*)(gp + bj * HALF), de = *(const u32x2*)(gp + 1024 + bj * HALF);
                    f32x4& v0 = acc[ai][bj][m][0]; f32x4& v1 = acc[ai][bj][m][1];
                    v0[0] *= ub0(nu.x) * __builtin_amdgcn_rcpf(ub0(de.x)); v0[1] *= ub1(nu.x) * __builtin_amdgcn_rcpf(ub1(de.x));
                    v0[2] *= ub2(nu.x) * __builtin_amdgcn_rcpf(ub2(de.x)); v0[3] *= ub3(nu.x) * __builtin_amdgcn_rcpf(ub3(de.x));
                    v1[0] *= ub0(nu.y) * __builtin_amdgcn_rcpf(ub0(de.y)); v1[1] *= ub1(nu.y) * __builtin_amdgcn_rcpf(ub1(de.y));
                    v1[2] *= ub2(nu.y) * __builtin_amdgcn_rcpf(ub2(de.y)); v1[3] *= ub3(nu.y) * __builtin_amdgcn_rcpf(ub3(de.y)); } }
        asm volatile("s_waitcnt vmcnt(0)" ::: "memory");
    }
    __device__ __forceinline__ void operator()(const f32x4 (&acc)[2][2][4][2], const Unit& u, int wr, int wc, int fr, int fq) const {
        const int row0 = u.pm * BM + wr * 64 + fr, col0 = u.pn * BM + wc * 32 + 8 * fq;
        constexpr float Q = 1.f / 255.f;
#pragma unroll
        for (int ai = 0; ai < 2; ++ai)
#pragma unroll
            for (int m = 0; m < 4; ++m) { const size_t row = (size_t)(row0 + ai * HALF + m * 16);
#pragma unroll
                for (int bj = 0; bj < 2; ++bj) { const int col = col0 + bj * HALF;
                    const u32x2 gw = *(const u32x2*)(GT8 + row * 3072 + 2048 + col);
                    f32x4 v0 = acc[ai][bj][m][0], v1 = acc[ai][bj][m][1];
                    v0[0] *= ub0(gw.x) * Q; v0[1] *= ub1(gw.x) * Q; v0[2] *= ub2(gw.x) * Q; v0[3] *= ub3(gw.x) * Q;
                    v1[0] *= ub0(gw.y) * Q; v1[1] *= ub1(gw.y) * Q; v1[2] *= ub2(gw.y) * Q; v1[3] *= ub3(gw.y) * Q;
                    u32x4 w; w.x = cvtpk(v0[0], v0[1]); w.y = cvtpk(v0[2], v0[3]); w.z = cvtpk(v1[0], v1[1]); w.w = cvtpk(v1[2], v1[3]);
                    *(u32x4*)(MG + row * 1024 + col) = w; } }
    }
};
struct EpiRes {
    static constexpr bool PERM = false;
    const float* xsrc; float* xdst; const float* csrc; float* cdst; const float* modl;
    __device__ __forceinline__ void operator()(const f32x4 (&acc)[2][2][4][2], const Unit& u, int wr, int wc, int fr, int fq) const {
        const int rbase = u.pm * BM + wr * 64 + fr;
        const int bi = rbase >> 13;
        const float* src = xsrc + (size_t)rbase * DM;
        float* dst = xdst + (size_t)rbase * DM;
        const int col0 = u.pn * BM + wc * 32 + 4 * fq;
        u32x2 up[2][2][2][4];
#pragma unroll
        for (int bj = 0; bj < 2; ++bj)
#pragma unroll
            for (int n = 0; n < 2; ++n) { const f32x4 gt = *(const f32x4*)(modl + bi * 3072 + 2048 + col0 + bj * HALF + n * 16);
#pragma unroll
                for (int ai = 0; ai < 2; ++ai)
#pragma unroll
                    for (int m = 0; m < 4; ++m) { const f32x4 v = gt * acc[ai][bj][m][n]; up[bj][n][ai][m].x = cvtpk(v[0], v[1]); up[bj][n][ai][m].y = cvtpk(v[2], v[3]); } }
        f32x4 xs[2][2][2][4];
#pragma unroll
        for (int bj = 0; bj < 2; ++bj)
#pragma unroll
            for (int n = 0; n < 2; ++n)
#pragma unroll
                for (int ai = 0; ai < 2; ++ai)
#pragma unroll
                    for (int m = 0; m < 4; ++m) xs[bj][n][ai][m] = *(const f32x4*)(src + (size_t)(ai * HALF + m * 16) * DM + col0 + bj * HALF + n * 16);
#pragma unroll
        for (int bj = 0; bj < 2; ++bj)
#pragma unroll
            for (int n = 0; n < 2; ++n)
#pragma unroll
                for (int ai = 0; ai < 2; ++ai)
#pragma unroll
                    for (int m = 0; m < 4; ++m) { const u32x2 w = up[bj][n][ai][m]; const f32x4 x = xs[bj][n][ai][m];
                        *(f32x4*)(dst + (size_t)(ai * HALF + m * 16) * DM + col0 + bj * HALF + n * 16) = (f32x4){x[0] + bflo(w.x), x[1] + bfhi(w.x), x[2] + bflo(w.y), x[3] + bfhi(w.y)}; }
    }
};
}

template <int NJ, int KC>
__device__ __forceinline__ void ag_load(bf16x8 (&bb)[KC][NJ], const bf16_t* tbase, int ldt, int ch) {
#pragma unroll
    for (int kk = 0; kk < KC; ++kk)
#pragma unroll
        for (int j = 0; j < NJ; ++j) bb[kk][j] = *(const bf16x8*)(tbase + (size_t)j * 16 * ldt + (ch * KC + kk) * 32);
}
template <int NI, int NJ, int KC>
__device__ __forceinline__ void ag_mma(f32x4 (&acc)[NI][NJ], const bf16x8 (&bb)[KC][NJ], const LAS unsigned char* abase, int RS, int ch) {
#pragma unroll
    for (int kk = 0; kk < KC; ++kk) { const LAS unsigned char* ap = abase + (ch * KC + kk) * 32 * RS;
        bf16x8 a[NI];
#pragma unroll
        for (int i = 0; i < NI; ++i) { const s16x4 lo = lds_tr(ap + i * 32), hi = lds_tr(ap + 4 * RS + i * 32); a[i] = cat8(lo, hi); }
#pragma unroll
        for (int i = 0; i < NI; ++i)
#pragma unroll
            for (int j = 0; j < NJ; ++j) acc[i][j] = __builtin_amdgcn_mfma_f32_16x16x32_bf16(a[i], bb[kk][j], acc[i][j], 0, 0, 0);
    }
}
template <int NI, int NJ, int KS, int KC>
__device__ __forceinline__ void act_gemm(f32x4 (&acc)[NI][NJ], const LAS unsigned char* act, int RS, int n0, const bf16_t* tab, int ldt, int lane) {
    constexpr int NC = KS / KC;
    static_assert(NC == 1 || NC % 2 == 0, "chunk count");
    const int g = lane >> 4, c = lane & 15;
    const LAS unsigned char* abase = act + (8 * g + (c >> 2)) * RS + (n0 + 4 * (c & 3)) * 2;
    const bf16_t* tbase = tab + (size_t)c * ldt + 8 * g;
    bf16x8 b0[KC][NJ];
    ag_load<NJ, KC>(b0, tbase, ldt, 0);
    if constexpr (NC == 1) { ag_mma<NI, NJ, KC>(acc, b0, abase, RS, 0); }
    else {
        bf16x8 b1[KC][NJ];
#pragma unroll 1
        for (int ch = 0; ch < NC; ch += 2) {
            ag_load<NJ, KC>(b1, tbase, ldt, ch + 1);
            ag_mma<NI, NJ, KC>(acc, b0, abase, RS, ch);
            if (ch + 2 < NC) ag_load<NJ, KC>(b0, tbase, ldt, ch + 2);
            ag_mma<NI, NJ, KC>(acc, b1, abase, RS, ch + 1);
        }
    }
}
template <int NI, int NJ> __device__ __forceinline__ void zero_acc(f32x4 (&acc)[NI][NJ]) {
#pragma unroll
    for (int i = 0; i < NI; ++i)
#pragma unroll
        for (int j = 0; j < NJ; ++j) acc[i][j] = (f32x4){0.f, 0.f, 0.f, 0.f};
}
__device__ __forceinline__ void mul_store4z(bf16_t* p, f32x4 v, u32x2 z, bool dry = false) {
    if (dry && v[0] != 1.2345e30f) return;
    u32x2 o; o.x = cvtpk(v[0] * bflo(z.x), v[1] * bfhi(z.x)); o.y = cvtpk(v[2] * bflo(z.y), v[3] * bfhi(z.y));
    *(u32x2*)p = o;
}
__device__ __forceinline__ void mul_store4(bf16_t* p, f32x4 v, bool dry = false) {
    if (dry && v[0] != 1.2345e30f) return;
    const u32x2 z = *(const u32x2*)p;
    u32x2 o; o.x = cvtpk(v[0] * bflo(z.x), v[1] * bfhi(z.x)); o.y = cvtpk(v[2] * bflo(z.y), v[3] * bfhi(z.y));
    *(u32x2*)p = o;
}

struct Params { const float* in[16]; float* out; unsigned char* ws; };

__device__ __forceinline__ void phase0(const Params& p, LAS unsigned char* lds, int tid, int bid, int G) {
    LAS float* sc = (LAS float*)lds;
    LAS float* red = (LAS float*)(lds + 20480);
    for (int i = tid; i < 5120; i += 512) { const float v = i < 4096 ? p.in[1][i] : p.in[3][i - 4096]; sc[i] = v / (1.f + expf(-v)); }
    __syncthreads();
    float* mod = (float*)(p.ws + WS_MOD);
    for (int item = bid; item < 192; item += G) {
        const int l = item / 48, cgp = item % 48, col = tid & 63, kg = tid >> 6, n = cgp * 64 + col;
        const float* w = p.in[4] + ((size_t)l * 1024 + kg * 128) * 3072 + n;
        float a0 = 0.f, a1 = 0.f, a2 = 0.f, a3 = 0.f, a4 = 0.f;
#pragma unroll 8
        for (int k = 0; k < 128; ++k) { const float wv = w[(size_t)k * 3072]; const int kk = kg * 128 + k;
            a0 += sc[kk] * wv; a1 += sc[1024 + kk] * wv; a2 += sc[2048 + kk] * wv; a3 += sc[3072 + kk] * wv; a4 += sc[4096 + kk] * wv; }
        red[(kg * 5 + 0) * 64 + col] = a0; red[(kg * 5 + 1) * 64 + col] = a1; red[(kg * 5 + 2) * 64 + col] = a2; red[(kg * 5 + 3) * 64 + col] = a3; red[(kg * 5 + 4) * 64 + col] = a4;
        __syncthreads();
        if (tid < 320) { const int bi = tid >> 6, c2 = tid & 63; float s = 0.f;
#pragma unroll
            for (int k2 = 0; k2 < 8; ++k2) s += red[(k2 * 5 + bi) * 64 + c2];
            mod[(l * 5 + bi) * 3072 + cgp * 64 + c2] = s + p.in[5][l * 3072 + cgp * 64 + c2]; }
        __syncthreads();
    }
    const int gt = bid * 512 + tid, NT = G * 512;
    float* rope = (float*)(p.ws + WS_ROPE);
    for (int i = gt; i < 5 * 3072; i += NT) ((float*)(p.ws + WS_ROPE + 65536))[i] = 0.f;
    for (int i = gt; i < 2048; i += NT) { const int pos = i >> 4, fi = i & 15; const float inv = exp2f(-(float)fi * (13.287712379549449f / 16.f)); const float ang = (float)pos * inv;
        const double rev = (double)ang * 0.15915494309189535; const double frc = rev - floor(rev); float s, c; sincospif((float)(2.0 * frc), &s, &c); rope[2 * i] = c; rope[2 * i + 1] = s; }
    if (gt < DEPTH * 64) {
        const int l = gt >> 6, d = gt & 63; float mq = fabsf(p.in[9][l * 64 + d]), mk = fabsf(p.in[10][l * 64 + d]);
#pragma unroll
        for (int o = 1; o < 64; o <<= 1) { mq = fmaxf(mq, __shfl_xor(mq, o)); mk = fmaxf(mk, __shfl_xor(mk, o)); }
        if (d == 0) ((float*)(p.ws + WS_ROPE + 131072))[l] = 8.f * LOG2E * mq * mk * 1.02f; }
    bf16_t* t128 = (bf16_t*)(p.ws + WS_T128);
    for (int i = gt; i < 65536; i += NT) { const int m = i >> 8, k = i & 255, part = m >> 7, k1 = m & 127, pp = k >> 7, l1 = k & 127; const int j = (l1 * k1) & 127; float s, c; sincospif((float)j / 64.f, &s, &c);
        const float v = (part == pp) ? c : (part == 0 ? s : -s); t128[i] = (bf16_t)(cvtpk(v, 0.f) & 0xffffu); }
    bf16_t* tc = (bf16_t*)(p.ws + WS_TC);
    for (int i = gt; i < 256 * 512; i += NT) { const int kk = i >> 9, k = i & 511, part = k >> 8, ll = k & 255; const int j = (kk * ll) & 255; float s, c; sincospif((float)j / 128.f, &s, &c);
        const float v = (part ? s : c) * 0.0625f; tc[i] = (bf16_t)(cvtpk(v, 0.f) & 0xffffu); }
    bf16_t* t3 = (bf16_t*)(p.ws + WS_T3);
    for (int i = gt; i < 128 * 64 * 128; i += NT) { const int k1 = i >> 13, k2 = (i >> 7) & 63, kp = i & 127, l2 = kp >> 1, part = kp & 1; const int j = (l2 * (k1 + 128 * k2)) & 8191; float s, c; sincospif((float)j / 4096.f, &s, &c);
        const float v = (part ? s : c) * 0.011048543456039806f; t3[i] = (bf16_t)(cvtpk(v, 0.f) & 0xffffu); }
}

__device__ __forceinline__ void transpose_blk(const float* Wsrc, int ldw, int K, bf16_t* WTdst, int kb, int perm, LAS float* scr, int lane) {
    const int k0 = 64 * kb;
    f32x4 wv[8];
#pragma unroll
    for (int i = 0; i < 8; ++i) wv[i] = *(const f32x4*)(Wsrc + (size_t)(k0 + 8 * i + (lane >> 3)) * ldw + 4 * (lane & 7));
#pragma unroll
    for (int i = 0; i < 8; ++i) { LAS float* d = scr + (8 * i + (lane >> 3)) * 33 + 4 * (lane & 7); d[0] = wv[i][0]; d[1] = wv[i][1]; d[2] = wv[i][2]; d[3] = wv[i][3]; }
    asm volatile("s_waitcnt lgkmcnt(0)" ::: "memory");
    const int c = lane & 7;
#pragma unroll
    for (int j = 0; j < 4; ++j) { const int n = (lane >> 3) + 8 * j; const int sc = perm ? (16 * ((n >> 2) & 1) + 4 * (n >> 3) + (n & 3)) : n; const LAS float* s = scr + (8 * c) * 33 + sc;
        u32x4 o; o.x = cvtpk(s[0 * 33], s[1 * 33]); o.y = cvtpk(s[2 * 33], s[3 * 33]); o.z = cvtpk(s[4 * 33], s[5 * 33]); o.w = cvtpk(s[6 * 33], s[7 * 33]);
        *(u32x4*)(WTdst + (size_t)n * K + k0 + 8 * c) = o; }
    asm volatile("s_waitcnt lgkmcnt(0)" ::: "memory");
}
__device__ __forceinline__ void conv_weights(const Params& p, LAS unsigned char* lds, int l, int tid, int lane, int wave, int bid, int G) {
    unsigned char* wsW = p.ws + ((l & 1) ? WS_W1 : WS_W);
    bf16_t* WinT = (bf16_t*)(wsW + W_IN_OFF);
    LAS float* scr = (LAS float*)(lds + wave * 8448);
    LAS float* ctab = (LAS float*)(lds + 8 * 8448);
    if (tid < 64) { float s, c; sincospif((float)tid / 32.f, &s, &c); ctab[tid] = c * 0.125f; ctab[64 + tid] = s * 0.125f; }
    __syncthreads();
    const int gw = bid * 8 + wave, NGW = G * 8;
    const float* win = p.in[6] + (size_t)l * 1024 * INW;
    constexpr int I_IN = 16 * 168, I_PA = 4 * 32, I_PC = 8 * 32, I_OUT = 16 * 32;
    for (int it = gw; it < I_IN + 2 * I_PA + I_PC + I_OUT; it += NGW) {
        int r = it;
        if (r < I_IN) { const int rb = 16 + r % 168, kb = r / 168, n = rb * 32; int c0, perm = 0;
            if (n < 1536 || n >= 2304) c0 = n - 256;
            else if (n < 2048) { const int t = n - 1536, tile = t >> 8, tt = t & 255, bj = tt >> 7, wc = (tt >> 5) & 3; c0 = 1280 + (tile * 4 + wc) * 64 + 32 * bj; perm = 1; }
            else { const int tt = n - 2048, bj = tt >> 7, wc = (tt >> 5) & 3; if (wc < 2) { c0 = 1792 + wc * 64 + 32 * bj; perm = 1; } else c0 = 1920 + (wc - 2) * 64 + 32 * bj; }
            transpose_blk(win + c0, INW, 1024, WinT + (size_t)n * 1024, kb, perm, scr, lane); continue; } r -= I_IN;
        if (r < I_PA) { transpose_blk(p.in[12] + (size_t)l * 256 * 1024 + 32 * (r & 31), 1024, 1024, (bf16_t*)(wsW + W_PA_OFF) + (size_t)32 * (r & 31) * 1024, r >> 5, 0, scr, lane); continue; } r -= I_PA;
        if (r < I_PA) { transpose_blk(p.in[13] + (size_t)l * 256 * 1024 + 32 * (r & 31), 1024, 1024, (bf16_t*)(wsW + W_PA_OFF) + (size_t)32 * (r & 31) * 1024 + 256, r >> 5, 0, scr, lane); continue; } r -= I_PA;
        if (r < I_PC) { transpose_blk(p.in[14] + (size_t)l * 512 * 1024 + 32 * (r & 31), 1024, 1024, (bf16_t*)(wsW + W_PA_OFF) + (size_t)32 * (r & 31) * 1024 + 512, r >> 5, 0, scr, lane); continue; } r -= I_PC;
        transpose_blk(p.in[15] + (size_t)l * 1024 * 1024 + 32 * (r & 31), 1024, 1024, (bf16_t*)(wsW + W_OUT_OFF) + (size_t)32 * (r & 31) * 1024, r >> 5, 0, scr, lane);
    }
    const int gtid = (G - 1 - bid) * 512 + tid, NT = G * 512;
    for (int id = gtid; id < 65536; id += NT) {
        const int n = id >> 7, ko = id & 127, part = n >> 8, grp = (n >> 6) & 3, m = n & 63;
        const LAS float* tb = ctab + part * 64;
        const float* wrow = win + (size_t)(ko * 8) * INW + grp * 64;
        float a[8];
#pragma unroll
        for (int j = 0; j < 8; ++j) a[j] = 0.f;
#pragma unroll 4
        for (int c4 = 0; c4 < 16; ++c4) {
            const float t0 = tb[(m * (4 * c4)) & 63], t1 = tb[(m * (4 * c4 + 1)) & 63], t2 = tb[(m * (4 * c4 + 2)) & 63], t3 = tb[(m * (4 * c4 + 3)) & 63];
#pragma unroll
            for (int j = 0; j < 8; ++j) { const f32x4 wv = *(const f32x4*)(wrow + (size_t)j * INW + c4 * 4); a[j] += wv[0] * t0 + wv[1] * t1 + wv[2] * t2 + wv[3] * t3; }
        }
        const float sg = part ? -1.f : 1.f;
        u32x4 o; o.x = cvtpk(sg * a[0], sg * a[1]); o.y = cvtpk(sg * a[2], sg * a[3]); o.z = cvtpk(sg * a[4], sg * a[5]); o.w = cvtpk(sg * a[6], sg * a[7]);
        *(u32x4*)(WinT + (size_t)n * 1024 + ko * 8) = o;
    }
    { const float* sw = p.in[7] + (size_t)l * 65536; bf16_t* dw = (bf16_t*)(p.ws + WS_SGUW);
      for (int id = gtid; id < 8192; id += NT) { const f32x4 v0 = *(const f32x4*)(sw + id * 8), v1 = *(const f32x4*)(sw + id * 8 + 4);
          u32x4 o; o.x = cvtpk(v0[0], v0[1]); o.y = cvtpk(v0[2], v0[3]); o.z = cvtpk(v1[0], v1[1]); o.w = cvtpk(v1[2], v1[3]); *(u32x4*)(dw + id * 8) = o; } }
}
__device__ __forceinline__ void h_rows(const Params& p, int l, int lane, int wave, int bid, int G) {
    const int gw = bid * 8 + wave, NGW = G * 8;
    const float* xs = l == 0 ? p.in[0] : p.out;
    const float* cs = l == 0 ? p.in[2] : (const float*)(p.ws + WS_XC);
    const float* mod = (const float*)(p.ws + WS_MOD) + (size_t)l * 5 * 3072;
    bf16_t* H = (bf16_t*)(p.ws + WS_H);
    for (int row0 = gw * 4; row0 < MT; row0 += NGW * 4) {
        const float* src = row0 < ML ? xs + (size_t)row0 * DM : cs + (size_t)(row0 - ML) * DM;
        const int bi = row0 < ML ? (row0 >> 13) : 4;
        const float* md = mod + bi * 3072;
        f32x4 v[4][4]; float ss[4];
#pragma unroll
        for (int r = 0; r < 4; ++r)
#pragma unroll
            for (int j = 0; j < 4; ++j) v[r][j] = *(const f32x4*)(src + (size_t)r * DM + 4 * lane + 256 * j);
#pragma unroll
        for (int r = 0; r < 4; ++r) { ss[r] = 0.f;
#pragma unroll
            for (int j = 0; j < 4; ++j) ss[r] += (v[r][j][0] * v[r][j][0] + v[r][j][1] * v[r][j][1]) + (v[r][j][2] * v[r][j][2] + v[r][j][3] * v[r][j][3]); }
#pragma unroll
        for (int o = 1; o < 64; o <<= 1) {
#pragma unroll
            for (int r = 0; r < 4; ++r) ss[r] += __shfl_xor(ss[r], o); }
#pragma unroll
        for (int j = 0; j < 4; ++j) { const int idx = 4 * lane + 256 * j; const f32x4 sh = *(const f32x4*)(md + idx), scl = *(const f32x4*)(md + 1024 + idx) + 1.f;
#pragma unroll
            for (int r = 0; r < 4; ++r) { const float rinv = rsqrtf(ss[r] * (1.f / 1024.f) + EPSV);
                const f32x4 o = v[r][j] * rinv * scl + sh; u32x2 w; w.x = cvtpk(o[0], o[1]); w.y = cvtpk(o[2], o[3]); *(u32x2*)(H + (size_t)(row0 + r) * DM + idx) = w; } }
    }
}

__device__ __forceinline__ void attn_item(LAS unsigned char* lds, const bf16_t* QKV, bf16_t* Z, const float* sinkl, const float m0,
                                          int b, int blk, int kvh, int hp, bool isctx, int tid, int lane, int wave, bool dry = false) {
    constexpr int RS = 144;
    LAS unsigned char* Qs = lds; LAS unsigned char* Ks = lds + 256 * RS; LAS unsigned char* Vs = Ks + 128 * RS;
    const int qrow0 = isctx ? (ML + b * 256 + blk * 128) : (b * SEQ + blk * 128);
    const int hl = wave >> 2, qq = wave & 3, gq = hp * 2 + hl, g = lane >> 4, c = lane & 15;
    u32x4 qreg[4];
#pragma unroll
    for (int it = 0; it < 4; ++it) { const int id = it * 512 + tid, r = id >> 3, c16 = id & 7;
        qreg[it] = *(const u32x4*)(QKV + (size_t)(qrow0 + (r & 127)) * 768 + (kvh * 4 + hp * 2 + (r >> 7)) * 64 + c16 * 8); }
    u32x2 zreg[2][4];
#pragma unroll
    for (int qi = 0; qi < 2; ++qi)
#pragma unroll
        for (int df = 0; df < 4; ++df) zreg[qi][df] = *(const u32x2*)(Z + (size_t)(qrow0 + qq * 32 + 16 * qi + c) * 1024 + 512 + (kvh * 4 + gq) * 64 + 16 * df + 4 * g);
    const LAS unsigned char* qbase = Qs + (hl * 128 + qq * 32 + c) * RS + 16 * g;
    f32x4 O[4][2]; float l_run[2];
    const float sinkv = sinkl[kvh * 4 + gq] * LOG2E;
    const float mshift = fmaxf(m0, sinkv), nm = -mshift;
    const f32x4 negm = {nm, nm, nm, nm};
#pragma unroll
    for (int qi = 0; qi < 2; ++qi) { l_run[qi] = (g == 0) ? __builtin_amdgcn_exp2f(sinkv - mshift) : 0.f;
#pragma unroll
        for (int df = 0; df < 4; ++df) O[df][qi] = (f32x4){0.f, 0.f, 0.f, 0.f}; }
    const LAS unsigned char* vbase = Vs + (4 * g + (c >> 2)) * RS + (4 * (c & 3)) * 2;
    const int kvoff = 512 + kvh * 64 + (tid & 7) * 8, kr0 = tid >> 3;
    int ti = isctx ? 3 : (blk == 0 ? 1 : 0);
    u32x4 kreg[2], vreg[2];
#define ATT_KROW(t) ((t) >= 3 ? ML + b * 256 + ((t) - 3) * 128 : qrow0 + ((t) - 1) * 128)
#define ATT_PRELOAD(t) do { const bf16_t* src_ = QKV + (size_t)(ATT_KROW(t) + kr0) * 768 + kvoff; \
        kreg[0] = *(const u32x4*)src_; vreg[0] = *(const u32x4*)(src_ + 128); kreg[1] = *(const u32x4*)(src_ + (size_t)64 * 768); vreg[1] = *(const u32x4*)(src_ + (size_t)64 * 768 + 128); } while (0)
    ATT_PRELOAD(ti);
    __syncthreads();
#pragma unroll
    for (int it = 0; it < 4; ++it) { const int id = it * 512 + tid; *(LAS u32x4*)(Qs + (id >> 3) * RS + (id & 7) * 16) = qreg[it]; }
#pragma unroll 1
    while (ti < 5) {
        int tn = ti + 1; if (tn == 2 && blk == 63) tn = 3;
        __syncthreads();
#pragma unroll
        for (int it = 0; it < 2; ++it) { *(LAS u32x4*)(Ks + (kr0 + 64 * it) * RS + (tid & 7) * 16) = kreg[it]; *(LAS u32x4*)(Vs + (kr0 + 64 * it) * RS + (tid & 7) * 16) = vreg[it]; }
        if (tn < 5) ATT_PRELOAD(tn);
        __syncthreads();
        const int ks_lo = (ti == 0) ? qq : 0, ks_hi = (ti == 2) ? qq + 1 : 4;
        const int sg = (ti == 0) ? 1 : -1;
        bf16x8 qf[2][2];
#pragma unroll
        for (int qi = 0; qi < 2; ++qi) { qf[qi][0] = *(const LAS bf16x8*)(qbase + (16 * qi) * RS); qf[qi][1] = *(const LAS bf16x8*)(qbase + (16 * qi) * RS + 64); }
        int base0 = sg * (4 * g - (qq * 32 + c)); asm volatile("" : "+v"(base0));
        float psum[2] = {0.f, 0.f};
        if (ti == 0 || ti == 2) {
#pragma unroll
        for (int ks = 0; ks < 4; ++ks) {
            if (ks >= ks_lo && ks < ks_hi) {
                asm volatile("" ::: "memory");
                const LAS unsigned char* kp = Ks + (32 * ks + c) * RS + 16 * g;
                const bf16x8 ka0 = *(const LAS bf16x8*)kp, ka1 = *(const LAS bf16x8*)(kp + 64), kb0 = *(const LAS bf16x8*)(kp + 16 * RS), kb1 = *(const LAS bf16x8*)(kp + 16 * RS + 64);
                bf16x8 pf[2];
#pragma unroll
                for (int qi = 0; qi < 2; ++qi) {
                    f32x4 s0 = __builtin_amdgcn_mfma_f32_16x16x32_bf16(ka0, qf[qi][0], negm, 0, 0, 0);
                    s0 = __builtin_amdgcn_mfma_f32_16x16x32_bf16(ka1, qf[qi][1], s0, 0, 0, 0);
                    f32x4 s1 = __builtin_amdgcn_mfma_f32_16x16x32_bf16(kb0, qf[qi][0], negm, 0, 0, 0);
                    s1 = __builtin_amdgcn_mfma_f32_16x16x32_bf16(kb1, qf[qi][1], s1, 0, 0, 0);
                    if (ti == 0 || ti == 2) {
                        const int base = base0 - sg * 16 * qi;
#pragma unroll
                        for (int r = 0; r < 4; ++r) { const int l0 = -sg * (32 * ks + r), l1 = -sg * (32 * ks + 16 + r); s0[r] = (base < l0) ? -1e30f : s0[r]; s1[r] = (base < l1) ? -1e30f : s1[r]; } }
#pragma unroll
                    for (int r = 0; r < 4; ++r) { s0[r] = __builtin_amdgcn_exp2f(s0[r]); s1[r] = __builtin_amdgcn_exp2f(s1[r]); psum[qi] += s0[r] + s1[r]; }
                    u32x4 pw; pw.x = cvtpk(s0[0], s0[1]); pw.y = cvtpk(s0[2], s0[3]); pw.z = cvtpk(s1[0], s1[1]); pw.w = cvtpk(s1[2], s1[3]);
                    pf[qi] = __builtin_bit_cast(bf16x8, pw);
                }
#pragma unroll
                for (int df = 0; df < 4; ++df) { const LAS unsigned char* vp = vbase + (ks * 32) * RS + df * 32;
                    const bf16x8 vf = cat8(lds_tr(vp), lds_tr(vp + 16 * RS));
                    O[df][0] = __builtin_amdgcn_mfma_f32_16x16x32_bf16(vf, pf[0], O[df][0], 0, 0, 0);
                    O[df][1] = __builtin_amdgcn_mfma_f32_16x16x32_bf16(vf, pf[1], O[df][1], 0, 0, 0); }
            }
        }
        } else {
#pragma unroll
        for (int ks = 0; ks < 4; ++ks) {
            {
                const LAS unsigned char* kp = Ks + (32 * ks + c) * RS + 16 * g;
                const bf16x8 ka0 = *(const LAS bf16x8*)kp, ka1 = *(const LAS bf16x8*)(kp + 64), kb0 = *(const LAS bf16x8*)(kp + 16 * RS), kb1 = *(const LAS bf16x8*)(kp + 16 * RS + 64);
                bf16x8 pf[2];
#pragma unroll
                for (int qi = 0; qi < 2; ++qi) {
                    f32x4 s0 = __builtin_amdgcn_mfma_f32_16x16x32_bf16(ka0, qf[qi][0], negm, 0, 0, 0);
                    s0 = __builtin_amdgcn_mfma_f32_16x16x32_bf16(ka1, qf[qi][1], s0, 0, 0, 0);
                    f32x4 s1 = __builtin_amdgcn_mfma_f32_16x16x32_bf16(kb0, qf[qi][0], negm, 0, 0, 0);
                    s1 = __builtin_amdgcn_mfma_f32_16x16x32_bf16(kb1, qf[qi][1], s1, 0, 0, 0);
#pragma unroll
                    for (int r = 0; r < 4; ++r) { s0[r] = __builtin_amdgcn_exp2f(s0[r]); s1[r] = __builtin_amdgcn_exp2f(s1[r]); psum[qi] += s0[r] + s1[r]; }
                    u32x4 pw; pw.x = cvtpk(s0[0], s0[1]); pw.y = cvtpk(s0[2], s0[3]); pw.z = cvtpk(s1[0], s1[1]); pw.w = cvtpk(s1[2], s1[3]);
                    pf[qi] = __builtin_bit_cast(bf16x8, pw);
                }
#pragma unroll
                for (int df = 0; df < 4; ++df) { const LAS unsigned char* vp = vbase + (ks * 32) * RS + df * 32;
                    const bf16x8 vf = cat8(lds_tr(vp), lds_tr(vp + 16 * RS));
                    O[df][0] = __builtin_amdgcn_mfma_f32_16x16x32_bf16(vf, pf[0], O[df][0], 0, 0, 0);
                    O[df][1] = __builtin_amdgcn_mfma_f32_16x16x32_bf16(vf, pf[1], O[df][1], 0, 0, 0); }
            }
        }
        }
        l_run[0] += psum[0]; l_run[1] += psum[1];
        ti = tn;
    }
#undef ATT_KROW
#undef ATT_PRELOAD
#pragma unroll
    for (int qi = 0; qi < 2; ++qi) { float lt = l_run[qi]; lt += __shfl_xor(lt, 16); lt += __shfl_xor(lt, 32); const float inv = 1.f / lt;
        const size_t row = (size_t)(qrow0 + qq * 32 + 16 * qi + c);
#pragma unroll
        for (int df = 0; df < 4; ++df) mul_store4z(Z + row * 1024 + 512 + (kvh * 4 + gq) * 64 + 16 * df + 4 * g, O[df][qi] * inv, zreg[qi][df], dry); }
}

__device__ __forceinline__ void f1_item(LAS unsigned char* lds, const bf16_t* Gb, bf16_t* Afft, const bf16_t* t128, int b, int l2, int tid, int lane, int wave) {
    constexpr int RS = 528;
    const int g = lane >> 4, c = lane & 15;
    __syncthreads();
#pragma unroll
    for (int it = 0; it < 16; ++it) { const int id = it * 512 + tid, row = id >> 5, c16 = id & 31, pp = row >> 7, l1 = row & 127;
        *(LAS u32x4*)(lds + row * RS + c16 * 16) = *(const u32x4*)(Gb + (size_t)(b * SEQ + 64 * l1 + l2) * 512 + pp * 256 + c16 * 8); }
    bf16x8 tb[8][2];
    { const bf16_t* tp = t128 + (size_t)(32 * wave + c) * 256 + 8 * g;
#pragma unroll
      for (int ks = 0; ks < 8; ++ks)
#pragma unroll
          for (int j = 0; j < 2; ++j) tb[ks][j] = *(const bf16x8*)(tp + (size_t)j * 16 * 256 + ks * 32); }
    __syncthreads();
    const LAS unsigned char* abase = lds + (8 * g + (c >> 2)) * RS + (4 * (c & 3)) * 2;
    const int part = wave >> 2;
#pragma unroll 1
    for (int cq = 0; cq < 4; ++cq) {
        f32x4 acc[4][2]; zero_acc<4, 2>(acc);
#pragma unroll
        for (int ks = 0; ks < 8; ++ks) {
            bf16x8 a[4];
#pragma unroll
            for (int i = 0; i < 4; ++i) { const LAS unsigned char* ap = abase + ks * 32 * RS + (cq * 64 + 16 * i) * 2; a[i] = cat8(lds_tr(ap), lds_tr(ap + 4 * RS)); }
#pragma unroll
            for (int i = 0; i < 4; ++i)
#pragma unroll
                for (int j = 0; j < 2; ++j) acc[i][j] = __builtin_amdgcn_mfma_f32_16x16x32_bf16(a[i], tb[ks][j], acc[i][j], 0, 0, 0);
        }
#pragma unroll
        for (int j = 0; j < 2; ++j) { const int k1 = (wave & 3) * 32 + 16 * j + c; const size_t arow = ((size_t)(b * 128 + k1) * 64 + l2) * 2 + part;
#pragma unroll
            for (int i = 0; i < 4; ++i) { const unsigned long long o = (unsigned long long)cvtpk(acc[i][j][0], acc[i][j][1]) | ((unsigned long long)cvtpk(acc[i][j][2], acc[i][j][3]) << 32);
                __hip_atomic_store((unsigned long long*)(Afft + arow * 256 + cq * 64 + 16 * i + 4 * g), o, __ATOMIC_RELAXED, __HIP_MEMORY_SCOPE_AGENT); } }
    }
}
__device__ __forceinline__ void sgu_item(LAS unsigned char* lds, const bf16_t* Ub, bf16_t* Z, const bf16_t* sguw, const float* sgub, int ci, int tid, int lane, int wave, bool dry = false) {
    constexpr int RS = 528;
    const int row0 = ci * 128;
    const int grp = wave >> 1, sh = wave & 1, g = lane >> 4, c = lane & 15;
    const int t = tid >> 2, qd = tid & 3; const bf16_t* vp = Ub + (size_t)(row0 + t) * 512 + 256 + qd * 64;
    u32x4 w[8];
#pragma unroll
    for (int i = 0; i < 8; ++i) w[i] = *(const u32x4*)(vp + 8 * i);
    bf16x8 b0[4][4];
    ag_load<4, 4>(b0, sguw + (size_t)grp * 16384 + (size_t)(sh * 64 + c) * 128 + 8 * g, 128, 0);
    u32x2 uw[4][4], zw[4][4];
#pragma unroll
    for (int j = 0; j < 4; ++j) { const size_t row = (size_t)(row0 + sh * 64 + 16 * j + c);
#pragma unroll
        for (int i = 0; i < 4; ++i) { const int col = grp * 64 + 16 * i + 4 * g; uw[i][j] = *(const u32x2*)(Ub + row * 512 + col); zw[i][j] = *(const u32x2*)(Z + row * 1024 + 256 + col); } }
    __syncthreads();
    { float ss = 0.f;
#pragma unroll
      for (int i = 0; i < 8; ++i) {
          const float a0 = bflo(w[i].x), a1 = bfhi(w[i].x), a2 = bflo(w[i].y), a3 = bfhi(w[i].y), a4 = bflo(w[i].z), a5 = bfhi(w[i].z), a6 = bflo(w[i].w), a7 = bfhi(w[i].w);
          ss += (a0 * a0 + a1 * a1) + (a2 * a2 + a3 * a3) + (a4 * a4 + a5 * a5) + (a6 * a6 + a7 * a7); }
      ss += __shfl_xor(ss, 1); ss += __shfl_xor(ss, 2);
      const float rinv = rsqrtf(ss * (1.f / 256.f) + EPSV);
#pragma unroll
      for (int i = 0; i < 8; ++i) { u32x4 o; o.x = cvtpk(bflo(w[i].x) * rinv, bfhi(w[i].x) * rinv); o.y = cvtpk(bflo(w[i].y) * rinv, bfhi(w[i].y) * rinv); o.z = cvtpk(bflo(w[i].z) * rinv, bfhi(w[i].z) * rinv); o.w = cvtpk(bflo(w[i].w) * rinv, bfhi(w[i].w) * rinv);
          *(LAS u32x4*)(lds + t * RS + qd * 128 + i * 16) = o; } }
    __syncthreads();
    f32x4 acc[4][4]; zero_acc<4, 4>(acc);
    ag_mma<4, 4, 4>(acc, b0, lds + (8 * g + (c >> 2)) * RS + (grp * 64 + 4 * (c & 3)) * 2, RS, 0);
#pragma unroll
    for (int j = 0; j < 4; ++j) { const int s_ = sh * 64 + 16 * j + c; const float bias = sgub[grp * 128 + s_]; const size_t row = (size_t)(row0 + s_);
#pragma unroll
        for (int i = 0; i < 4; ++i) { const int col = grp * 64 + 16 * i + 4 * g; const u32x2 u2 = uw[i][j];
            f32x4 v = acc[i][j]; v[0] = (v[0] + bias) * bflo(u2.x); v[1] = (v[1] + bias) * bfhi(u2.x); v[2] = (v[2] + bias) * bflo(u2.y); v[3] = (v[3] + bias) * bfhi(u2.y);
            mul_store4z(Z + row * 1024 + 256 + col, v, zw[i][j], dry); } }
}
__device__ __forceinline__ void f3_wave_item(LAS unsigned char* ldsw, const bf16_t* Afft, bf16_t* Z, const bf16_t* t3, int wi, int lane, bool dry) {
    constexpr int RS = 80;
    const int b = wi >> 10, k1 = (wi >> 3) & 127, ch0 = (wi & 7) * 32;
    const bf16_t* src = Afft + (size_t)(b * 128 + k1) * 128 * 256 + ch0;
    u32x4 v[8];
#pragma unroll
    for (int it = 0; it < 8; ++it) { const int id = it * 64 + lane; v[it] = *(const u32x4*)(src + (size_t)(id >> 2) * 256 + (id & 3) * 8); }
#pragma unroll
    for (int it = 0; it < 8; ++it) { const int id = it * 64 + lane; *(LAS u32x4*)(ldsw + (id >> 2) * RS + (id & 3) * 16) = v[it]; }
    asm volatile("s_waitcnt lgkmcnt(0)" ::: "memory");
    const int g = lane >> 4, c = lane & 15;
    f32x4 acc[2][4]; zero_acc<2, 4>(acc);
    act_gemm<2, 4, 4, 4>(acc, ldsw, RS, 0, t3 + (size_t)k1 * 64 * 128, 128, lane);
#pragma unroll
    for (int j = 0; j < 4; ++j) { const int k2 = 16 * j + c; const size_t row = (size_t)b * SEQ + k1 + 128 * k2;
#pragma unroll
        for (int i = 0; i < 2; ++i) mul_store4(Z + row * 1024 + ch0 + 16 * i + 4 * g, acc[i][j], dry); }
    asm volatile("" ::: "memory");
}
__device__ __forceinline__ void fc_item(LAS unsigned char* lds, const bf16_t* Gb, bf16_t* Z, const bf16_t* tc, int item, int tid, int lane, int wave, bool dry = false) {
    constexpr int RS = 144;
    const int b = item >> 3, chq = (item >> 1) & 3, kh = item & 1;
    u32x4 v[8];
#pragma unroll
    for (int it = 0; it < 8; ++it) { const int id = it * 512 + tid, row = id >> 3, c16 = id & 7, part = row >> 8, ll = row & 255;
        v[it] = *(const u32x4*)(Gb + (size_t)(ML + b * 256 + ll) * 512 + part * 256 + chq * 64 + c16 * 8); }
    __syncthreads();
#pragma unroll
    for (int it = 0; it < 8; ++it) { const int id = it * 512 + tid; *(LAS u32x4*)(lds + (id >> 3) * RS + (id & 7) * 16) = v[it]; }
    __syncthreads();
    const int g = lane >> 4, c = lane & 15, kk0 = kh * 128 + (wave >> 2) * 64;
    f32x4 acc[1][4]; zero_acc<1, 4>(acc);
    act_gemm<1, 4, 16, 4>(acc, lds, RS, 16 * (wave & 3), tc + (size_t)kk0 * 512, 512, lane);
#pragma unroll
    for (int j = 0; j < 4; ++j) { const size_t row = (size_t)(ML + b * 256 + kk0 + 16 * j + c); mul_store4(Z + row * 1024 + chq * 64 + 16 * (wave & 3) + 4 * g, acc[0][j], dry); }
}

__device__ __forceinline__ void ctx_merge_tile(const bf16_t* Y, const unsigned char* GT, bf16_t* MG, const unsigned char* wsW, int tile, int lane, int wave) {
    const int m = ML + 64 * (tile >> 4) + 16 * (wave >> 1) + (lane & 15), nb = 64 * (tile & 15) + 32 * (wave & 1), g = lane >> 4, c = lane & 15;
    f32x4 mg[2] = {(f32x4){0.f, 0.f, 0.f, 0.f}, (f32x4){0.f, 0.f, 0.f, 0.f}};
#pragma unroll
    for (int seg = 0; seg < 3; ++seg) {
        const int Kseg = seg == 2 ? 512 : 256;
        const bf16_t* Wt = (const bf16_t*)(wsW + W_PA_OFF) + seg * 256;
        const bf16_t* yp = Y + (size_t)m * 1024 + seg * 256 + 8 * g;
        const bf16_t* wp = Wt + (size_t)(nb + c) * 1024 + 8 * g;
        f32x4 acc[2] = {(f32x4){0.f, 0.f, 0.f, 0.f}, (f32x4){0.f, 0.f, 0.f, 0.f}};
#pragma unroll 8
        for (int ks = 0; ks < Kseg / 32; ++ks) {
            const bf16x8 yf = *(const bf16x8*)(yp + ks * 32);
#pragma unroll
            for (int j = 0; j < 2; ++j) { const bf16x8 wf = *(const bf16x8*)(wp + (size_t)j * 16 * 1024 + ks * 32); acc[j] = __builtin_amdgcn_mfma_f32_16x16x32_bf16(wf, yf, acc[j], 0, 0, 0); }
        }
#pragma unroll
        for (int j = 0; j < 2; ++j) { const unsigned gw = *(const unsigned*)(GT + (size_t)m * 3072 + seg * 1024 + nb + 16 * j + 4 * g);
            mg[j][0] += acc[j][0] * ub0(gw) * (1.f / 255.f); mg[j][1] += acc[j][1] * ub1(gw) * (1.f / 255.f); mg[j][2] += acc[j][2] * ub2(gw) * (1.f / 255.f); mg[j][3] += acc[j][3] * ub3(gw) * (1.f / 255.f); }
    }
#pragma unroll
    for (int j = 0; j < 2; ++j) { u32x2 o; o.x = cvtpk(mg[j][0], mg[j][1]); o.y = cvtpk(mg[j][2], mg[j][3]); *(u32x2*)(MG + (size_t)m * 1024 + nb + 16 * j + 4 * g) = o; }
}
__device__ __forceinline__ void ctx_out_tile(const bf16_t* MG, const bf16_t* WoT, const float* csrc, float* cdst, const float* gate_c, int tile, int lane, int wave) {
    const int mr = 64 * (tile >> 4) + 16 * (wave >> 1) + (lane & 15), nb = 64 * (tile & 15) + 32 * (wave & 1), g = lane >> 4, c = lane & 15;
    const bf16_t* ap = MG + (size_t)(ML + mr) * 1024 + 8 * g;
    const bf16_t* wp = WoT + (size_t)(nb + c) * 1024 + 8 * g;
    f32x4 acc[2] = {(f32x4){0.f, 0.f, 0.f, 0.f}, (f32x4){0.f, 0.f, 0.f, 0.f}};
#pragma unroll 8
    for (int ks = 0; ks < 32; ++ks) {
        const bf16x8 yf = *(const bf16x8*)(ap + ks * 32);
#pragma unroll
        for (int j = 0; j < 2; ++j) { const bf16x8 wf = *(const bf16x8*)(wp + (size_t)j * 16 * 1024 + ks * 32); acc[j] = __builtin_amdgcn_mfma_f32_16x16x32_bf16(wf, yf, acc[j], 0, 0, 0); }
    }
#pragma unroll
    for (int j = 0; j < 2; ++j) { const int n = nb + 16 * j + 4 * g; const f32x4 gt = *(const f32x4*)(gate_c + n); const f32x4 xs = *(const f32x4*)(csrc + (size_t)mr * DM + n);
        *(f32x4*)(cdst + (size_t)mr * DM + n) = xs + gt * acc[j]; }
}

#define XB_TMO      128
#define XB_XCNT(j)  (256  + 64 * (j))
#define XB_XSUB(j)  (1280 + 64 * (j))
#define XB_XGEN(j)  (2304 + 64 * (j))
#define XB_TOP      3328
#define XB_TOPGEN   3392
#define XCD_BAR_WORDS 3456
#define XB_SPIN_CAP (1u << 18)
__device__ __forceinline__ unsigned xb_ld(unsigned* p)              { return __hip_atomic_load(p, __ATOMIC_RELAXED, __HIP_MEMORY_SCOPE_AGENT); }
__device__ __forceinline__ unsigned xb_add(unsigned* p, unsigned v) { return __hip_atomic_fetch_add(p, v, __ATOMIC_RELAXED, __HIP_MEMORY_SCOPE_AGENT); }
__device__ __forceinline__ unsigned xb_xcc_id() { return (unsigned)__builtin_amdgcn_s_getreg((3 << 11) | 20) & 0xFu; }
#define XB_SPIN(cond, bar) do { unsigned _sp = 0; while (cond) { __builtin_amdgcn_s_sleep(1); \
    if ((++_sp & 255u) == 0u) { if (xb_ld(&(bar)[XB_TMO])) break; if (_sp > XB_SPIN_CAP) { atomicAdd(&(bar)[XB_TMO], 1u); break; } } } } while (0)
struct XcdBarrier { unsigned* bar; unsigned x; volatile LAS unsigned* st; };
__device__ __forceinline__ XcdBarrier xcd_barrier_post(unsigned* bar, volatile LAS unsigned* st) {
    XcdBarrier b; b.bar = bar; b.x = xb_xcc_id(); b.st = st;
    if (threadIdx.x == 0) (void)xb_add(&bar[XB_XCNT(b.x)], 1u);
    return b;
}
__device__ __forceinline__ void xcd_barrier_complete(unsigned* bar, unsigned x, unsigned& nloc, unsigned& nx) {
    const unsigned G = gridDim.x * gridDim.y * gridDim.z;
    unsigned sum, cnt, mine, sp = 0u;
    for (;;) {
        sum = 0u; cnt = 0u; mine = 0u;
#pragma unroll
        for (unsigned j = 0; j < 16; ++j) { const unsigned c = xb_ld(&bar[XB_XCNT(j)]); sum += c; cnt += (c > 0u) ? 1u : 0u; mine = (j == x) ? c : mine; }
        if (sum == G) break;
        __builtin_amdgcn_s_sleep(1);
        if ((++sp & 255u) == 0u) { if (xb_ld(&bar[XB_TMO])) break; if (sp > XB_SPIN_CAP) { atomicAdd(&bar[XB_TMO], 1u); break; } }
    }
    nloc = mine > 0u ? mine : 1u; nx = cnt > 0u ? cnt : 1u;
}
__device__ __forceinline__ void xcd_barrier(const XcdBarrier& b) {
    asm volatile("s_waitcnt vmcnt(0)" ::: "memory");
    __syncthreads();
    if (threadIdx.x == 0) {
        unsigned bz_ = 0u, bx = b.x;
        asm volatile("" : "+s"(bz_), "+s"(bx)); unsigned* bar = b.bar + bz_;
        __builtin_amdgcn_s_waitcnt(0);
        unsigned nloc = b.st[0], nx = b.st[1];
        if (nloc == 0u) { xcd_barrier_complete(bar, bx, nloc, nx); b.st[0] = nloc; b.st[1] = nx; }
        const unsigned old = xb_add(&bar[XB_XSUB(bx)], 1u);
        const unsigned gen = old / nloc;
        if (old + 1u == (gen + 1u) * nloc) {
            __builtin_amdgcn_fence(__ATOMIC_RELEASE, "agent");
            asm volatile("s_waitcnt vmcnt(0)" ::: "memory");
            const unsigned og = xb_add(&bar[XB_TOP], 1u);
            const unsigned tg = og / nx;
            if (og + 1u == (tg + 1u) * nx) xb_add(&bar[XB_TOPGEN], 1u);
            else XB_SPIN(xb_ld(&bar[XB_TOPGEN]) == tg, bar);
            __builtin_amdgcn_fence(__ATOMIC_ACQUIRE, "agent");
            xb_add(&bar[XB_XGEN(bx)], 1u);
            asm volatile("s_waitcnt vmcnt(0)" ::: "memory");
        } else {
            XB_SPIN(xb_ld(&bar[XB_XGEN(bx)]) == gen, bar);
            __builtin_amdgcn_fence(__ATOMIC_ACQUIRE, "agent");
            asm volatile("s_waitcnt vmcnt(0)" ::: "memory");
        }
    }
    __syncthreads();
}

#define PHASE_IDS() int t__ = threadIdx.x, b__ = blockIdx.x, g__ = gridDim.x; asm volatile("" : "+v"(t__)); asm volatile("" : "+s"(b__), "+s"(g__)); \
    size_t wz_ = 0; asm volatile("" : "+s"(wz_)); unsigned char* ws = p.ws + wz_;     \
    const int tid = t__, lane = tid & 63, wave = __builtin_amdgcn_readfirstlane(tid >> 6), bid = b__, G = g__; (void)lane; (void)wave; (void)bid; (void)G
__global__ void __launch_bounds__(512, 2) fwd_megakernel(Params p) {
    extern __shared__ __attribute__((aligned(16))) unsigned char lds_raw[];
    LAS unsigned char* lds = (LAS unsigned char*)lds_raw;
    cg::grid_group grid = cg::this_grid();
    volatile LAS unsigned* bst = (volatile LAS unsigned*)(lds + LDS_BYTES - 16);
    if (threadIdx.x < 4) bst[threadIdx.x] = 0u;
    __syncthreads();
    const XcdBarrier xbar = xcd_barrier_post((unsigned*)(p.ws + WS_BAR), bst);
    unsigned long long tacc_ = 0ull, t0_ = 0ull; (void)t0_; (void)tacc_;
#define TS_BEGIN(k) do { if (PROBE_TS == (k)) t0_ = __builtin_amdgcn_s_memrealtime(); } while (0)
#define TS_END(k) do { if (PROBE_TS == (k)) tacc_ += __builtin_amdgcn_s_memrealtime() - t0_; } while (0)
#define GSYNC() do { TS_BEGIN(7); xcd_barrier(xbar); if (PROBE_DUP == 7) xcd_barrier(xbar); TS_END(7); } while (0)
    const unsigned long long tstart_ = (PROBE_TS == 8) ? __builtin_amdgcn_s_memrealtime() : 0ull; (void)tstart_;
    TS_BEGIN(9);
#ifndef SKIP_P0
    { PHASE_IDS(); phase0(p, lds, tid, bid, G); __syncthreads(); conv_weights(p, lds, 0, tid, lane, wave, bid, G); }
#endif
    TS_END(9);
    grid.sync();
#pragma unroll 1
    for (int l = 0; l < DEPTH; ++l) {
        const bool last = (l == DEPTH - 1);
        TS_BEGIN(1);
#ifndef SKIP_P1
        for (int rep = (PROBE_DUP == 1 ? 0 : 1); rep < 2; ++rep) { PHASE_IDS(); h_rows(p, l, lane, wave, bid, G); }
#endif
        TS_END(1);
        GSYNC();
        TS_BEGIN(2);
#ifndef SKIP_P2
#pragma unroll 1
        for (int rep = (PROBE_DUP == 2 ? 0 : 1); rep < 2; ++rep) { PHASE_IDS();
          pg8::Gemm g{(const bf16_t*)(ws + WS_H), (const bf16_t*)(ws + ((l & 1) ? WS_W1 : WS_W) + W_IN_OFF), MT, NIN, 1024, 1024}; pg8::StaticOrder S; S.init(MT, NIN, G, bid);
          pg8::EpiProj E{(bf16_t*)(ws + WS_G), (bf16_t*)(ws + WS_Z), (bf16_t*)(ws + WS_U), (bf16_t*)(ws + WS_QKV), (bf16_t*)(ws + WS_GT), (const float*)(ws + WS_ROPE), p.in[9] + l * 64, p.in[10] + l * 64};
          pg8::gemm_phase<pg8::EpiProj>(lds, g, S, E, tid); }
#endif
        TS_END(2);
        GSYNC();
        TS_BEGIN(3);
#ifndef SKIP_P3
#pragma unroll 1
        for (int rep = 1; rep < 2; ++rep) { PHASE_IDS(); const bool dry = false;
          bf16_t* Zb = (bf16_t*)(ws + WS_Z); const bf16_t* QKVb = (const bf16_t*)(ws + WS_QKV);
          const int n_attn = last ? 1024 : 1056, n_f1 = 256, n_sgu = last ? 256 : 264, total = n_attn + n_f1 + n_sgu;
          const float* sinkl = p.in[11] + l * 8; const float* sgub = p.in[8] + l * 512; const float m0 = ((const float*)(ws + WS_ROPE + 131072))[l];
          unsigned* f1cnt = (unsigned*)(ws + WS_BAR) + 3584 + 64 * (l * 4);
          for (int item = bid; item < total; item += G) {
              int tid = t__; asm volatile("" : "+v"(tid)); const int lane = tid & 63;
              if (item < n_f1) { f1_item(lds, (const bf16_t*)(ws + WS_G), (bf16_t*)(ws + WS_H), (const bf16_t*)(ws + WS_T128), item >> 6, item & 63, tid, lane, wave);
                                 asm volatile("s_waitcnt vmcnt(0)" ::: "memory"); __syncthreads();
                                 if (tid == 0) __hip_atomic_fetch_add(f1cnt + 64 * (item >> 6), 1u, __ATOMIC_RELAXED, __HIP_MEMORY_SCOPE_AGENT); }
              else if (item < n_f1 + n_attn) { const int ia = item - n_f1; const bool ic = ia >= 1024; const int i2 = ia - 1024;
                                   attn_item(lds, QKVb, Zb, sinkl, m0, ic ? (i2 >> 3) : (ia >> 8), ic ? ((i2 >> 2) & 1) : ((ia >> 2) & 63), (ia >> 1) & 1, ia & 1, ic, tid, lane, wave, dry); }
              else { sgu_item(lds, (const bf16_t*)(ws + WS_U), Zb, (const bf16_t*)(ws + WS_SGUW), sgub, item - n_attn - n_f1, tid, lane, wave, dry); }
          }
          if (rep == 1) {
              __syncthreads();
              if (tid == 0) { unsigned sp = 0;
                  while (__hip_atomic_load(f1cnt, __ATOMIC_RELAXED, __HIP_MEMORY_SCOPE_AGENT) < 64u || __hip_atomic_load(f1cnt + 64, __ATOMIC_RELAXED, __HIP_MEMORY_SCOPE_AGENT) < 64u ||
                         __hip_atomic_load(f1cnt + 128, __ATOMIC_RELAXED, __HIP_MEMORY_SCOPE_AGENT) < 64u || __hip_atomic_load(f1cnt + 192, __ATOMIC_RELAXED, __HIP_MEMORY_SCOPE_AGENT) < 64u) {
                      __builtin_amdgcn_s_sleep(2); if (++sp > (1u << 20)) break; } }
              __syncthreads();
              __builtin_amdgcn_fence(__ATOMIC_ACQUIRE, "agent");
              asm volatile("s_waitcnt vmcnt(0)" ::: "memory");
              for (int wi = bid * 8 + wave; wi < 4096; wi += G * 8) f3_wave_item(lds + wave * 10240, (const bf16_t*)(ws + WS_H), Zb, (const bf16_t*)(ws + WS_T3), wi, lane, false);
              if (!last) { for (int item = (bid + G - 64 % G) % G; item < 32; item += G) fc_item(lds, (const bf16_t*)(ws + WS_G), Zb, (const bf16_t*)(ws + WS_TC), item, tid, lane, wave, false); }
              if (!last) { __syncthreads(); conv_weights(p, lds, l + 1, tid, lane, wave, bid, G); }
          }
        }
#endif
        TS_END(3);
        GSYNC();
        TS_BEGIN(5);
#ifndef SKIP_P5
        if (!last) { PHASE_IDS();
          for (int t = bid; t < 256; t += G) ctx_merge_tile((const bf16_t*)(ws + WS_Z), (const unsigned char*)(ws + WS_GT), (bf16_t*)(ws + WS_H), ws + ((l & 1) ? WS_W1 : WS_W), t, lane, wave); }
#pragma unroll 1
        for (int rep = (PROBE_DUP == 5 ? 0 : 1); rep < 2; ++rep) { PHASE_IDS();
          pg8::StaticOrder S; S.init(ML, 1024, G, bid);
          pg8::Gemm g{(const bf16_t*)(ws + WS_Z), (const bf16_t*)(ws + ((l & 1) ? WS_W1 : WS_W) + W_PA_OFF), ML, 1024, 1024, 1024};
          pg8::EpiMerge E{(const unsigned char*)(ws + WS_GT), (bf16_t*)(ws + WS_H)};
          pg8::gemm_phase<pg8::EpiMerge, true>(lds, g, S, E, tid); }
#endif
        TS_END(5);
        GSYNC();
        TS_BEGIN(6);
#ifndef SKIP_P6
#pragma unroll 1
        for (int rep = (PROBE_DUP == 6 ? 0 : 1); rep < 2; ++rep) { PHASE_IDS();
          const int Mrows = ML; pg8::StaticOrder S; S.init(Mrows, 1024, G, bid);
          pg8::Gemm g{(const bf16_t*)(ws + WS_H), (const bf16_t*)(ws + ((l & 1) ? WS_W1 : WS_W) + W_OUT_OFF), Mrows, 1024, 1024, 1024};
          float* XC = (float*)(ws + WS_XC);
          if (!last && rep == 1) { for (int t = bid; t < 256; t += G) ctx_out_tile((const bf16_t*)(ws + WS_H), (const bf16_t*)(ws + ((l & 1) ? WS_W1 : WS_W) + W_OUT_OFF), l == 0 ? p.in[2] : XC, XC, (const float*)(ws + WS_MOD) + (size_t)(l * 5 + 4) * 3072 + 2048, t, lane, wave); }
          pg8::EpiRes E{l == 0 ? p.in[0] : p.out, p.out, l == 0 ? p.in[2] : XC, XC, rep == 0 ? (const float*)(ws + WS_ROPE + 65536) : (const float*)(ws + WS_MOD) + (size_t)l * 5 * 3072};
          pg8::gemm_phase<pg8::EpiRes>(lds, g, S, E, tid); }
#endif
        TS_END(6);
        if (!last) GSYNC();
    }
    if (PROBE_TS != 0) {
        if (PROBE_TS == 8) tacc_ = __builtin_amdgcn_s_memrealtime() - tstart_;
        xcd_barrier(xbar);
        if (blockIdx.x == 0 && threadIdx.x == 0) p.out[0] += 0.3f + (float)tacc_ * (0.01f / PROBE_SCALE);
    }
}

extern "C" void kernel_launch(void* const* d_in, const int* in_sizes, int n_in, void* d_out, int out_size, void* d_ws, size_t ws_size, hipStream_t stream) {
    static int grid = 0;
    if (grid == 0) {
        if (n_in != 16 || ws_size < WS_END) { fprintf(stderr, "kernel_launch: unexpected inputs (n_in %d, ws %zu)\n", n_in, ws_size); grid = -1; return; }
        int dev = 0, cus = 0, per_cu = 0;
        hipGetDevice(&dev);
        hipDeviceGetAttribute(&cus, hipDeviceAttributeMultiprocessorCount, dev);
        hipFuncSetAttribute((const void*)fwd_megakernel, hipFuncAttributeMaxDynamicSharedMemorySize, LDS_BYTES);
        hipOccupancyMaxActiveBlocksPerMultiprocessor(&per_cu, (const void*)fwd_megakernel, 512, LDS_BYTES);
        if (per_cu < 1 || cus < 1) { fprintf(stderr, "kernel_launch: occupancy query gave %d blocks/CU on %d CUs\n", per_cu, cus); grid = -1; return; }
        grid = cus;
    }
    if (grid < 0) return;
    if (hipMemsetAsync((char*)d_ws + WS_BAR, 0, 20480, stream) != hipSuccess) { fprintf(stderr, "kernel_launch: memset of barrier words failed\n"); return; }
    Params p{};
    for (int i = 0; i < 16; ++i) p.in[i] = (const float*)d_in[i];
    p.out = (float*)d_out; p.ws = (unsigned char*)d_ws;
    void* args[] = {&p};
    hipError_t e = hipLaunchCooperativeKernel((const void*)fwd_megakernel, dim3(grid), dim3(512), args, LDS_BYTES, stream);
    if (e != hipSuccess) fprintf(stderr, "cooperative launch failed: %s (grid %d)\n", hipGetErrorString(e), grid);
}
```

```cpp
#include <hip/hip_runtime.h>
#include <hip/hip_cooperative_groups.h>
#include <cstdio>
#include <cstdint>
namespace cg = cooperative_groups;

#define LAS __attribute__((address_space(3)))
typedef unsigned short bf16_t;
typedef short bf16x8 __attribute__((ext_vector_type(8)));
typedef short s16x4 __attribute__((ext_vector_type(4)));
typedef float f32x4 __attribute__((ext_vector_type(4)));
typedef unsigned u32x4 __attribute__((ext_vector_type(4)));
typedef unsigned u32x2 __attribute__((ext_vector_type(2)));
typedef float f32x2_t __attribute__((ext_vector_type(2)));
typedef __bf16 bf16x2_t __attribute__((ext_vector_type(2)));

constexpr int DM = 1024, NB = 4, SEQ = 8192, DEPTH = 4, CTXL = 256;
constexpr int ML = NB * SEQ;
constexpr int MC = NB * CTXL;
constexpr int MT = ML + MC;
constexpr int INW = 5632;
constexpr int NIN = 5888;
constexpr float EPSV = 1e-6f;
constexpr float LOG2E = 1.4426950408889634f;

constexpr size_t MiB = 1u << 20;
constexpr size_t WS_MOD = 0;
constexpr size_t WS_ROPE = 256 * 1024;
constexpr size_t WS_T128 = 512 * 1024;
constexpr size_t WS_TC = 1 * MiB;
constexpr size_t WS_T3 = 2 * MiB;
constexpr size_t WS_SGUW = 4 * MiB;
constexpr size_t WS_BAR = 6 * MiB;
constexpr size_t WS_XC = 8 * MiB;
constexpr size_t WS_W = 16 * MiB;
constexpr size_t W_IN_OFF = 0, W_PA_OFF = (size_t)NIN * 1024 * 2, W_PB_OFF = W_PA_OFF + 1024 * 256 * 2, W_PC_OFF = W_PB_OFF + 1024 * 256 * 2, W_OUT_OFF = W_PC_OFF + 1024 * 512 * 2;
constexpr size_t WS_H = 32 * MiB;
constexpr size_t WS_G = 98 * MiB;
constexpr size_t WS_Z = 131 * MiB;
constexpr size_t WS_U = 197 * MiB;
constexpr size_t WS_QKV = 230 * MiB;
constexpr size_t WS_GT = 280 * MiB;
constexpr size_t WS_W1 = 478 * MiB;
constexpr size_t WS_END = 494 * MiB;
static_assert(W_OUT_OFF + 1024 * 1024 * 2 <= 16 * MiB, "weights fit");

constexpr int LDS_BYTES = 147456;
#ifndef PROBE_TS
#define PROBE_TS 0
#endif
#ifndef PROBE_SCALE
#define PROBE_SCALE 1000.f
#endif
#ifndef PROBE_DUP
#define PROBE_DUP 0
#endif

__device__ __forceinline__ unsigned cvtpk(float lo, float hi) { f32x2_t v = {lo, hi}; bf16x2_t b = __builtin_convertvector(v, bf16x2_t); return __builtin_bit_cast(unsigned, b); }
__device__ __forceinline__ float bflo(unsigned w) { return __uint_as_float(w << 16); }
__device__ __forceinline__ float bfhi(unsigned w) { return __uint_as_float(w & 0xffff0000u); }
__device__ __forceinline__ float silu_f(float v) { return v * __builtin_amdgcn_rcpf(1.f + __expf(-v)); }
__device__ __forceinline__ float sigm_f(float v) { return __builtin_amdgcn_rcpf(1.f + __expf(-v)); }
__device__ __forceinline__ unsigned pack4q(f32x4 v) {
    unsigned w = 0u;
    w = __builtin_amdgcn_cvt_pk_u8_f32(fmaxf(v[0] * 255.f, 1.f), 0u, w); w = __builtin_amdgcn_cvt_pk_u8_f32(fmaxf(v[1] * 255.f, 1.f), 1u, w);
    w = __builtin_amdgcn_cvt_pk_u8_f32(fmaxf(v[2] * 255.f, 1.f), 2u, w); w = __builtin_amdgcn_cvt_pk_u8_f32(fmaxf(v[3] * 255.f, 1.f), 3u, w); return w; }
__device__ __forceinline__ float ub0(unsigned w) { return (float)(w & 0xffu); }
__device__ __forceinline__ float ub1(unsigned w) { return (float)((w >> 8) & 0xffu); }
__device__ __forceinline__ float ub2(unsigned w) { return (float)((w >> 16) & 0xffu); }
__device__ __forceinline__ float ub3(unsigned w) { return (float)(w >> 24); }
typedef short v4i16_t __attribute__((ext_vector_type(4)));
__device__ __forceinline__ s16x4 lds_tr(const LAS unsigned char* p) { return __builtin_bit_cast(s16x4, __builtin_amdgcn_ds_read_tr16_b64_v4i16((LAS v4i16_t*)p)); }
__device__ __forceinline__ bf16x8 cat8(s16x4 a, s16x4 b) { return (bf16x8){a[0], a[1], a[2], a[3], b[0], b[1], b[2], b[3]}; }

namespace pg8 {
constexpr int BM = 256, BK = 64, HALF = 128, HTB = HALF * BK * 2, STAGE_BYTES = 8 * HTB, NXCD = 8, WGM = 8;
__host__ __device__ __forceinline__ int lds_byte(int r, int c) { const int st = (r >> 4) * 2 + (c >> 5), rr = r & 15, cc = c & 31, ob = rr * 64 + cc * 2; return st * 1024 + (ob ^ (((ob >> 9) & 1) << 5)); }
__host__ __device__ __forceinline__ void stage_rc(int b, int& R, int& C) { const int st = b / 1024, sb = b % 1024, swz = sb ^ (((sb >> 9) & 1) << 5); R = (st >> 1) * 16 + swz / 64; C = (st & 1) * 32 + (swz % 64) / 2; }
__host__ __device__ __forceinline__ int perm32(int rho) { const int n = rho >> 4, i = rho & 15; return 8 * (i >> 2) + 4 * n + (i & 3); }
struct Unit { int pm, pn; };
struct Gemm { const bf16_t* A; const bf16_t* Bt; int M, N, K, lda; };
struct StaticOrder {
    int nM, nN, nwg, G, c;
    __host__ __device__ void init(int M, int N, int G_, int c_) { nM = M / BM; nN = N / BM; nwg = nM * nN; G = G_; c = c_; }
    __host__ __device__ bool next(int i, Unit& u) const {
        const long L = (long)i * G + c; if (L >= nwg) return false;
        int wgid = (int)L; { const int q = nwg / NXCD, r = nwg % NXCD, xcd = wgid % NXCD, off = wgid / NXCD; wgid = (xcd < r ? xcd * (q + 1) : r * (q + 1) + (xcd - r) * q) + off; }
        const int nig = WGM * nN, gid = wgid / nig, fm = gid * WGM, gsz = (nM - fm) < WGM ? (nM - fm) : WGM;
        u.pm = fm + ((wgid % nig) % gsz); u.pn = (wgid % nig) / gsz; return true;
    }
};
template <class Epi, bool HOOK = false>
__device__ __forceinline__ void gemm_phase(LAS unsigned char* lds, const Gemm g, const StaticOrder& S, const Epi& E, const int tid) {
    const int wid = __builtin_amdgcn_readfirstlane(tid >> 6), lane = tid & 63, wr = wid >> 2, wc = wid & 3, fr = lane & 15, fq = lane >> 4;
    const int K = g.K, nt = K / BK, lda = g.lda;
    unsigned voffA[2], voffB[2];
#pragma unroll
    for (int i = 0; i < 2; ++i) { int R, C; stage_rc(tid * 16 + i * 8192, R, C); const int Rb = Epi::PERM ? ((R & ~31) + perm32(R & 31)) : R;
        voffA[i] = (unsigned)(R * lda + C) * 2u; voffB[i] = (unsigned)(Rb * K + C) * 2u; }
    const size_t kstep = (size_t)(BK * 2);
    const size_t hstepA = (size_t)HALF * lda * 2, hstepB = (size_t)HALF * K * 2;
    const size_t tstepA = 2 * hstepA, tstepB = 2 * hstepB;
    const unsigned ldsw = (unsigned)wid * 1024u;
    const int aoff = lds_byte(wr * 64 + fr, fq * 8), boff = lds_byte(wc * 32 + fr, fq * 8);
#define PG8_SA(b, h) (((b) * 2 + (h)) * HTB)
#define PG8_SB(b, h) ((4 + (b) * 2 + (h)) * HTB)
#define PG8_STAGE(bufoff, gbase, voff) do { _Pragma("unroll") for (int _i = 0; _i < 2; ++_i) \
        __builtin_amdgcn_global_load_lds((const unsigned*)((const char*)(gbase) + (voff)[_i]), (LAS unsigned*)(lds + (bufoff) + ldsw + _i * 8192), 16, 0, 0); } while (0)
#define PG8_LDA(dst, b, h) do { _Pragma("unroll") for (int m = 0; m < 4; ++m) _Pragma("unroll") for (int k = 0; k < 2; ++k) dst[m][k] = *(const LAS bf16x8*)(lds + PG8_SA(b, h) + aoff + m * 2048 + k * 1024); } while (0)
#define PG8_LDB(dst, b, h) do { _Pragma("unroll") for (int n = 0; n < 2; ++n) _Pragma("unroll") for (int k = 0; k < 2; ++k) dst[n][k] = *(const LAS bf16x8*)(lds + PG8_SB(b, h) + boff + n * 2048 + k * 1024); } while (0)
#define PG8_MMA(ai, bj, At, Bt) do { __builtin_amdgcn_s_setprio(1); _Pragma("unroll") for (int m = 0; m < 4; ++m) _Pragma("unroll") for (int n = 0; n < 2; ++n) _Pragma("unroll") for (int k = 0; k < 2; ++k) \
        acc[ai][bj][m][n] = __builtin_amdgcn_mfma_f32_16x16x32_bf16(Bt[n][k], At[m][k], acc[ai][bj][m][n], 0, 0, 0); __builtin_amdgcn_s_setprio(0); } while (0)
#define PG8_WAIT_V(n) asm volatile("s_waitcnt vmcnt(" #n ")" ::: "memory")
#define PG8_WAIT_L(n) asm volatile("s_waitcnt lgkmcnt(" #n ")" ::: "memory")
#define PG8_BAR __builtin_amdgcn_s_barrier()
#define PG8_SCHED __builtin_amdgcn_sched_barrier(0)
    Unit cur, nxt; int ui = 0;
    if (!S.next(0, cur)) return;
    f32x4 acc[2][2][4][2];
#pragma unroll
    for (int a = 0; a < 2; ++a)
#pragma unroll
        for (int b = 0; b < 2; ++b)
#pragma unroll
            for (int m = 0; m < 4; ++m)
#pragma unroll
                for (int n = 0; n < 2; ++n) acc[a][b][m][n] = (f32x4){0.f, 0.f, 0.f, 0.f};
    bf16x8 At[4][2], B0[2][2], B1[2][2];
    const char* cA = (const char*)g.A + (size_t)cur.pm * tstepA; const char* cB = (const char*)g.Bt + (size_t)cur.pn * tstepB;
    PG8_STAGE(PG8_SB(0, 0), cB, voffB); PG8_STAGE(PG8_SB(0, 1), cB + hstepB, voffB); PG8_STAGE(PG8_SA(0, 0), cA, voffA); PG8_STAGE(PG8_SA(0, 1), cA + hstepA, voffA);
    if (wr == 1) PG8_BAR;
    PG8_WAIT_V(2); PG8_BAR;
    PG8_STAGE(PG8_SB(1, 0), cB + kstep, voffB); PG8_STAGE(PG8_SA(1, 0), cA + kstep, voffA); PG8_STAGE(PG8_SB(1, 1), cB + hstepB + kstep, voffB);
    PG8_WAIT_V(6); PG8_BAR;
    for (;;) {
        const bool has_next = S.next(ui + 1, nxt);
        const char* nA = has_next ? (const char*)g.A + (size_t)nxt.pm * tstepA : cA; const char* nB = has_next ? (const char*)g.Bt + (size_t)nxt.pn * tstepB : cB;
        for (int t = 0; t < nt; t += 2) {
            if constexpr (HOOK) { if (t == 4 || t == 8) E.mid(acc, cur, t == 8, wr, wc, fr, fq); }
            const bool last = (t == nt - 2);
            const char* a1 = cA + (size_t)(t + 1) * kstep;
            const char* a2 = last ? nA : cA + (size_t)(t + 2) * kstep; const char* b2 = last ? nB : cB + (size_t)(t + 2) * kstep;
            const char* a3 = a2 + kstep; const char* b3 = b2 + kstep;
            PG8_LDB(B0, 0, 0); PG8_LDB(B1, 0, 1); PG8_SCHED; PG8_LDA(At, 0, 0); PG8_STAGE(PG8_SA(1, 1), a1 + hstepA, voffA);
            PG8_WAIT_V(8); PG8_WAIT_L(0); PG8_BAR; PG8_MMA(0, 0, At, B0); PG8_MMA(0, 1, At, B1); PG8_BAR; PG8_SCHED;
            PG8_LDA(At, 0, 1); PG8_STAGE(PG8_SB(0, 0), b2, voffB); PG8_STAGE(PG8_SB(0, 1), b2 + hstepB, voffB); PG8_STAGE(PG8_SA(0, 0), a2, voffA);
            PG8_WAIT_V(8); PG8_WAIT_L(0); PG8_BAR; PG8_MMA(1, 0, At, B0); PG8_MMA(1, 1, At, B1); PG8_BAR; PG8_SCHED;
            PG8_LDB(B0, 1, 0); PG8_LDB(B1, 1, 1); PG8_SCHED; PG8_LDA(At, 1, 0); PG8_STAGE(PG8_SA(0, 1), a2 + hstepA, voffA);
            PG8_WAIT_V(8); PG8_WAIT_L(0); PG8_BAR; PG8_MMA(0, 0, At, B0); PG8_MMA(0, 1, At, B1); PG8_BAR; PG8_SCHED;
            PG8_LDA(At, 1, 1); PG8_STAGE(PG8_SB(1, 0), b3, voffB); PG8_STAGE(PG8_SB(1, 1), b3 + hstepB, voffB); PG8_STAGE(PG8_SA(1, 0), a3, voffA);
            PG8_WAIT_V(8); PG8_WAIT_L(0); PG8_BAR; PG8_MMA(1, 0, At, B0); PG8_MMA(1, 1, At, B1); PG8_BAR; PG8_SCHED;
        }
        if (wr == 0) PG8_BAR;
        { Unit ue = cur; asm volatile("" : "+s"(ue.pm), "+s"(ue.pn));
          E(acc, ue, wr, wc, fr, fq); }
        if (!has_next) break;
#pragma unroll
        for (int a = 0; a < 2; ++a)
#pragma unroll
            for (int b = 0; b < 2; ++b)
#pragma unroll
                for (int m = 0; m < 4; ++m)
#pragma unroll
                    for (int n = 0; n < 2; ++n) acc[a][b][m][n] = (f32x4){0.f, 0.f, 0.f, 0.f};
        cur = nxt; cA = nA; cB = nB; ++ui;
        if (wr == 1) PG8_BAR;
    }
    PG8_WAIT_V(0);
    PG8_BAR;
#undef PG8_SA
#undef PG8_SB
#undef PG8_STAGE
#undef PG8_LDA
#undef PG8_LDB
#undef PG8_MMA
#undef PG8_WAIT_V
#undef PG8_WAIT_L
#undef PG8_BAR
#undef PG8_SCHED
}

struct EpiProj {
    static constexpr bool PERM = true;
    bf16_t *Gb, *Zb, *Ub, *QKVb, *GTb; const float *rope, *qg, *kg;
    __device__ __forceinline__ void operator()(const f32x4 (&acc)[2][2][4][2], const Unit& u, int wr, int wc, int fr, int fq) const {
        const int pn = u.pn;
        const int row0 = u.pm * BM + wr * 64 + fr;
        if (pn >= 6 && pn <= 8) {
            const bool isq = pn < 8;
            if (!isq && wc >= 2) {
#pragma unroll
                for (int ai = 0; ai < 2; ++ai)
#pragma unroll
                    for (int m = 0; m < 4; ++m) { bf16_t* rowp = QKVb + (size_t)(row0 + ai * HALF + m * 16) * 768 + 640 + (wc - 2) * 64 + 8 * fq;
#pragma unroll
                        for (int bj = 0; bj < 2; ++bj) { const f32x4 v0 = acc[ai][bj][m][0], v1 = acc[ai][bj][m][1];
                            u32x4 w; w.x = cvtpk(v0[0], v0[1]); w.y = cvtpk(v0[2], v0[3]); w.z = cvtpk(v1[0], v1[1]); w.w = cvtpk(v1[2], v1[3]);
                            *(u32x4*)(rowp + bj * 32) = w; } }
            } else {
                const int head = isq ? (pn - 6) * 4 + wc : wc;
                const float* gain = isq ? qg : kg;
                const int cbase = (isq ? 0 : 512) + head * 64 + 4 * fq;
                const float scale = isq ? 0.125f * LOG2E : 1.f;
                const bool dorope = u.pm < (ML / BM);
                const f32x4 g1a = *(const f32x4*)(gain + 4 * fq), g2a = *(const f32x4*)(gain + 16 + 4 * fq), g1b = *(const f32x4*)(gain + 32 + 4 * fq), g2b = *(const f32x4*)(gain + 48 + 4 * fq);
#pragma unroll
                for (int ai = 0; ai < 2; ++ai)
#pragma unroll
                    for (int m = 0; m < 4; ++m) { const int row = row0 + ai * HALF + m * 16;
                        f32x4 x1a = acc[ai][0][m][0], x2a = acc[ai][0][m][1], x1b = acc[ai][1][m][0], x2b = acc[ai][1][m][1];
                        float ss = 0.f;
#pragma unroll
                        for (int e = 0; e < 4; ++e) ss += (x1a[e] * x1a[e] + x2a[e] * x2a[e]) + (x1b[e] * x1b[e] + x2b[e] * x2b[e]);
                        ss += __shfl_xor(ss, 16); ss += __shfl_xor(ss, 32);
                        const float rinv = rsqrtf(ss * (1.f / 64.f) + EPSV);
                        x1a = x1a * rinv * g1a; x2a = x2a * rinv * g2a; x1b = x1b * rinv * g1b; x2b = x2b * rinv * g2b;
                        if (dorope) { const int t = row & (SEQ - 1);
                            const float* ra = rope + ((t >> 6) * 16 + 4 * fq) * 2; const f32x4 a0 = *(const f32x4*)ra, a1 = *(const f32x4*)(ra + 4);
                            const float* rb = rope + ((t & 63) * 16 + 4 * fq) * 2; const f32x4 b0 = *(const f32x4*)rb, b1 = *(const f32x4*)(rb + 4);
                            const f32x4 ca = {a0[0], a0[2], a1[0], a1[2]}, sa = {a0[1], a0[3], a1[1], a1[3]}, cb = {b0[0], b0[2], b1[0], b1[2]}, sb = {b0[1], b0[3], b1[1], b1[3]};
                            const f32x4 y1a = x1a * ca - x2a * sa, y2a = x2a * ca + x1a * sa, y1b = x1b * cb - x2b * sb, y2b = x2b * cb + x1b * sb;
                            x1a = y1a; x2a = y2a; x1b = y1b; x2b = y2b; }
                        x1a = x1a * scale; x2a = x2a * scale; x1b = x1b * scale; x2b = x2b * scale;
                        bf16_t* dp = QKVb + (size_t)row * 768 + cbase;
                        u32x2 w;
                        w.x = cvtpk(x1a[0], x1a[1]); w.y = cvtpk(x1a[2], x1a[3]); *(u32x2*)dp = w;
                        w.x = cvtpk(x2a[0], x2a[1]); w.y = cvtpk(x2a[2], x2a[3]); *(u32x2*)(dp + 16) = w;
                        w.x = cvtpk(x1b[0], x1b[1]); w.y = cvtpk(x1b[2], x1b[3]); *(u32x2*)(dp + 32) = w;
                        w.x = cvtpk(x2b[0], x2b[1]); w.y = cvtpk(x2b[2], x2b[3]); *(u32x2*)(dp + 48) = w; }
            }
            return;
        }
        bf16_t* base; int ld, c0, act;
        if (pn < 2) { base = Gb; ld = 512; c0 = pn * 256; act = 0; }
        else if (pn == 2) { base = Zb; ld = 1024; c0 = 0; act = 1; }
        else if (pn == 3) { base = Ub; ld = 512; c0 = 0; act = 0; }
        else if (pn == 4) { base = Ub; ld = 512; c0 = 256; act = 0; }
        else if (pn == 5) { base = Zb; ld = 1024; c0 = 256; act = 1; }
        else if (pn < 11) { base = Zb; ld = 1024; c0 = 512 + (pn - 9) * 256; act = 1; }
        else {
            unsigned char* gb8 = (unsigned char*)GTb + (size_t)row0 * 3072 + (pn - 11) * 256 + wc * 32 + 8 * fq;
#pragma unroll
            for (int ai = 0; ai < 2; ++ai)
#pragma unroll
                for (int m = 0; m < 4; ++m)
#pragma unroll
                    for (int bj = 0; bj < 2; ++bj) { f32x4 v0 = acc[ai][bj][m][0], v1 = acc[ai][bj][m][1];
#pragma unroll
                        for (int e = 0; e < 4; ++e) { v0[e] = sigm_f(v0[e]); v1[e] = sigm_f(v1[e]); }
                        u32x2 w; w.x = pack4q(v0); w.y = pack4q(v1);
                        *(u32x2*)(gb8 + (size_t)(ai * HALF + m * 16) * 3072 + bj * HALF) = w; }
            return; }
        const int col0 = c0 + wc * 32 + 8 * fq;
#pragma unroll
        for (int ai = 0; ai < 2; ++ai)
#pragma unroll
            for (int m = 0; m < 4; ++m) { bf16_t* rowp = base + (size_t)(row0 + ai * HALF + m * 16) * ld + col0;
#pragma unroll
                for (int bj = 0; bj < 2; ++bj) { f32x4 v0 = acc[ai][bj][m][0], v1 = acc[ai][bj][m][1];
                    if (act == 1) {
#pragma unroll
                        for (int e = 0; e < 4; ++e) { v0[e] = silu_f(v0[e]); v1[e] = silu_f(v1[e]); } }
                    else if (act == 2) {
#pragma unroll
                        for (int e = 0; e < 4; ++e) { v0[e] = sigm_f(v0[e]); v1[e] = sigm_f(v1[e]); } }
                    u32x4 w; w.x = cvtpk(v0[0], v0[1]); w.y = cvtpk(v0[2], v0[3]); w.z = cvtpk(v1[0], v1[1]); w.w = cvtpk(v1[2], v1[3]);
                    *(u32x4*)(rowp + bj * HALF) = w; } }
    }
};
struct EpiMerge {
    static constexpr bool PERM = true;
    const unsigned char* GT8; bf16_t* MG;
    __device__ __forceinline__ void mid(f32x4 (&acc)[2][2][4][2], const Unit& u, bool second, int wr, int wc, int fr, int fq) const {
        const int row0 = u.pm * BM + wr * 64 + fr, col0 = u.pn * BM + wc * 32 + 8 * fq + (second ? 1024 : 0);
        u32x2 nu[2][4][2], de[2][4][2];
#pragma unroll
        for (int ai = 0; ai < 2; ++ai)
#pragma unroll
            for (int m = 0; m < 4; ++m) { const unsigned char* gp = GT8 + (size_t)(row0 + ai * HALF + m * 16) * 3072 + col0;
#pragma unroll
                for (int bj = 0; bj < 2; ++bj) { nu[ai][m][bj] = *(const u32x2*)(gp + bj * HALF); de[ai][m][bj] = *(const u32x2*)(gp + 1024 + bj * HALF); } }
#pragma unroll
        for (int ai = 0; ai < 2; ++ai)
#pragma unroll
            for (int m = 0; m < 4; ++m)
#pragma unroll
                for (int bj = 0; bj < 2; ++bj) { const u32x2 n_ = nu[ai][m][bj], d_ = de[ai][m][bj];
                    f32x4& v0 = acc[ai][bj][m][0]; f32x4& v1 = acc[ai][bj][m][1];
                    v0[0] *= ub0(n_.x) * __builtin_amdgcn_rcpf(ub0(d_.x)); v0[1] *= ub1(n_.x) * __builtin_amdgcn_rcpf(ub1(d_.x));
                    v0[2] *= ub2(n_.x) * __builtin_amdgcn_rcpf(ub2(d_.x)); v0[3] *= ub3(n_.x) * __builtin_amdgcn_rcpf(ub3(d_.x));
                    v1[0] *= ub0(n_.y) * __builtin_amdgcn_rcpf(ub0(d_.y)); v1[1] *= ub1(n_.y) * __builtin_amdgcn_rcpf(ub1(d_.y));
                    v1[2] *= ub2(n_.y) * __builtin_amdgcn_rcpf(ub2(d_.y)); v1[3] *= ub3(n_.y) * __builtin_amdgcn_rcpf(ub3(d_.y)); }
        asm volatile("s_waitcnt vmcnt(0)" ::: "memory");
    }
    __device__ __forceinline__ void operator()(const f32x4 (&acc)[2][2][4][2], const Unit& u, int wr, int wc, int fr, int fq) const {
        const int row0 = u.pm * BM + wr * 64 + fr, col0 = u.pn * BM + wc * 32 + 8 * fq;
        constexpr float Q = 1.f / 255.f;
#pragma unroll
        for (int ai = 0; ai < 2; ++ai)
#pragma unroll
            for (int m = 0; m < 4; ++m) { const size_t row = (size_t)(row0 + ai * HALF + m * 16);
#pragma unroll
                for (int bj = 0; bj < 2; ++bj) { const int col = col0 + bj * HALF;
                    const u32x2 gw = *(const u32x2*)(GT8 + row * 3072 + 2048 + col);
                    f32x4 v0 = acc[ai][bj][m][0], v1 = acc[ai][bj][m][1];
                    v0[0] *= ub0(gw.x) * Q; v0[1] *= ub1(gw.x) * Q; v0[2] *= ub2(gw.x) * Q; v0[3] *= ub3(gw.x) * Q;
                    v1[0] *= ub0(gw.y) * Q; v1[1] *= ub1(gw.y) * Q; v1[2] *= ub2(gw.y) * Q; v1[3] *= ub3(gw.y) * Q;
                    u32x4 w; w.x = cvtpk(v0[0], v0[1]); w.y = cvtpk(v0[2], v0[3]); w.z = cvtpk(v1[0], v1[1]); w.w = cvtpk(v1[2], v1[3]);
                    *(u32x4*)(MG + row * 1024 + col) = w; } }
    }
};
struct EpiRes {
    static constexpr bool PERM = false;
    const float* xsrc; float* xdst; const float* csrc; float* cdst; const float* modl;
    __device__ __forceinline__ void operator()(const f32x4 (&acc)[2][2][4][2], const Unit& u, int wr, int wc, int fr, int fq) const {
        const int rbase = u.pm * BM + wr * 64 + fr;
        const int bi = rbase >> 13;
        const float* src = xsrc + (size_t)rbase * DM;
        float* dst = xdst + (size_t)rbase * DM;
        const int col0 = u.pn * BM + wc * 32 + 4 * fq;
        u32x2 up[2][2][2][4];
#pragma unroll
        for (int bj = 0; bj < 2; ++bj)
#pragma unroll
            for (int n = 0; n < 2; ++n) { const f32x4 gt = *(const f32x4*)(modl + bi * 3072 + 2048 + col0 + bj * HALF + n * 16);
#pragma unroll
                for (int ai = 0; ai < 2; ++ai)
#pragma unroll
                    for (int m = 0; m < 4; ++m) { const f32x4 v = gt * acc[ai][bj][m][n]; up[bj][n][ai][m].x = cvtpk(v[0], v[1]); up[bj][n][ai][m].y = cvtpk(v[2], v[3]); } }
        f32x4 xs[2][2][2][4];
#pragma unroll
        for (int bj = 0; bj < 2; ++bj)
#pragma unroll
            for (int n = 0; n < 2; ++n)
#pragma unroll
                for (int ai = 0; ai < 2; ++ai)
#pragma unroll
                    for (int m = 0; m < 4; ++m) xs[bj][n][ai][m] = *(const f32x4*)(src + (size_t)(ai * HALF + m * 16) * DM + col0 + bj * HALF + n * 16);
#pragma unroll
        for (int bj = 0; bj < 2; ++bj)
#pragma unroll
            for (int n = 0; n < 2; ++n)
#pragma unroll
                for (int ai = 0; ai < 2; ++ai)
#pragma unroll
                    for (int m = 0; m < 4; ++m) { const u32x2 w = up[bj][n][ai][m]; const f32x4 x = xs[bj][n][ai][m];
                        *(f32x4*)(dst + (size_t)(ai * HALF + m * 16) * DM + col0 + bj * HALF + n * 16) = (f32x4){x[0] + bflo(w.x), x[1] + bfhi(w.x), x[2] + bflo(w.y), x[3] + bfhi(w.y)}; }
    }
};
}

template <int NJ, int KC>
__device__ __forceinline__ void ag_load(bf16x8 (&bb)[KC][NJ], const bf16_t* tbase, int ldt, int ch) {
#pragma unroll
    for (int kk = 0; kk < KC; ++kk)
#pragma unroll
        for (int j = 0; j < NJ; ++j) bb[kk][j] = *(const bf16x8*)(tbase + (size_t)j * 16 * ldt + (ch * KC + kk) * 32);
}
template <int NI, int NJ, int KC>
__device__ __forceinline__ void ag_mma(f32x4 (&acc)[NI][NJ], const bf16x8 (&bb)[KC][NJ], const LAS unsigned char* abase, int RS, int ch) {
#pragma unroll
    for (int kk = 0; kk < KC; ++kk) { const LAS unsigned char* ap = abase + (ch * KC + kk) * 32 * RS;
        bf16x8 a[NI];
#pragma unroll
        for (int i = 0; i < NI; ++i) { const s16x4 lo = lds_tr(ap + i * 32), hi = lds_tr(ap + 4 * RS + i * 32); a[i] = cat8(lo, hi); }
#pragma unroll
        for (int i = 0; i < NI; ++i)
#pragma unroll
            for (int j = 0; j < NJ; ++j) acc[i][j] = __builtin_amdgcn_mfma_f32_16x16x32_bf16(a[i], bb[kk][j], acc[i][j], 0, 0, 0);
    }
}
template <int NI, int NJ, int KS, int KC>
__device__ __forceinline__ void act_gemm(f32x4 (&acc)[NI][NJ], const LAS unsigned char* act, int RS, int n0, const bf16_t* tab, int ldt, int lane) {
    constexpr int NC = KS / KC;
    static_assert(NC == 1 || NC % 2 == 0, "chunk count");
    const int g = lane >> 4, c = lane & 15;
    const LAS unsigned char* abase = act + (8 * g + (c >> 2)) * RS + (n0 + 4 * (c & 3)) * 2;
    const bf16_t* tbase = tab + (size_t)c * ldt + 8 * g;
    bf16x8 b0[KC][NJ];
    ag_load<NJ, KC>(b0, tbase, ldt, 0);
    if constexpr (NC == 1) { ag_mma<NI, NJ, KC>(acc, b0, abase, RS, 0); }
    else {
        bf16x8 b1[KC][NJ];
#pragma unroll 1
        for (int ch = 0; ch < NC; ch += 2) {
            ag_load<NJ, KC>(b1, tbase, ldt, ch + 1);
            ag_mma<NI, NJ, KC>(acc, b0, abase, RS, ch);
            if (ch + 2 < NC) ag_load<NJ, KC>(b0, tbase, ldt, ch + 2);
            ag_mma<NI, NJ, KC>(acc, b1, abase, RS, ch + 1);
        }
    }
}
template <int NI, int NJ> __device__ __forceinline__ void zero_acc(f32x4 (&acc)[NI][NJ]) {
#pragma unroll
    for (int i = 0; i < NI; ++i)
#pragma unroll
        for (int j = 0; j < NJ; ++j) acc[i][j] = (f32x4){0.f, 0.f, 0.f, 0.f};
}
__device__ __forceinline__ void mul_store4z(bf16_t* p, f32x4 v, u32x2 z, bool dry = false) {
    if (dry && v[0] != 1.2345e30f) return;
    u32x2 o; o.x = cvtpk(v[0] * bflo(z.x), v[1] * bfhi(z.x)); o.y = cvtpk(v[2] * bflo(z.y), v[3] * bfhi(z.y));
    *(u32x2*)p = o;
}
__device__ __forceinline__ void mul_store4(bf16_t* p, f32x4 v, bool dry = false) {
    if (dry && v[0] != 1.2345e30f) return;
    const u32x2 z = *(const u32x2*)p;
    u32x2 o; o.x = cvtpk(v[0] * bflo(z.x), v[1] * bfhi(z.x)); o.y = cvtpk(v[2] * bflo(z.y), v[3] * bfhi(z.y));
    *(u32x2*)p = o;
}

struct Params { const float* in[16]; float* out; unsigned char* ws; };

__device__ __forceinline__ void phase0(const Params& p, LAS unsigned char* lds, int tid, int bid, int G) {
    LAS float* sc = (LAS float*)lds;
    LAS float* red = (LAS float*)(lds + 20480);
    for (int i = tid; i < 5120; i += 512) { const float v = i < 4096 ? p.in[1][i] : p.in[3][i - 4096]; sc[i] = v / (1.f + expf(-v)); }
    __syncthreads();
    float* mod = (float*)(p.ws + WS_MOD);
    for (int item = bid; item < 192; item += G) {
        const int l = item / 48, cgp = item % 48, col = tid & 63, kg = tid >> 6, n = cgp * 64 + col;
        const float* w = p.in[4] + ((size_t)l * 1024 + kg * 128) * 3072 + n;
        float a0 = 0.f, a1 = 0.f, a2 = 0.f, a3 = 0.f, a4 = 0.f;
#pragma unroll 8
        for (int k = 0; k < 128; ++k) { const float wv = w[(size_t)k * 3072]; const int kk = kg * 128 + k;
            a0 += sc[kk] * wv; a1 += sc[1024 + kk] * wv; a2 += sc[2048 + kk] * wv; a3 += sc[3072 + kk] * wv; a4 += sc[4096 + kk] * wv; }
        red[(kg * 5 + 0) * 64 + col] = a0; red[(kg * 5 + 1) * 64 + col] = a1; red[(kg * 5 + 2) * 64 + col] = a2; red[(kg * 5 + 3) * 64 + col] = a3; red[(kg * 5 + 4) * 64 + col] = a4;
        __syncthreads();
        if (tid < 320) { const int bi = tid >> 6, c2 = tid & 63; float s = 0.f;
#pragma unroll
            for (int k2 = 0; k2 < 8; ++k2) s += red[(k2 * 5 + bi) * 64 + c2];
            mod[(l * 5 + bi) * 3072 + cgp * 64 + c2] = s + p.in[5][l * 3072 + cgp * 64 + c2]; }
        __syncthreads();
    }
    const int gt = bid * 512 + tid, NT = G * 512;
    float* rope = (float*)(p.ws + WS_ROPE);
    for (int i = gt; i < 5 * 3072; i += NT) ((float*)(p.ws + WS_ROPE + 65536))[i] = 0.f;
    for (int i = gt; i < 2048; i += NT) { const int pos = i >> 4, fi = i & 15; const float inv = exp2f(-(float)fi * (13.287712379549449f / 16.f)); const float ang = (float)pos * inv;
        const double rev = (double)ang * 0.15915494309189535; const double frc = rev - floor(rev); float s, c; sincospif((float)(2.0 * frc), &s, &c); rope[2 * i] = c; rope[2 * i + 1] = s; }
    if (gt < DEPTH * 64) {
        const int l = gt >> 6, d = gt & 63; float mq = fabsf(p.in[9][l * 64 + d]), mk = fabsf(p.in[10][l * 64 + d]);
#pragma unroll
        for (int o = 1; o < 64; o <<= 1) { mq = fmaxf(mq, __shfl_xor(mq, o)); mk = fmaxf(mk, __shfl_xor(mk, o)); }
        if (d == 0) ((float*)(p.ws + WS_ROPE + 131072))[l] = 8.f * LOG2E * mq * mk * 1.02f; }
    bf16_t* t128 = (bf16_t*)(p.ws + WS_T128);
    for (int i = gt; i < 65536; i += NT) { const int m = i >> 8, k = i & 255, part = m >> 7, k1 = m & 127, pp = k >> 7, l1 = k & 127; const int j = (l1 * k1) & 127; float s, c; sincospif((float)j / 64.f, &s, &c);
        const float v = (part == pp) ? c : (part == 0 ? s : -s); t128[i] = (bf16_t)(cvtpk(v, 0.f) & 0xffffu); }
    bf16_t* tc = (bf16_t*)(p.ws + WS_TC);
    for (int i = gt; i < 256 * 512; i += NT) { const int kk = i >> 9, k = i & 511, part = k >> 8, ll = k & 255; const int j = (kk * ll) & 255; float s, c; sincospif((float)j / 128.f, &s, &c);
        const float v = (part ? s : c) * 0.0625f; tc[i] = (bf16_t)(cvtpk(v, 0.f) & 0xffffu); }
    bf16_t* t3 = (bf16_t*)(p.ws + WS_T3);
    for (int i = gt; i < 128 * 64 * 128; i += NT) { const int k1 = i >> 13, k2 = (i >> 7) & 63, kp = i & 127, l2 = kp >> 1, part = kp & 1; const int j = (l2 * (k1 + 128 * k2)) & 8191; float s, c; sincospif((float)j / 4096.f, &s, &c);
        const float v = (part ? s : c) * 0.011048543456039806f; t3[i] = (bf16_t)(cvtpk(v, 0.f) & 0xffffu); }
}

__device__ __forceinline__ void transpose_blk(const float* Wsrc, int ldw, int K, bf16_t* WTdst, int kb, int perm, LAS float* scr, int lane) {
    const int k0 = 64 * kb;
    f32x4 wv[8];
#pragma unroll
    for (int i = 0; i < 8; ++i) wv[i] = *(const f32x4*)(Wsrc + (size_t)(k0 + 8 * i + (lane >> 3)) * ldw + 4 * (lane & 7));
#pragma unroll
    for (int i = 0; i < 8; ++i) { LAS float* d = scr + (8 * i + (lane >> 3)) * 33 + 4 * (lane & 7); d[0] = wv[i][0]; d[1] = wv[i][1]; d[2] = wv[i][2]; d[3] = wv[i][3]; }
    asm volatile("s_waitcnt lgkmcnt(0)" ::: "memory");
    const int c = lane & 7;
#pragma unroll
    for (int j = 0; j < 4; ++j) { const int n = (lane >> 3) + 8 * j; const int sc = perm ? (16 * ((n >> 2) & 1) + 4 * (n >> 3) + (n & 3)) : n; const LAS float* s = scr + (8 * c) * 33 + sc;
        u32x4 o; o.x = cvtpk(s[0 * 33], s[1 * 33]); o.y = cvtpk(s[2 * 33], s[3 * 33]); o.z = cvtpk(s[4 * 33], s[5 * 33]); o.w = cvtpk(s[6 * 33], s[7 * 33]);
        *(u32x4*)(WTdst + (size_t)n * K + k0 + 8 * c) = o; }
    asm volatile("s_waitcnt lgkmcnt(0)" ::: "memory");
}
__device__ __forceinline__ void conv_weights(const Params& p, LAS unsigned char* lds, int l, int tid, int lane, int wave, int bid, int G) {
    unsigned char* wsW = p.ws + ((l & 1) ? WS_W1 : WS_W);
    bf16_t* WinT = (bf16_t*)(wsW + W_IN_OFF);
    LAS float* scr = (LAS float*)(lds + wave * 8448);
    LAS float* ctab = (LAS float*)(lds + 8 * 8448);
    if (tid < 64) { float s, c; sincospif((float)tid / 32.f, &s, &c); ctab[tid] = c * 0.125f; ctab[64 + tid] = s * 0.125f; }
    __syncthreads();
    const int gw = bid * 8 + wave, NGW = G * 8;
    const float* win = p.in[6] + (size_t)l * 1024 * INW;
    constexpr int I_IN = 16 * 168, I_PA = 4 * 32, I_PC = 8 * 32, I_OUT = 16 * 32;
    for (int it = gw; it < I_IN + 2 * I_PA + I_PC + I_OUT; it += NGW) {
        int r = it;
        if (r < I_IN) { const int rb = 16 + r % 168, kb = r / 168, n = rb * 32; int c0, perm = 0;
            if (n < 1536 || n >= 2304) c0 = n - 256;
            else if (n < 2048) { const int t = n - 1536, tile = t >> 8, tt = t & 255, bj = tt >> 7, wc = (tt >> 5) & 3; c0 = 1280 + (tile * 4 + wc) * 64 + 32 * bj; perm = 1; }
            else { const int tt = n - 2048, bj = tt >> 7, wc = (tt >> 5) & 3; if (wc < 2) { c0 = 1792 + wc * 64 + 32 * bj; perm = 1; } else c0 = 1920 + (wc - 2) * 64 + 32 * bj; }
            transpose_blk(win + c0, INW, 1024, WinT + (size_t)n * 1024, kb, perm, scr, lane); continue; } r -= I_IN;
        if (r < I_PA) { transpose_blk(p.in[12] + (size_t)l * 256 * 1024 + 32 * (r & 31), 1024, 1024, (bf16_t*)(wsW + W_PA_OFF) + (size_t)32 * (r & 31) * 1024, r >> 5, 0, scr, lane); continue; } r -= I_PA;
        if (r < I_PA) { transpose_blk(p.in[13] + (size_t)l * 256 * 1024 + 32 * (r & 31), 1024, 1024, (bf16_t*)(wsW + W_PA_OFF) + (size_t)32 * (r & 31) * 1024 + 256, r >> 5, 0, scr, lane); continue; } r -= I_PA;
        if (r < I_PC) { transpose_blk(p.in[14] + (size_t)l * 512 * 1024 + 32 * (r & 31), 1024, 1024, (bf16_t*)(wsW + W_PA_OFF) + (size_t)32 * (r & 31) * 1024 + 512, r >> 5, 0, scr, lane); continue; } r -= I_PC;
        transpose_blk(p.in[15] + (size_t)l * 1024 * 1024 + 32 * (r & 31), 1024, 1024, (bf16_t*)(wsW + W_OUT_OFF) + (size_t)32 * (r & 31) * 1024, r >> 5, 0, scr, lane);
    }
    const int gtid = (G - 1 - bid) * 512 + tid, NT = G * 512;
    for (int id = gtid; id < 65536; id += NT) {
        const int n = id >> 7, ko = id & 127, part = n >> 8, grp = (n >> 6) & 3, m = n & 63;
        const LAS float* tb = ctab + part * 64;
        const float* wrow = win + (size_t)(ko * 8) * INW + grp * 64;
        float a[8];
#pragma unroll
        for (int j = 0; j < 8; ++j) a[j] = 0.f;
#pragma unroll 4
        for (int c4 = 0; c4 < 16; ++c4) {
            const float t0 = tb[(m * (4 * c4)) & 63], t1 = tb[(m * (4 * c4 + 1)) & 63], t2 = tb[(m * (4 * c4 + 2)) & 63], t3 = tb[(m * (4 * c4 + 3)) & 63];
#pragma unroll
            for (int j = 0; j < 8; ++j) { const f32x4 wv = *(const f32x4*)(wrow + (size_t)j * INW + c4 * 4); a[j] += wv[0] * t0 + wv[1] * t1 + wv[2] * t2 + wv[3] * t3; }
        }
        const float sg = part ? -1.f : 1.f;
        u32x4 o; o.x = cvtpk(sg * a[0], sg * a[1]); o.y = cvtpk(sg * a[2], sg * a[3]); o.z = cvtpk(sg * a[4], sg * a[5]); o.w = cvtpk(sg * a[6], sg * a[7]);
        *(u32x4*)(WinT + (size_t)n * 1024 + ko * 8) = o;
    }
    { const float* sw = p.in[7] + (size_t)l * 65536; bf16_t* dw = (bf16_t*)(p.ws + WS_SGUW);
      for (int id = gtid; id < 8192; id += NT) { const f32x4 v0 = *(const f32x4*)(sw + id * 8), v1 = *(const f32x4*)(sw + id * 8 + 4);
          u32x4 o; o.x = cvtpk(v0[0], v0[1]); o.y = cvtpk(v0[2], v0[3]); o.z = cvtpk(v1[0], v1[1]); o.w = cvtpk(v1[2], v1[3]); *(u32x4*)(dw + id * 8) = o; } }
}
__device__ __forceinline__ void h_rows(const Params& p, int l, int lane, int wave, int bid, int G) {
    const int gw = bid * 8 + wave, NGW = G * 8;
    const float* xs = l == 0 ? p.in[0] : p.out;
    const float* cs = l == 0 ? p.in[2] : (const float*)(p.ws + WS_XC);
    const float* mod = (const float*)(p.ws + WS_MOD) + (size_t)l * 5 * 3072;
    bf16_t* H = (bf16_t*)(p.ws + WS_H);
    for (int row0 = gw * 4; row0 < MT; row0 += NGW * 4) {
        const float* src = row0 < ML ? xs + (size_t)row0 * DM : cs + (size_t)(row0 - ML) * DM;
        const int bi = row0 < ML ? (row0 >> 13) : 4;
        const float* md = mod + bi * 3072;
        f32x4 v[4][4]; float ss[4];
#pragma unroll
        for (int r = 0; r < 4; ++r)
#pragma unroll
            for (int j = 0; j < 4; ++j) v[r][j] = *(const f32x4*)(src + (size_t)r * DM + 4 * lane + 256 * j);
#pragma unroll
        for (int r = 0; r < 4; ++r) { ss[r] = 0.f;
#pragma unroll
            for (int j = 0; j < 4; ++j) ss[r] += (v[r][j][0] * v[r][j][0] + v[r][j][1] * v[r][j][1]) + (v[r][j][2] * v[r][j][2] + v[r][j][3] * v[r][j][3]); }
#pragma unroll
        for (int o = 1; o < 64; o <<= 1) {
#pragma unroll
            for (int r = 0; r < 4; ++r) ss[r] += __shfl_xor(ss[r], o); }
#pragma unroll
        for (int j = 0; j < 4; ++j) { const int idx = 4 * lane + 256 * j; const f32x4 sh = *(const f32x4*)(md + idx), scl = *(const f32x4*)(md + 1024 + idx) + 1.f;
#pragma unroll
            for (int r = 0; r < 4; ++r) { const float rinv = rsqrtf(ss[r] * (1.f / 1024.f) + EPSV);
                const f32x4 o = v[r][j] * rinv * scl + sh; u32x2 w; w.x = cvtpk(o[0], o[1]); w.y = cvtpk(o[2], o[3]); *(u32x2*)(H + (size_t)(row0 + r) * DM + idx) = w; } }
    }
}

__device__ __forceinline__ void attn_item(LAS unsigned char* lds, const bf16_t* QKV, bf16_t* Z, const float* sinkl, const float m0,
                                          int b, int blk, int kvh, int hp, bool isctx, int tid, int lane, int wave, bool dry = false) {
    constexpr int RS = 144;
    LAS unsigned char* Qs = lds; LAS unsigned char* Ks = lds + 256 * RS; LAS unsigned char* Vs = Ks + 128 * RS;
    const int qrow0 = isctx ? (ML + b * 256 + blk * 128) : (b * SEQ + blk * 128);
    const int hl = wave >> 2, qq = wave & 3, gq = hp * 2 + hl, g = lane >> 4, c = lane & 15;
    u32x4 qreg[4];
#pragma unroll
    for (int it = 0; it < 4; ++it) { const int id = it * 512 + tid, r = id >> 3, c16 = id & 7;
        qreg[it] = *(const u32x4*)(QKV + (size_t)(qrow0 + (r & 127)) * 768 + (kvh * 4 + hp * 2 + (r >> 7)) * 64 + c16 * 8); }
    u32x2 zreg[2][4];
#pragma unroll
    for (int qi = 0; qi < 2; ++qi)
#pragma unroll
        for (int df = 0; df < 4; ++df) zreg[qi][df] = *(const u32x2*)(Z + (size_t)(qrow0 + qq * 32 + 16 * qi + c) * 1024 + 512 + (kvh * 4 + gq) * 64 + 16 * df + 4 * g);
    const LAS unsigned char* qbase = Qs + (hl * 128 + qq * 32 + c) * RS + 16 * g;
    f32x4 O[4][2]; float l_run[2];
    const float sinkv = sinkl[kvh * 4 + gq] * LOG2E;
    const float mshift = fmaxf(m0, sinkv), nm = -mshift;
    const f32x4 negm = {nm, nm, nm, nm};
#pragma unroll
    for (int qi = 0; qi < 2; ++qi) { l_run[qi] = (g == 0) ? __builtin_amdgcn_exp2f(sinkv - mshift) : 0.f;
#pragma unroll
        for (int df = 0; df < 4; ++df) O[df][qi] = (f32x4){0.f, 0.f, 0.f, 0.f}; }
    const LAS unsigned char* vbase = Vs + (4 * g + (c >> 2)) * RS + (4 * (c & 3)) * 2;
    const int kvoff = 512 + kvh * 64 + (tid & 7) * 8, kr0 = tid >> 3;
    int ti = isctx ? 3 : (blk == 0 ? 1 : 0);
    u32x4 kreg[2], vreg[2];
#define ATT_KROW(t) ((t) >= 3 ? ML + b * 256 + ((t) - 3) * 128 : qrow0 + ((t) - 1) * 128)
#define ATT_PRELOAD(t) do { const bf16_t* src_ = QKV + (size_t)(ATT_KROW(t) + kr0) * 768 + kvoff; \
        kreg[0] = *(const u32x4*)src_; vreg[0] = *(const u32x4*)(src_ + 128); kreg[1] = *(const u32x4*)(src_ + (size_t)64 * 768); vreg[1] = *(const u32x4*)(src_ + (size_t)64 * 768 + 128); } while (0)
    ATT_PRELOAD(ti);
    __syncthreads();
#pragma unroll
    for (int it = 0; it < 4; ++it) { const int id = it * 512 + tid; *(LAS u32x4*)(Qs + (id >> 3) * RS + (id & 7) * 16) = qreg[it]; }
#pragma unroll 1
    while (ti < 5) {
        int tn = ti + 1; if (tn == 2 && blk == 63) tn = 3;
        __syncthreads();
#pragma unroll
        for (int it = 0; it < 2; ++it) { *(LAS u32x4*)(Ks + (kr0 + 64 * it) * RS + (tid & 7) * 16) = kreg[it]; *(LAS u32x4*)(Vs + (kr0 + 64 * it) * RS + (tid & 7) * 16) = vreg[it]; }
        if (tn < 5) ATT_PRELOAD(tn);
        __syncthreads();
        const int ks_lo = (ti == 0) ? qq : 0, ks_hi = (ti == 2) ? qq + 1 : 4;
        const int sg = (ti == 0) ? 1 : -1;
        bf16x8 qf[2][2];
#pragma unroll
        for (int qi = 0; qi < 2; ++qi) { qf[qi][0] = *(const LAS bf16x8*)(qbase + (16 * qi) * RS); qf[qi][1] = *(const LAS bf16x8*)(qbase + (16 * qi) * RS + 64); }
        int base0 = sg * (4 * g - (qq * 32 + c)); asm volatile("" : "+v"(base0));
        float psum[2] = {0.f, 0.f};
        if (ti == 0 || ti == 2) {
#pragma unroll
        for (int ks = 0; ks < 4; ++ks) {
            if (ks >= ks_lo && ks < ks_hi) {
                asm volatile("" ::: "memory");
                const LAS unsigned char* kp = Ks + (32 * ks + c) * RS + 16 * g;
                const bf16x8 ka0 = *(const LAS bf16x8*)kp, ka1 = *(const LAS bf16x8*)(kp + 64), kb0 = *(const LAS bf16x8*)(kp + 16 * RS), kb1 = *(const LAS bf16x8*)(kp + 16 * RS + 64);
                bf16x8 pf[2];
#pragma unroll
                for (int qi = 0; qi < 2; ++qi) {
                    f32x4 s0 = __builtin_amdgcn_mfma_f32_16x16x32_bf16(ka0, qf[qi][0], negm, 0, 0, 0);
                    s0 = __builtin_amdgcn_mfma_f32_16x16x32_bf16(ka1, qf[qi][1], s0, 0, 0, 0);
                    f32x4 s1 = __builtin_amdgcn_mfma_f32_16x16x32_bf16(kb0, qf[qi][0], negm, 0, 0, 0);
                    s1 = __builtin_amdgcn_mfma_f32_16x16x32_bf16(kb1, qf[qi][1], s1, 0, 0, 0);
                    if (ti == 0 || ti == 2) {
                        const int base = base0 - sg * 16 * qi;
#pragma unroll
                        for (int r = 0; r < 4; ++r) { const int l0 = -sg * (32 * ks + r), l1 = -sg * (32 * ks + 16 + r); s0[r] = (base < l0) ? -1e30f : s0[r]; s1[r] = (base < l1) ? -1e30f : s1[r]; } }
#pragma unroll
                    for (int r = 0; r < 4; ++r) { s0[r] = __builtin_amdgcn_exp2f(s0[r]); s1[r] = __builtin_amdgcn_exp2f(s1[r]); psum[qi] += s0[r] + s1[r]; }
                    u32x4 pw; pw.x = cvtpk(s0[0], s0[1]); pw.y = cvtpk(s0[2], s0[3]); pw.z = cvtpk(s1[0], s1[1]); pw.w = cvtpk(s1[2], s1[3]);
                    pf[qi] = __builtin_bit_cast(bf16x8, pw);
                }
#pragma unroll
                for (int df = 0; df < 4; ++df) { const LAS unsigned char* vp = vbase + (ks * 32) * RS + df * 32;
                    const bf16x8 vf = cat8(lds_tr(vp), lds_tr(vp + 16 * RS));
                    O[df][0] = __builtin_amdgcn_mfma_f32_16x16x32_bf16(vf, pf[0], O[df][0], 0, 0, 0);
                    O[df][1] = __builtin_amdgcn_mfma_f32_16x16x32_bf16(vf, pf[1], O[df][1], 0, 0, 0); }
            }
        }
        } else {
#pragma unroll
        for (int ks = 0; ks < 4; ++ks) {
            {
                const LAS unsigned char* kp = Ks + (32 * ks + c) * RS + 16 * g;
                const bf16x8 ka0 = *(const LAS bf16x8*)kp, ka1 = *(const LAS bf16x8*)(kp + 64), kb0 = *(const LAS bf16x8*)(kp + 16 * RS), kb1 = *(const LAS bf16x8*)(kp + 16 * RS + 64);
                bf16x8 pf[2];
#pragma unroll
                for (int qi = 0; qi < 2; ++qi) {
                    f32x4 s0 = __builtin_amdgcn_mfma_f32_16x16x32_bf16(ka0, qf[qi][0], negm, 0, 0, 0);
                    s0 = __builtin_amdgcn_mfma_f32_16x16x32_bf16(ka1, qf[qi][1], s0, 0, 0, 0);
                    f32x4 s1 = __builtin_amdgcn_mfma_f32_16x16x32_bf16(kb0, qf[qi][0], negm, 0, 0, 0);
                    s1 = __builtin_amdgcn_mfma_f32_16x16x32_bf16(kb1, qf[qi][1], s1, 0, 0, 0);
#pragma unroll
                    for (int r = 0; r < 4; ++r) { s0[r] = __builtin_amdgcn_exp2f(s0[r]); s1[r] = __builtin_amdgcn_exp2f(s1[r]); psum[qi] += s0[r] + s1[r]; }
                    u32x4 pw; pw.x = cvtpk(s0[0], s0[1]); pw.y = cvtpk(s0[2], s0[3]); pw.z = cvtpk(s1[0], s1[1]); pw.w = cvtpk(s1[2], s1[3]);
                    pf[qi] = __builtin_bit_cast(bf16x8, pw);
                }
#pragma unroll
                for (int df = 0; df < 4; ++df) { const LAS unsigned char* vp = vbase + (ks * 32) * RS + df * 32;
                    const bf16x8 vf = cat8(lds_tr(vp), lds_tr(vp + 16 * RS));
                    O[df][0] = __builtin_amdgcn_mfma_f32_16x16x32_bf16(vf, pf[0], O[df][0], 0, 0, 0);
                    O[df][1] = __builtin_amdgcn_mfma_f32_16x16x32_bf16(vf, pf[1], O[df][1], 0, 0, 0); }
            }
        }
        }
        l_run[0] += psum[0]; l_run[1] += psum[1];
        ti = tn;
    }
#undef ATT_KROW
#undef ATT_PRELOAD
#pragma unroll
    for (int qi = 0; qi < 2; ++qi) { float lt = l_run[qi]; lt += __shfl_xor(lt, 16); lt += __shfl_xor(lt, 32); const float inv = 1.f / lt;
        const size_t row = (size_t)(qrow0 + qq * 32 + 16 * qi + c);
#pragma unroll
        for (int df = 0; df < 4; ++df) mul_store4z(Z + row * 1024 + 512 + (kvh * 4 + gq) * 64 + 16 * df + 4 * g, O[df][qi] * inv, zreg[qi][df], dry); }
}

__device__ __forceinline__ void f1_item(LAS unsigned char* lds, const bf16_t* Gb, bf16_t* Afft, const bf16_t* t128, int b, int l2, int tid, int lane, int wave) {
    constexpr int RS = 528;
    const int g = lane >> 4, c = lane & 15;
    __syncthreads();
#pragma unroll
    for (int it = 0; it < 16; ++it) { const int id = it * 512 + tid, row = id >> 5, c16 = id & 31, pp = row >> 7, l1 = row & 127;
        *(LAS u32x4*)(lds + row * RS + c16 * 16) = *(const u32x4*)(Gb + (size_t)(b * SEQ + 64 * l1 + l2) * 512 + pp * 256 + c16 * 8); }
    bf16x8 tb[8][2];
    { const bf16_t* tp = t128 + (size_t)(32 * wave + c) * 256 + 8 * g;
#pragma unroll
      for (int ks = 0; ks < 8; ++ks)
#pragma unroll
          for (int j = 0; j < 2; ++j) tb[ks][j] = *(const bf16x8*)(tp + (size_t)j * 16 * 256 + ks * 32); }
    __syncthreads();
    const LAS unsigned char* abase = lds + (8 * g + (c >> 2)) * RS + (4 * (c & 3)) * 2;
    const int part = wave >> 2;
#pragma unroll 1
    for (int cq = 0; cq < 4; ++cq) {
        f32x4 acc[4][2]; zero_acc<4, 2>(acc);
#pragma unroll
        for (int ks = 0; ks < 8; ++ks) {
            bf16x8 a[4];
#pragma unroll
            for (int i = 0; i < 4; ++i) { const LAS unsigned char* ap = abase + ks * 32 * RS + (cq * 64 + 16 * i) * 2; a[i] = cat8(lds_tr(ap), lds_tr(ap + 4 * RS)); }
#pragma unroll
            for (int i = 0; i < 4; ++i)
#pragma unroll
                for (int j = 0; j < 2; ++j) acc[i][j] = __builtin_amdgcn_mfma_f32_16x16x32_bf16(a[i], tb[ks][j], acc[i][j], 0, 0, 0);
        }
#pragma unroll
        for (int j = 0; j < 2; ++j) { const int k1 = (wave & 3) * 32 + 16 * j + c; const size_t arow = ((size_t)(b * 128 + k1) * 64 + l2) * 2 + part;
#pragma unroll
            for (int i = 0; i < 4; ++i) { const unsigned long long o = (unsigned long long)cvtpk(acc[i][j][0], acc[i][j][1]) | ((unsigned long long)cvtpk(acc[i][j][2], acc[i][j][3]) << 32);
                __hip_atomic_store((unsigned long long*)(Afft + arow * 256 + cq * 64 + 16 * i + 4 * g), o, __ATOMIC_RELAXED, __HIP_MEMORY_SCOPE_AGENT); } }
    }
}
__device__ __forceinline__ void sgu_item(LAS unsigned char* lds, const bf16_t* Ub, bf16_t* Z, const bf16_t* sguw, const float* sgub, int ci, int tid, int lane, int wave, bool dry = false) {
    constexpr int RS = 528;
    const int row0 = ci * 128;
    const int grp = wave >> 1, sh = wave & 1, g = lane >> 4, c = lane & 15;
    const int t = tid >> 2, qd = tid & 3; const bf16_t* vp = Ub + (size_t)(row0 + t) * 512 + 256 + qd * 64;
    u32x4 w[8];
#pragma unroll
    for (int i = 0; i < 8; ++i) w[i] = *(const u32x4*)(vp + 8 * i);
    bf16x8 b0[4][4];
    ag_load<4, 4>(b0, sguw + (size_t)grp * 16384 + (size_t)(sh * 64 + c) * 128 + 8 * g, 128, 0);
    u32x2 uw[4][4], zw[4][4];
#pragma unroll
    for (int j = 0; j < 4; ++j) { const size_t row = (size_t)(row0 + sh * 64 + 16 * j + c);
#pragma unroll
        for (int i = 0; i < 4; ++i) { const int col = grp * 64 + 16 * i + 4 * g; uw[i][j] = *(const u32x2*)(Ub + row * 512 + col); zw[i][j] = *(const u32x2*)(Z + row * 1024 + 256 + col); } }
    __syncthreads();
    { float ss = 0.f;
#pragma unroll
      for (int i = 0; i < 8; ++i) {
          const float a0 = bflo(w[i].x), a1 = bfhi(w[i].x), a2 = bflo(w[i].y), a3 = bfhi(w[i].y), a4 = bflo(w[i].z), a5 = bfhi(w[i].z), a6 = bflo(w[i].w), a7 = bfhi(w[i].w);
          ss += (a0 * a0 + a1 * a1) + (a2 * a2 + a3 * a3) + (a4 * a4 + a5 * a5) + (a6 * a6 + a7 * a7); }
      ss += __shfl_xor(ss, 1); ss += __shfl_xor(ss, 2);
      const float rinv = rsqrtf(ss * (1.f / 256.f) + EPSV);
#pragma unroll
      for (int i = 0; i < 8; ++i) { u32x4 o; o.x = cvtpk(bflo(w[i].x) * rinv, bfhi(w[i].x) * rinv); o.y = cvtpk(bflo(w[i].y) * rinv, bfhi(w[i].y) * rinv); o.z = cvtpk(bflo(w[i].z) * rinv, bfhi(w[i].z) * rinv); o.w = cvtpk(bflo(w[i].w) * rinv, bfhi(w[i].w) * rinv);
          *(LAS u32x4*)(lds + t * RS + qd * 128 + i * 16) = o; } }
    __syncthreads();
    f32x4 acc[4][4]; zero_acc<4, 4>(acc);
    ag_mma<4, 4, 4>(acc, b0, lds + (8 * g + (c >> 2)) * RS + (grp * 64 + 4 * (c & 3)) * 2, RS, 0);
#pragma unroll
    for (int j = 0; j < 4; ++j) { const int s_ = sh * 64 + 16 * j + c; const float bias = sgub[grp * 128 + s_]; const size_t row = (size_t)(row0 + s_);
#pragma unroll
        for (int i = 0; i < 4; ++i) { const int col = grp * 64 + 16 * i + 4 * g; const u32x2 u2 = uw[i][j];
            f32x4 v = acc[i][j]; v[0] = (v[0] + bias) * bflo(u2.x); v[1] = (v[1] + bias) * bfhi(u2.x); v[2] = (v[2] + bias) * bflo(u2.y); v[3] = (v[3] + bias) * bfhi(u2.y);
            mul_store4z(Z + row * 1024 + 256 + col, v, zw[i][j], dry); } }
}
__device__ __forceinline__ void f3_wave_item(LAS unsigned char* ldsw, const bf16_t* Afft, bf16_t* Z, const bf16_t* t3, int wi, int lane, bool dry) {
    constexpr int RS = 80;
    const int b = wi >> 10, k1 = (wi >> 3) & 127, ch0 = (wi & 7) * 32;
    const bf16_t* src = Afft + (size_t)(b * 128 + k1) * 128 * 256 + ch0;
    u32x4 v[8];
#pragma unroll
    for (int it = 0; it < 8; ++it) { const int id = it * 64 + lane; v[it] = *(const u32x4*)(src + (size_t)(id >> 2) * 256 + (id & 3) * 8); }
#pragma unroll
    for (int it = 0; it < 8; ++it) { const int id = it * 64 + lane; *(LAS u32x4*)(ldsw + (id >> 2) * RS + (id & 3) * 16) = v[it]; }
    asm volatile("s_waitcnt lgkmcnt(0)" ::: "memory");
    const int g = lane >> 4, c = lane & 15;
    f32x4 acc[2][4]; zero_acc<2, 4>(acc);
    act_gemm<2, 4, 4, 4>(acc, ldsw, RS, 0, t3 + (size_t)k1 * 64 * 128, 128, lane);
#pragma unroll
    for (int j = 0; j < 4; ++j) { const int k2 = 16 * j + c; const size_t row = (size_t)b * SEQ + k1 + 128 * k2;
#pragma unroll
        for (int i = 0; i < 2; ++i) mul_store4(Z + row * 1024 + ch0 + 16 * i + 4 * g, acc[i][j], dry); }
    asm volatile("" ::: "memory");
}
__device__ __forceinline__ void fc_item(LAS unsigned char* lds, const bf16_t* Gb, bf16_t* Z, const bf16_t* tc, int item, int tid, int lane, int wave, bool dry = false) {
    constexpr int RS = 144;
    const int b = item >> 3, chq = (item >> 1) & 3, kh = item & 1;
    u32x4 v[8];
#pragma unroll
    for (int it = 0; it < 8; ++it) { const int id = it * 512 + tid, row = id >> 3, c16 = id & 7, part = row >> 8, ll = row & 255;
        v[it] = *(const u32x4*)(Gb + (size_t)(ML + b * 256 + ll) * 512 + part * 256 + chq * 64 + c16 * 8); }
    __syncthreads();
#pragma unroll
    for (int it = 0; it < 8; ++it) { const int id = it * 512 + tid; *(LAS u32x4*)(lds + (id >> 3) * RS + (id & 7) * 16) = v[it]; }
    __syncthreads();
    const int g = lane >> 4, c = lane & 15, kk0 = kh * 128 + (wave >> 2) * 64;
    f32x4 acc[1][4]; zero_acc<1, 4>(acc);
    act_gemm<1, 4, 16, 4>(acc, lds, RS, 16 * (wave & 3), tc + (size_t)kk0 * 512, 512, lane);
#pragma unroll
    for (int j = 0; j < 4; ++j) { const size_t row = (size_t)(ML + b * 256 + kk0 + 16 * j + c); mul_store4(Z + row * 1024 + chq * 64 + 16 * (wave & 3) + 4 * g, acc[0][j], dry); }
}

__device__ __forceinline__ void ctx_merge_tile(const bf16_t* Y, const unsigned char* GT, bf16_t* MG, const unsigned char* wsW, int tile, int lane, int wave) {
    const int m = ML + 64 * (tile >> 4) + 16 * (wave >> 1) + (lane & 15), nb = 64 * (tile & 15) + 32 * (wave & 1), g = lane >> 4, c = lane & 15;
    f32x4 mg[2] = {(f32x4){0.f, 0.f, 0.f, 0.f}, (f32x4){0.f, 0.f, 0.f, 0.f}};
#pragma unroll
    for (int seg = 0; seg < 3; ++seg) {
        const int Kseg = seg == 2 ? 512 : 256;
        const bf16_t* Wt = (const bf16_t*)(wsW + W_PA_OFF) + seg * 256;
        const bf16_t* yp = Y + (size_t)m * 1024 + seg * 256 + 8 * g;
        const bf16_t* wp = Wt + (size_t)(nb + c) * 1024 + 8 * g;
        f32x4 acc[2] = {(f32x4){0.f, 0.f, 0.f, 0.f}, (f32x4){0.f, 0.f, 0.f, 0.f}};
#pragma unroll 8
        for (int ks = 0; ks < Kseg / 32; ++ks) {
            const bf16x8 yf = *(const bf16x8*)(yp + ks * 32);
#pragma unroll
            for (int j = 0; j < 2; ++j) { const bf16x8 wf = *(const bf16x8*)(wp + (size_t)j * 16 * 1024 + ks * 32); acc[j] = __builtin_amdgcn_mfma_f32_16x16x32_bf16(wf, yf, acc[j], 0, 0, 0); }
        }
#pragma unroll
        for (int j = 0; j < 2; ++j) { const unsigned gw = *(const unsigned*)(GT + (size_t)m * 3072 + seg * 1024 + nb + 16 * j + 4 * g);
            mg[j][0] += acc[j][0] * ub0(gw) * (1.f / 255.f); mg[j][1] += acc[j][1] * ub1(gw) * (1.f / 255.f); mg[j][2] += acc[j][2] * ub2(gw) * (1.f / 255.f); mg[j][3] += acc[j][3] * ub3(gw) * (1.f / 255.f); }
    }
#pragma unroll
    for (int j = 0; j < 2; ++j) { u32x2 o; o.x = cvtpk(mg[j][0], mg[j][1]); o.y = cvtpk(mg[j][2], mg[j][3]); *(u32x2*)(MG + (size_t)m * 1024 + nb + 16 * j + 4 * g) = o; }
}
__device__ __forceinline__ void ctx_out_tile(const bf16_t* MG, const bf16_t* WoT, const float* csrc, float* cdst, const float* gate_c, int tile, int lane, int wave) {
    const int mr = 64 * (tile >> 4) + 16 * (wave >> 1) + (lane & 15), nb = 64 * (tile & 15) + 32 * (wave & 1), g = lane >> 4, c = lane & 15;
    const bf16_t* ap = MG + (size_t)(ML + mr) * 1024 + 8 * g;
    const bf16_t* wp = WoT + (size_t)(nb + c) * 1024 + 8 * g;
    f32x4 acc[2] = {(f32x4){0.f, 0.f, 0.f, 0.f}, (f32x4){0.f, 0.f, 0.f, 0.f}};
#pragma unroll 8
    for (int ks = 0; ks < 32; ++ks) {
        const bf16x8 yf = *(const bf16x8*)(ap + ks * 32);
#pragma unroll
        for (int j = 0; j < 2; ++j) { const bf16x8 wf = *(const bf16x8*)(wp + (size_t)j * 16 * 1024 + ks * 32); acc[j] = __builtin_amdgcn_mfma_f32_16x16x32_bf16(wf, yf, acc[j], 0, 0, 0); }
    }
#pragma unroll
    for (int j = 0; j < 2; ++j) { const int n = nb + 16 * j + 4 * g; const f32x4 gt = *(const f32x4*)(gate_c + n); const f32x4 xs = *(const f32x4*)(csrc + (size_t)mr * DM + n);
        *(f32x4*)(cdst + (size_t)mr * DM + n) = xs + gt * acc[j]; }
}

#define XB_TMO      128
#define XB_XCNT(j)  (256  + 64 * (j))
#define XB_XSUB(j)  (1280 + 64 * (j))
#define XB_XGEN(j)  (2304 + 64 * (j))
#define XB_TOP      3328
#define XB_TOPGEN   3392
#define XCD_BAR_WORDS 3456
#define XB_SPIN_CAP (1u << 18)
__device__ __forceinline__ unsigned xb_ld(unsigned* p)              { return __hip_atomic_load(p, __ATOMIC_RELAXED, __HIP_MEMORY_SCOPE_AGENT); }
__device__ __forceinline__ unsigned xb_add(unsigned* p, unsigned v) { return __hip_atomic_fetch_add(p, v, __ATOMIC_RELAXED, __HIP_MEMORY_SCOPE_AGENT); }
__device__ __forceinline__ unsigned xb_xcc_id() { return (unsigned)__builtin_amdgcn_s_getreg((3 << 11) | 20) & 0xFu; }
#define XB_SPIN(cond, bar) do { unsigned _sp = 0; while (cond) { __builtin_amdgcn_s_sleep(1); \
    if ((++_sp & 255u) == 0u) { if (xb_ld(&(bar)[XB_TMO])) break; if (_sp > XB_SPIN_CAP) { atomicAdd(&(bar)[XB_TMO], 1u); break; } } } } while (0)
struct XcdBarrier { unsigned* bar; unsigned x; volatile LAS unsigned* st; };
__device__ __forceinline__ XcdBarrier xcd_barrier_post(unsigned* bar, volatile LAS unsigned* st) {
    XcdBarrier b; b.bar = bar; b.x = xb_xcc_id(); b.st = st;
    if (threadIdx.x == 0) (void)xb_add(&bar[XB_XCNT(b.x)], 1u);
    return b;
}
__device__ __forceinline__ void xcd_barrier_complete(unsigned* bar, unsigned x, unsigned& nloc, unsigned& nx) {
    const unsigned G = gridDim.x * gridDim.y * gridDim.z;
    unsigned sum, cnt, mine, sp = 0u;
    for (;;) {
        sum = 0u; cnt = 0u; mine = 0u;
#pragma unroll
        for (unsigned j = 0; j < 16; ++j) { const unsigned c = xb_ld(&bar[XB_XCNT(j)]); sum += c; cnt += (c > 0u) ? 1u : 0u; mine = (j == x) ? c : mine; }
        if (sum == G) break;
        __builtin_amdgcn_s_sleep(1);
        if ((++sp & 255u) == 0u) { if (xb_ld(&bar[XB_TMO])) break; if (sp > XB_SPIN_CAP) { atomicAdd(&bar[XB_TMO], 1u); break; } }
    }
    nloc = mine > 0u ? mine : 1u; nx = cnt > 0u ? cnt : 1u;
}
__device__ __forceinline__ void xcd_barrier(const XcdBarrier& b) {
    asm volatile("s_waitcnt vmcnt(0)" ::: "memory");
    __syncthreads();
    if (threadIdx.x == 0) {
        unsigned bz_ = 0u, bx = b.x;
        asm volatile("" : "+s"(bz_), "+s"(bx)); unsigned* bar = b.bar + bz_;
        __builtin_amdgcn_s_waitcnt(0);
        unsigned nloc = b.st[0], nx = b.st[1];
        if (nloc == 0u) { xcd_barrier_complete(bar, bx, nloc, nx); b.st[0] = nloc; b.st[1] = nx; }
        const unsigned old = xb_add(&bar[XB_XSUB(bx)], 1u);
        const unsigned gen = old / nloc;
        if (old + 1u == (gen + 1u) * nloc) {
            __builtin_amdgcn_fence(__ATOMIC_RELEASE, "agent");
            asm volatile("s_waitcnt vmcnt(0)" ::: "memory");
            const unsigned og = xb_add(&bar[XB_TOP], 1u);
            const unsigned tg = og / nx;
            if (og + 1u == (tg + 1u) * nx) xb_add(&bar[XB_TOPGEN], 1u);
            else XB_SPIN(xb_ld(&bar[XB_TOPGEN]) == tg, bar);
            __builtin_amdgcn_fence(__ATOMIC_ACQUIRE, "agent");
            xb_add(&bar[XB_XGEN(bx)], 1u);
            asm volatile("s_waitcnt vmcnt(0)" ::: "memory");
        } else {
            XB_SPIN(xb_ld(&bar[XB_XGEN(bx)]) == gen, bar);
            __builtin_amdgcn_fence(__ATOMIC_ACQUIRE, "agent");
            asm volatile("s_waitcnt vmcnt(0)" ::: "memory");
        }
    }
    __syncthreads();
}

#define PHASE_IDS() int t__ = threadIdx.x, b__ = blockIdx.x, g__ = gridDim.x; asm volatile("" : "+v"(t__)); asm volatile("" : "+s"(b__), "+s"(g__)); \
    size_t wz_ = 0; asm volatile("" : "+s"(wz_)); unsigned char* ws = p.ws + wz_;     \
    const int tid = t__, lane = tid & 63, wave = __builtin_amdgcn_readfirstlane(tid >> 6), bid = b__, G = g__; (void)lane; (void)wave; (void)bid; (void)G
__global__ void __launch_bounds__(512, 2) fwd_megakernel(Params p) {
    extern __shared__ __attribute__((aligned(16))) unsigned char lds_raw[];
    LAS unsigned char* lds = (LAS unsigned char*)lds_raw;
    cg::grid_group grid = cg::this_grid();
    volatile LAS unsigned* bst = (volatile LAS unsigned*)(lds + LDS_BYTES - 16);
    if (threadIdx.x < 4) bst[threadIdx.x] = 0u;
    __syncthreads();
    const XcdBarrier xbar = xcd_barrier_post((unsigned*)(p.ws + WS_BAR), bst);
    unsigned long long tacc_ = 0ull, t0_ = 0ull; (void)t0_; (void)tacc_;
#define TS_BEGIN(k) do { if (PROBE_TS == (k)) t0_ = __builtin_amdgcn_s_memrealtime(); } while (0)
#define TS_END(k) do { if (PROBE_TS == (k)) tacc_ += __builtin_amdgcn_s_memrealtime() - t0_; } while (0)
#define GSYNC() do { TS_BEGIN(7); xcd_barrier(xbar); if (PROBE_DUP == 7) xcd_barrier(xbar); TS_END(7); } while (0)
    const unsigned long long tstart_ = (PROBE_TS == 8) ? __builtin_amdgcn_s_memrealtime() : 0ull; (void)tstart_;
    TS_BEGIN(9);
#ifndef SKIP_P0
    { PHASE_IDS(); phase0(p, lds, tid, bid, G); __syncthreads(); conv_weights(p, lds, 0, tid, lane, wave, bid, G); }
#endif
    TS_END(9);
    grid.sync();
#pragma unroll 1
    for (int l = 0; l < DEPTH; ++l) {
        const bool last = (l == DEPTH - 1);
        TS_BEGIN(1);
#ifndef SKIP_P1
        for (int rep = (PROBE_DUP == 1 ? 0 : 1); rep < 2; ++rep) { PHASE_IDS(); h_rows(p, l, lane, wave, bid, G); }
#endif
        TS_END(1);
        GSYNC();
        TS_BEGIN(2);
#ifndef SKIP_P2
#pragma unroll 1
        for (int rep = (PROBE_DUP == 2 ? 0 : 1); rep < 2; ++rep) { PHASE_IDS();
          pg8::Gemm g{(const bf16_t*)(ws + WS_H), (const bf16_t*)(ws + ((l & 1) ? WS_W1 : WS_W) + W_IN_OFF), MT, NIN, 1024, 1024}; pg8::StaticOrder S; S.init(MT, NIN, G, bid);
          pg8::EpiProj E{(bf16_t*)(ws + WS_G), (bf16_t*)(ws + WS_Z), (bf16_t*)(ws + WS_U), (bf16_t*)(ws + WS_QKV), (bf16_t*)(ws + WS_GT), (const float*)(ws + WS_ROPE), p.in[9] + l * 64, p.in[10] + l * 64};
          pg8::gemm_phase<pg8::EpiProj>(lds, g, S, E, tid); }
#endif
        TS_END(2);
        GSYNC();
        TS_BEGIN(3);
#ifndef SKIP_P3
#pragma unroll 1
        for (int rep = 1; rep < 2; ++rep) { PHASE_IDS(); const bool dry = false;
          bf16_t* Zb = (bf16_t*)(ws + WS_Z); const bf16_t* QKVb = (const bf16_t*)(ws + WS_QKV);
          const int n_attn = last ? 1024 : 1056, n_f1 = 256, n_sgu = last ? 256 : 264, total = n_attn + n_f1 + n_sgu;
          const float* sinkl = p.in[11] + l * 8; const float* sgub = p.in[8] + l * 512; const float m0 = ((const float*)(ws + WS_ROPE + 131072))[l];
          unsigned* f1cnt = (unsigned*)(ws + WS_BAR) + 3584 + 64 * (l * 4);
          for (int item = bid; item < total; item += G) {
              int tid = t__; asm volatile("" : "+v"(tid)); const int lane = tid & 63;
              if (item < n_f1) { f1_item(lds, (const bf16_t*)(ws + WS_G), (bf16_t*)(ws + WS_H), (const bf16_t*)(ws + WS_T128), item >> 6, item & 63, tid, lane, wave);
                                 asm volatile("s_waitcnt vmcnt(0)" ::: "memory"); __syncthreads();
                                 if (tid == 0) __hip_atomic_fetch_add(f1cnt + 64 * (item >> 6), 1u, __ATOMIC_RELAXED, __HIP_MEMORY_SCOPE_AGENT); }
              else if (item < n_f1 + n_attn) { const int ia = item - n_f1; const bool ic = ia >= 1024; const int i2 = ia - 1024;
                                   attn_item(lds, QKVb, Zb, sinkl, m0, ic ? (i2 >> 3) : (ia >> 8), ic ? ((i2 >> 2) & 1) : ((ia >> 2) & 63), (ia >> 1) & 1, ia & 1, ic, tid, lane, wave, dry); }
              else { sgu_item(lds, (const bf16_t*)(ws + WS_U), Zb, (const bf16_t*)(ws + WS_SGUW), sgub, item - n_attn - n_f1, tid, lane, wave, dry); }
          }
          if (rep == 1) {
              __syncthreads();
              if (tid == 0) { unsigned sp = 0;
                  while (__hip_atomic_load(f1cnt, __ATOMIC_RELAXED, __HIP_MEMORY_SCOPE_AGENT) < 64u || __hip_atomic_load(f1cnt + 64, __ATOMIC_RELAXED, __HIP_MEMORY_SCOPE_AGENT) < 64u ||
                         __hip_atomic_load(f1cnt + 128, __ATOMIC_RELAXED, __HIP_MEMORY_SCOPE_AGENT) < 64u || __hip_atomic_load(f1cnt + 192, __ATOMIC_RELAXED, __HIP_MEMORY_SCOPE_AGENT) < 64u) {
                      __builtin_amdgcn_s_sleep(2); if (++sp > (1u << 20)) break; } }
              __syncthreads();
              __builtin_amdgcn_fence(__ATOMIC_ACQUIRE, "agent");
              asm volatile("s_waitcnt vmcnt(0)" ::: "memory");
              for (int wi = bid * 8 + wave; wi < 4096; wi += G * 8) f3_wave_item(lds + wave * 10240, (const bf16_t*)(ws + WS_H), Zb, (const bf16_t*)(ws + WS_T3), wi, lane, false);
              if (!last) { for (int item = (bid + G - 64 % G) % G; item < 32; item += G) fc_item(lds, (const bf16_t*)(ws + WS_G), Zb, (const bf16_t*)(ws + WS_TC), item, tid, lane, wave, false); }
              if (!last) { __syncthreads(); conv_weights(p, lds, l + 1, tid, lane, wave, bid, G); }
          }
        }
#endif
        TS_END(3);
        GSYNC();
        TS_BEGIN(5);
#ifndef SKIP_P5
        if (!last) { PHASE_IDS();
          for (int t = bid; t < 256; t += G) ctx_merge_tile((const bf16_t*)(ws + WS_Z), (const unsigned char*)(ws + WS_GT), (bf16_t*)(ws + WS_H), ws + ((l & 1) ? WS_W1 : WS_W), t, lane, wave); }
#pragma unroll 1
        for (int rep = (PROBE_DUP == 5 ? 0 : 1); rep < 2; ++rep) { PHASE_IDS();
          pg8::StaticOrder S; S.init(ML, 1024, G, bid);
          pg8::Gemm g{(const bf16_t*)(ws + WS_Z), (const bf16_t*)(ws + ((l & 1) ? WS_W1 : WS_W) + W_PA_OFF), ML, 1024, 1024, 1024};
          pg8::EpiMerge E{(const unsigned char*)(ws + WS_GT), (bf16_t*)(ws + WS_H)};
          pg8::gemm_phase<pg8::EpiMerge, true>(lds, g, S, E, tid); }
#endif
        TS_END(5);
        GSYNC();
        TS_BEGIN(6);
#ifndef SKIP_P6
#pragma unroll 1
        for (int rep = (PROBE_DUP == 6 ? 0 : 1); rep < 2; ++rep) { PHASE_IDS();
          const int Mrows = ML; pg8::StaticOrder S; S.init(Mrows, 1024, G, bid);
          pg8::Gemm g{(const bf16_t*)(ws + WS_H), (const bf16_t*)(ws + ((l & 1) ? WS_W1 : WS_W) + W_OUT_OFF), Mrows, 1024, 1024, 1024};
          float* XC = (float*)(ws + WS_XC);
          if (!last && rep == 1) { for (int t = bid; t < 256; t += G) ctx_out_tile((const bf16_t*)(ws + WS_H), (const bf16_t*)(ws + ((l & 1) ? WS_W1 : WS_W) + W_OUT_OFF), l == 0 ? p.in[2] : XC, XC, (const float*)(ws + WS_MOD) + (size_t)(l * 5 + 4) * 3072 + 2048, t, lane, wave); }
          pg8::EpiRes E{l == 0 ? p.in[0] : p.out, p.out, l == 0 ? p.in[2] : XC, XC, rep == 0 ? (const float*)(ws + WS_ROPE + 65536) : (const float*)(ws + WS_MOD) + (size_t)l * 5 * 3072};
          pg8::gemm_phase<pg8::EpiRes>(lds, g, S, E, tid); }
#endif
        TS_END(6);
        if (!last) GSYNC();
    }
    if (PROBE_TS != 0) {
        if (PROBE_TS == 8) tacc_ = __builtin_amdgcn_s_memrealtime() - tstart_;
        xcd_barrier(xbar);
        if (blockIdx.x == 0 && threadIdx.x == 0) p.out[0] += 0.3f + (float)tacc_ * (0.01f / PROBE_SCALE);
    }
}

extern "C" void kernel_launch(void* const* d_in, const int* in_sizes, int n_in, void* d_out, int out_size, void* d_ws, size_t ws_size, hipStream_t stream) {
    static int grid = 0;
    if (grid == 0) {
        if (n_in != 16 || ws_size < WS_END) { fprintf(stderr, "kernel_launch: unexpected inputs (n_in %d, ws %zu)\n", n_in, ws_size); grid = -1; return; }
        int dev = 0, cus = 0, per_cu = 0;
        hipGetDevice(&dev);
        hipDeviceGetAttribute(&cus, hipDeviceAttributeMultiprocessorCount, dev);
        hipFuncSetAttribute((const void*)fwd_megakernel, hipFuncAttributeMaxDynamicSharedMemorySize, LDS_BYTES);
        hipOccupancyMaxActiveBlocksPerMultiprocessor(&per_cu, (const void*)fwd_megakernel, 512, LDS_BYTES);
        if (per_cu < 1 || cus < 1) { fprintf(stderr, "kernel_launch: occupancy query gave %d blocks/CU on %d CUs\n", per_cu, cus); grid = -1; return; }
        grid = cus;
    }
    if (grid < 0) return;
    if (hipMemsetAsync((char*)d_ws + WS_BAR, 0, 20480, stream) != hipSuccess) { fprintf(stderr, "kernel_launch: memset of barrier words failed\n"); return; }
    Params p{};
    for (int i = 0; i < 16; ++i) p.in[i] = (const float*)d_in[i];
    p.out = (float*)d_out; p.ws = (unsigned char*)d_ws;
    void* args[] = {&p};
    hipError_t e = hipLaunchCooperativeKernel((const void*)fwd_megakernel, dim3(grid), dim3(512), args, LDS_BYTES, stream);
    if (e != hipSuccess) fprintf(stderr, "cooperative launch failed: %s (grid %d)\n", hipGetErrorString(e), grid);
}
```
